# Optimizing an MI355X kernel written in HIP

```python
import jax, jax.numpy as jnp
from jax import lax
import numpy as np

D_MODEL = 2048
BATCH = 2
SEQ = 16384
DEPTH = 2

GRID_W = 64
CTX_LEN = 256
N_MIXERS = 2
D_FF = 4 * D_MODEL
ROPE_BASE = 10000.0
NORM_EPS = 1e-6
Q_BLOCK = 128
NEG_INF = -1e30

MLA_HEADS = 16
MLA_Q_LORA = 512
MLA_KV_LORA = 512
MLA_NOPE = 128
MLA_ROPE = 64
MLA_V = 128

SWA_HEADS = 32
SWA_KV_HEADS = 4
SWA_HEAD_DIM = 64
SWA_WINDOW = 128

N_MLA_LAYERS = (DEPTH + 1) // 2
N_SWA_LAYERS = DEPTH // 2

kernel_name = 'hybrid_mla_swa_dit'


def rmsnorm(x, g):
    xf = x.astype(jnp.float32)
    y = xf * lax.rsqrt(jnp.mean(xf * xf, axis=-1, keepdims=True) + NORM_EPS)
    return (y * g.astype(jnp.float32)).astype(x.dtype)


def axial_angles(n_tokens, rot_dim):
    rows = n_tokens // GRID_W
    row = jnp.repeat(jnp.arange(rows, dtype=jnp.float32), GRID_W)
    col = jnp.tile(jnp.arange(GRID_W, dtype=jnp.float32), rows)
    n_freq = rot_dim // 4
    freqs = ROPE_BASE ** (-jnp.arange(n_freq, dtype=jnp.float32) / n_freq)
    return jnp.concatenate([row[:, None] * freqs, col[:, None] * freqs], axis=-1)


def apply_rope(x, cos, sin):
    half = x.shape[-1] // 2
    x1, x2 = x[..., :half], x[..., half:]
    return jnp.concatenate([x1 * cos - x2 * sin, x1 * sin + x2 * cos], axis=-1)


def mla_mixer(h_lat, h_ctx, w_in, g_qa, g_kva, w_qb, w_kvb, w_out, cos, sin, need_ctx):
    B, S, _ = h_lat.shape
    n_qk = MLA_NOPE + MLA_ROPE
    scale = n_qk ** -0.5

    def queries(q_a):
        q = (rmsnorm(q_a, g_qa) @ w_qb).reshape(q_a.shape[0], q_a.shape[1], MLA_HEADS, n_qk)
        return q[..., :MLA_NOPE], q[..., MLA_NOPE:]

    def keys_values(c_kv):
        kv = (rmsnorm(c_kv, g_kva) @ w_kvb).reshape(c_kv.shape[0], c_kv.shape[1], MLA_HEADS, MLA_NOPE + MLA_V)
        return kv[..., :MLA_NOPE], kv[..., MLA_NOPE:]

    def attend(qn, qr, kn, kr, v):
        s = jnp.einsum('bqhd,bkhd->bhqk', qn, kn) + jnp.einsum('bqhr,bkr->bhqk', qr, kr)
        p = jax.nn.softmax(s.astype(jnp.float32) * scale, axis=-1).astype(v.dtype)
        o = jnp.einsum('bhqk,bkhv->bqhv', p, v)
        return o.reshape(o.shape[0], o.shape[1], MLA_HEADS * MLA_V)

    p_l = h_lat @ w_in
    qn_l, qr_l = queries(p_l[..., :MLA_Q_LORA])
    qr_l = apply_rope(qr_l, cos[:, None], sin[:, None])
    kn_l, v_l = keys_values(p_l[..., MLA_Q_LORA:MLA_Q_LORA + MLA_KV_LORA])
    kr_l = apply_rope(p_l[..., MLA_Q_LORA + MLA_KV_LORA:], cos, sin)

    p_c = h_ctx @ (w_in if need_ctx else w_in[:, MLA_Q_LORA:])
    p_c_kv = p_c[..., p_c.shape[-1] - (MLA_KV_LORA + MLA_ROPE):]
    kn_c, v_c = keys_values(p_c_kv[..., :MLA_KV_LORA])
    kr_c = p_c_kv[..., MLA_KV_LORA:]

    kn_all = jnp.concatenate([kn_c, kn_l], axis=1)
    kr_all = jnp.concatenate([kr_c, kr_l], axis=1)
    v_all = jnp.concatenate([v_c, v_l], axis=1)

    def block(i):
        st = i * Q_BLOCK
        qn = lax.dynamic_slice_in_dim(qn_l, st, Q_BLOCK, axis=1)
        qr = lax.dynamic_slice_in_dim(qr_l, st, Q_BLOCK, axis=1)
        return attend(qn, qr, kn_all, kr_all, v_all)

    o_l = lax.map(block, jnp.arange(S // Q_BLOCK))
    o_l = jnp.moveaxis(o_l, 0, 1).reshape(B, S, MLA_HEADS * MLA_V)
    out_l = o_l @ w_out
    if need_ctx:
        qn_c, qr_c = queries(p_c[..., :MLA_Q_LORA])
        out_c = attend(qn_c, qr_c, kn_c, kr_c, v_c) @ w_out
    else:
        out_c = None
    return out_l, out_c


def swa_mixer(h_lat, h_ctx, w_qkv, sink, w_out, cos, sin, need_ctx):
    B, S, _ = h_lat.shape
    L = h_ctx.shape[1]
    G = SWA_HEADS // SWA_KV_HEADS
    dq = SWA_HEADS * SWA_HEAD_DIM
    dkv = SWA_KV_HEADS * SWA_HEAD_DIM
    scale = SWA_HEAD_DIM ** -0.5
    sink_g = sink.astype(jnp.float32).reshape(SWA_KV_HEADS, G)

    def attend(q, k, v, mask):
        s = jnp.einsum('bqkgd,bskd->bkgqs', q, k).astype(jnp.float32) * scale
        if mask is not None:
            s = jnp.where(mask, s, NEG_INF)
        sk = jnp.broadcast_to(sink_g[None, :, :, None, None], s.shape[:-1] + (1,))
        p = jax.nn.softmax(jnp.concatenate([s, sk], axis=-1), axis=-1)[..., :-1].astype(v.dtype)
        o = jnp.einsum('bkgqs,bskd->bqkgd', p, v)
        return o.reshape(o.shape[0], o.shape[1], dq)

    p_l = h_lat @ w_qkv
    q_l = apply_rope(p_l[..., :dq].reshape(B, S, SWA_KV_HEADS, G, SWA_HEAD_DIM), cos[:, None, None], sin[:, None, None])
    k_l = apply_rope(p_l[..., dq:dq + dkv].reshape(B, S, SWA_KV_HEADS, SWA_HEAD_DIM), cos[:, None], sin[:, None])
    v_l = p_l[..., dq + dkv:].reshape(B, S, SWA_KV_HEADS, SWA_HEAD_DIM)

    p_c = h_ctx @ (w_qkv if need_ctx else w_qkv[:, dq:])
    p_c_kv = p_c[..., p_c.shape[-1] - 2 * dkv:]
    k_c = p_c_kv[..., :dkv].reshape(B, L, SWA_KV_HEADS, SWA_HEAD_DIM)
    v_c = p_c_kv[..., dkv:].reshape(B, L, SWA_KV_HEADS, SWA_HEAD_DIM)

    pad = ((0, 0), (SWA_WINDOW, SWA_WINDOW), (0, 0), (0, 0))
    kp = jnp.pad(k_l, pad)
    vp = jnp.pad(v_l, pad)
    span = Q_BLOCK + 2 * SWA_WINDOW
    ctx_mask = jnp.ones((Q_BLOCK, L), dtype=bool)

    def block(i):
        st = i * Q_BLOCK
        q = lax.dynamic_slice_in_dim(q_l, st, Q_BLOCK, axis=1)
        kw = lax.dynamic_slice_in_dim(kp, st, span, axis=1)
        vw = lax.dynamic_slice_in_dim(vp, st, span, axis=1)
        qpos = st + jnp.arange(Q_BLOCK)
        kpos = st - SWA_WINDOW + jnp.arange(span)
        band = (jnp.abs(qpos[:, None] - kpos[None, :]) <= SWA_WINDOW) & (kpos >= 0)[None, :] & (kpos < S)[None, :]
        mask = jnp.concatenate([ctx_mask, band], axis=1)
        return attend(q, jnp.concatenate([k_c, kw], axis=1), jnp.concatenate([v_c, vw], axis=1), mask)

    o_l = lax.map(block, jnp.arange(S // Q_BLOCK))
    o_l = jnp.moveaxis(o_l, 0, 1).reshape(B, S, dq)
    out_l = o_l @ w_out
    if need_ctx:
        q_c = p_c[..., :dq].reshape(B, L, SWA_KV_HEADS, G, SWA_HEAD_DIM)
        out_c = attend(q_c, k_c, v_c, None) @ w_out
    else:
        out_c = None
    return out_l, out_c


def sq_relu_mlp(h, w_in, w_out):
    return jnp.square(jax.nn.relu(h @ w_in)) @ w_out


def _w(key, shape, fan_in, scale=1.0):
    return jax.random.normal(key, shape, jnp.float32) * (scale * fan_in ** -0.5)


def setup_inputs(seed: int = 0) -> dict:
    key = jax.random.key(seed)
    ks = jax.random.split(key, 20)
    D = D_MODEL
    return {
        'x': jax.random.normal(ks[0], (BATCH, SEQ, D), jnp.float32),
        'c': jax.random.normal(ks[1], (BATCH, D), jnp.float32),
        'ctx': jax.random.normal(ks[2], (BATCH, CTX_LEN, D), jnp.float32),
        'c_ctx': jax.random.normal(ks[3], (D,), jnp.float32),
        'w_mod': _w(ks[4], (DEPTH, D, 6 * D), D, 0.5),
        'b_mod': 0.02 * jax.random.normal(ks[5], (DEPTH, 6 * D), jnp.float32),
        'g_norm': 1.0 + 0.1 * jax.random.normal(ks[6], (DEPTH, 4, D), jnp.float32),
        'w_ff_in': _w(ks[7], (DEPTH, D, D_FF), D),
        'w_ff_out': _w(ks[8], (DEPTH, D_FF, D), D_FF),
        'mla_w_in': _w(ks[9], (N_MLA_LAYERS, D, MLA_Q_LORA + MLA_KV_LORA + MLA_ROPE), D),
        'mla_g_qa': 1.0 + 0.1 * jax.random.normal(ks[10], (N_MLA_LAYERS, MLA_Q_LORA), jnp.float32),
        'mla_g_kva': 1.0 + 0.1 * jax.random.normal(ks[11], (N_MLA_LAYERS, MLA_KV_LORA), jnp.float32),
        'mla_w_qb': _w(ks[12], (N_MLA_LAYERS, MLA_Q_LORA, MLA_HEADS * (MLA_NOPE + MLA_ROPE)), MLA_Q_LORA),
        'mla_w_kvb': _w(ks[13], (N_MLA_LAYERS, MLA_KV_LORA, MLA_HEADS * (MLA_NOPE + MLA_V)), MLA_KV_LORA),
        'mla_w_out': _w(ks[14], (N_MLA_LAYERS, MLA_HEADS * MLA_V, D), MLA_HEADS * MLA_V),
        'swa_w_qkv': _w(ks[15], (N_SWA_LAYERS, D, (SWA_HEADS + 2 * SWA_KV_HEADS) * SWA_HEAD_DIM), D),
        'swa_sink': 0.5 * jax.random.normal(ks[16], (N_SWA_LAYERS, SWA_HEADS), jnp.float32),
        'swa_w_out': _w(ks[17], (N_SWA_LAYERS, SWA_HEADS * SWA_HEAD_DIM, D), SWA_HEADS * SWA_HEAD_DIM),
    }


def reference(x, c, ctx, c_ctx, w_mod, b_mod, g_norm, w_ff_in, w_ff_out,
              mla_w_in, mla_g_qa, mla_g_kva, mla_w_qb, mla_w_kvb, mla_w_out,
              swa_w_qkv, swa_sink, swa_w_out):
    S = x.shape[1]
    ang_mla = axial_angles(S, MLA_ROPE)
    ang_swa = axial_angles(S, SWA_HEAD_DIM)
    cos_mla, sin_mla = jnp.cos(ang_mla).astype(x.dtype), jnp.sin(ang_mla).astype(x.dtype)
    cos_swa, sin_swa = jnp.cos(ang_swa).astype(x.dtype), jnp.sin(ang_swa).astype(x.dtype)

    s = ctx
    for i in range(DEPTH):
        need_ctx = i < DEPTH - 1
        mod_l = (jax.nn.silu(c) @ w_mod[i] + b_mod[i])[:, None, :]
        mod_c = jax.nn.silu(c_ctx) @ w_mod[i] + b_mod[i]
        sh_a, sc_a, gt_a, sh_f, sc_f, gt_f = jnp.split(mod_l, 6, axis=-1)
        csh_a, csc_a, cgt_a, csh_f, csc_f, cgt_f = jnp.split(mod_c, 6, axis=-1)

        h_l = rmsnorm(x, g_norm[i, 0]) * (1.0 + sc_a) + sh_a
        h_c = rmsnorm(s, g_norm[i, 0]) * (1.0 + csc_a) + csh_a
        j = i // N_MIXERS
        if i % N_MIXERS == 0:
            y_l, y_c = mla_mixer(h_l, h_c, mla_w_in[j], mla_g_qa[j], mla_g_kva[j], mla_w_qb[j],
                                 mla_w_kvb[j], mla_w_out[j], cos_mla, sin_mla, need_ctx)
        else:
            y_l, y_c = swa_mixer(h_l, h_c, swa_w_qkv[j], swa_sink[j], swa_w_out[j],
                                 cos_swa, sin_swa, need_ctx)
        x = x + gt_a * rmsnorm(y_l, g_norm[i, 1])

        f_l = rmsnorm(x, g_norm[i, 2]) * (1.0 + sc_f) + sh_f
        x = x + gt_f * rmsnorm(sq_relu_mlp(f_l, w_ff_in[i], w_ff_out[i]), g_norm[i, 3])

        if need_ctx:
            s = s + cgt_a * rmsnorm(y_c, g_norm[i, 1])
            f_c = rmsnorm(s, g_norm[i, 2]) * (1.0 + csc_f) + csh_f
            s = s + cgt_f * rmsnorm(sq_relu_mlp(f_c, w_ff_in[i], w_ff_out[i]), g_norm[i, 3])
    return x
```

```cpp
#include <hip/hip_runtime.h>
#include <hip/hip_cooperative_groups.h>
#include <cstdio>
#include <cstdint>
namespace cg = cooperative_groups;

constexpr int DM = 2048, SEQ = 16384, CTXL = 256, TB = SEQ + CTXL  , NROW = 2 * TB  , DFF = 8192;
constexpr int NP1 = 1280  , NQ = 3072, NKV = 4096, NQKV = 2560;
constexpr float NORM_EPS = 1e-6f;
__device__ __forceinline__ int lane_id_v() { int l; asm volatile("v_mbcnt_lo_u32_b32 %0, -1, 0\n\tv_mbcnt_hi_u32_b32 %0, -1, %0" : "=v"(l)); return l; }
namespace pg8 {
#define PG8_LAS __attribute__((address_space(3)))
typedef unsigned short bf16_t;
typedef short bf16x8 __attribute__((ext_vector_type(8)));
typedef float f32x4 __attribute__((ext_vector_type(4)));
typedef unsigned u32x4 __attribute__((ext_vector_type(4)));
constexpr int BM = 256, BK = 64, HALF = 128, HTB = HALF * BK * 2  , STAGE_BYTES = 8 * HTB, NXCD = 8, WGM = 8;

__host__ __device__ __forceinline__ int lds_byte(int r, int c) { const int st = (r >> 4) * 2 + (c >> 5), rr = r & 15, cc = c & 31, ob = rr * 64 + cc * 2; return st * 1024 + (ob ^ (((ob >> 9) & 1) << 5)); }
__host__ __device__ __forceinline__ void stage_rc(int b, int& R, int& C) { const int st = b / 1024, sb = b % 1024, swz = sb ^ (((sb >> 9) & 1) << 5); R = (st >> 1) * 16 + swz / 64; C = (st & 1) * 32 + (swz % 64) / 2; }
__host__ __device__ __forceinline__ int perm32(int rho) { const int n = rho >> 4, i = rho & 15; return 8 * (i >> 2) + 4 * n + (i & 3); }

struct Unit { int pm, pn, kc; };
struct Gemm { const bf16_t* A; const bf16_t* Bt; int M, N, K, lda, ldb; };

struct StaticOrder {
    int nM, nN, nwg, G, c;
    __host__ __device__ void init(int M, int N, int G_, int c_) { nM = M / BM; nN = N / BM; nwg = nM * nN; G = G_; c = c_; }
    __host__ __device__ bool next(int i, Unit& u) const {
        const long L = (long)i * G + c; if (L >= nwg) return false;
        int wgid = (int)L; { const int q = nwg / NXCD, r = nwg % NXCD, xcd = wgid % NXCD, off = wgid / NXCD; wgid = (xcd < r ? xcd * (q + 1) : r * (q + 1) + (xcd - r) * q) + off; }
        const int nig = WGM * nN, gid = wgid / nig, fm = gid * WGM, gsz = (nM - fm) < WGM ? (nM - fm) : WGM;
        u.pm = fm + ((wgid % nig) % gsz); u.pn = (wgid % nig) / gsz; return true;
    }
    __device__ __forceinline__ void a_ready(const Unit&) const {}
    __device__ __forceinline__ void done(const Unit&) const {}
};


__device__ __forceinline__ unsigned cvt_pk_bf16(float lo, float hi) { unsigned r; asm volatile("v_cvt_pk_bf16_f32 %0, %1, %2" : "=v"(r) : "v"(lo), "v"(hi)); return r; }

struct RowSched {
    int nM, nN, nwg, G, c, skipctx;
    __device__ void init(int nM_, int nN_, int G_, int c_, int skipctx_) { nM = nM_; nN = nN_; nwg = nM * nN; G = G_; c = c_; skipctx = skipctx_; }
    __device__ bool next(int i, Unit& u) const {
        const long L = (long)i * G + c; if (L >= nwg) return false;
        int wgid = (int)L; { const int q = nwg / NXCD, r = nwg % NXCD, xcd = wgid % NXCD, off = wgid / NXCD; wgid = (xcd < r ? xcd * (q + 1) : r * (q + 1) + (xcd - r) * q) + off; }
        const int nig = WGM * nN, gid = wgid / nig, fm = gid * WGM, gsz = (nM - fm) < WGM ? (nM - fm) : WGM;
        int pm = fm + ((wgid % nig) % gsz); u.pn = (wgid % nig) / gsz;
        if (skipctx) pm += 1 + (pm >= 64 ? 1 : 0);
        u.pm = pm; u.kc = 0; return true;
    }
    __device__ __forceinline__ void a_ready(const Unit&) const {}
    __device__ __forceinline__ void done(const Unit&) const {}
};

struct CtxSplitSched {
    int nN, NKC, nwg, G, c;
    __device__ void init(int nN_, int NKC_, int G_, int c_) { nN = nN_; NKC = NKC_; nwg = 2 * nN * NKC; G = G_; c = c_; }
    __device__ bool next(int i, Unit& u) const {
        const long L = (long)i * G + c; if (L >= nwg) return false;
        const int l = (int)L, t = l / NKC; u.kc = l - t * NKC; u.pn = t % nN; u.pm = (t / nN) ? 65 : 0; return true;
    }
    __device__ __forceinline__ void a_ready(const Unit&) const {}
    __device__ __forceinline__ void done(const Unit&) const {}
};

template <int MODE> struct Epi {
    static constexpr bool PERM = true, AFTER_DRAIN = false;
    bf16_t* O; int ldc;
    float* ssq;
    const float* rssq;
    bf16_t* KR;
    const float* rtab; const float* ctab;
    float* part;
    __device__ __forceinline__ void operator()(const f32x4 (&acc)[2][2][4][2], const Unit& u, int wr, int wc, int fr, int fq) const {
        const int pm = u.pm, pn = u.pn;
        const bool isctx = (pm == 0) || (pm == 65);
        const int tbase = (pm > 65 ? pm - 66 : pm - 1) * 256;
#pragma unroll
        for (int ai = 0; ai < 2; ++ai)
#pragma unroll
            for (int m = 0; m < 4; ++m) {
                const int rt = ai * HALF + wr * 64 + m * 16 + fr;
                const int row = pm * BM + rt;
                const int t = tbase + rt;
                float rs = 1.f;
                if (MODE == 2 || MODE == 3) rs = __builtin_amdgcn_rsqf(rssq[row] * (1.0f / 512.0f) + 1e-6f);
                float sq = 0.f;
#pragma unroll
                for (int bj = 0; bj < 2; ++bj) {
                    const int col = pn * BM + bj * HALF + wc * 32 + 8 * fq;
                    f32x4 v0 = acc[ai][bj][m][0], v1 = acc[ai][bj][m][1];
                    if (MODE == 6) { float* pp = part + ((size_t)u.kc * 512 + (pm == 65 ? 256 : 0) + rt) * ldc + col; *(f32x4*)pp = v0; *(f32x4*)(pp + 4) = v1; continue; }
                    if (MODE == 2 || MODE == 3) { v0 = v0 * rs; v1 = v1 * rs; }
                    if (MODE == 0 || MODE == 1) sq += (v0[0] * v0[0] + v0[1] * v0[1]) + (v0[2] * v0[2] + v0[3] * v0[3]) + (v1[0] * v1[0] + v1[1] * v1[1]) + (v1[2] * v1[2] + v1[3] * v1[3]);
                    bool dorope = false; int i0 = 0;
                    if (MODE == 2) { const int hc = col % 192; dorope = (!isctx) && (hc >= 128); i0 = (hc - 128) >> 1; }
                    if (MODE == 5) { dorope = (!isctx) && (col < 2304); i0 = (col & 63) >> 1; }
                    if (MODE == 1) { dorope = (!isctx) && (pn == 4) && (col < 1088); i0 = (col - 1024) >> 1; }
                    if (MODE == 1 || MODE == 2 || MODE == 5) {
                        if (dorope) {
                            const float* tb = (i0 < 16) ? (rtab + ((t >> 6) * 16 + i0) * 2) : (ctab + ((t & 63) * 16 + (i0 - 16)) * 2);
                            const f32x4 c0 = *(const f32x4*)tb, c1 = *(const f32x4*)(tb + 4);
                            f32x4 w0, w1;
                            w0[0] = v0[0] * c0[0] - v0[1] * c0[1]; w0[1] = v0[0] * c0[1] + v0[1] * c0[0];
                            w0[2] = v0[2] * c0[2] - v0[3] * c0[3]; w0[3] = v0[2] * c0[3] + v0[3] * c0[2];
                            w1[0] = v1[0] * c1[0] - v1[1] * c1[1]; w1[1] = v1[0] * c1[1] + v1[1] * c1[0];
                            w1[2] = v1[2] * c1[2] - v1[3] * c1[3]; w1[3] = v1[2] * c1[3] + v1[3] * c1[2];
                            v0 = w0; v1 = w1;
                        }
                    }
                    if (MODE == 4) {
#pragma unroll
                        for (int e = 0; e < 4; ++e) { const float a = fmaxf(v0[e], 0.f), b = fmaxf(v1[e], 0.f); v0[e] = a * a; v1[e] = b * b; }
                    }
                    u32x4 w; w.x = cvt_pk_bf16(v0[0], v0[1]); w.y = cvt_pk_bf16(v0[2], v0[3]); w.z = cvt_pk_bf16(v1[0], v1[1]); w.w = cvt_pk_bf16(v1[2], v1[3]);
                    if (MODE == 1 && pn == 4) { if (col < 1088) *(u32x4*)(KR + (size_t)row * 64 + (col - 1024)) = w; }
                    else *(u32x4*)(O + (size_t)row * ldc + col) = w;
                }
                if (MODE == 0 || MODE == 1) {
                    if (MODE == 0 || pn < 4) {
                        sq += __shfl_xor(sq, 16); sq += __shfl_xor(sq, 32);
                        if (fq == 0) atomicAdd(ssq + (MODE == 1 ? (size_t)(pn >> 1) * NROW : (size_t)0) + row, sq);
                    }
                }
            }
    }
};

template <class Epi, class Sched, bool ALIGN_EPI = false, bool SP2 = false>
__device__ __forceinline__ void gemm_phase(PG8_LAS unsigned char* lds, const Gemm g, const Sched& S, const Epi& E, const int wave_) {
    const int wid = wave_, lane = lane_id_v(), tid = wid * 64 + lane, wr = wid >> 2, wc = wid & 3, fr = lane & 15, fq = lane >> 4;
    const int K = g.K, nt = K / BK, lda = g.lda, ldb = g.ldb;
    unsigned voffA[2], voffB[2];
#pragma unroll
    for (int i = 0; i < 2; ++i) { int R, C; stage_rc(tid * 16 + i * 8192, R, C); const int Rb = Epi::PERM ? ((R & ~31) + perm32(R & 31)) : R;
        voffA[i] = (unsigned)(R * lda + C) * 2u; voffB[i] = (unsigned)(Rb * ldb + C) * 2u; }
    const size_t kstep = (size_t)(BK * 2);
    const size_t hstepA = (size_t)HALF * lda * 2, hstepB = (size_t)HALF * ldb * 2;
    const size_t tstepA = 2 * hstepA, tstepB = 2 * hstepB;
    const unsigned ldsw = (unsigned)wid * 1024u;
    const int aoff = lds_byte(wr * 64 + fr, fq * 8), boff = lds_byte(wc * 32 + fr, fq * 8);
#define PG8_SA(b, h) (((b) * 2 + (h)) * HTB)
#define PG8_SB(b, h) ((4 + (b) * 2 + (h)) * HTB)
#define PG8_STAGE(bufoff, gbase, voff) do { _Pragma("unroll") for (int _i = 0; _i < 2; ++_i) \
        __builtin_amdgcn_global_load_lds((const unsigned*)((const char*)(gbase) + (voff)[_i]), (PG8_LAS unsigned*)(lds + (bufoff) + ldsw + _i * 8192), 16, 0, 0); } while (0)
#define PG8_LDA(dst, b, h) do { _Pragma("unroll") for (int m = 0; m < 4; ++m) _Pragma("unroll") for (int k = 0; k < 2; ++k) dst[m][k] = *(const PG8_LAS bf16x8*)(lds + PG8_SA(b, h) + aoff + m * 2048 + k * 1024); } while (0)
#define PG8_LDB(dst, b, h) do { _Pragma("unroll") for (int n = 0; n < 2; ++n) _Pragma("unroll") for (int k = 0; k < 2; ++k) dst[n][k] = *(const PG8_LAS bf16x8*)(lds + PG8_SB(b, h) + boff + n * 2048 + k * 1024); } while (0)
#define PG8_MMA(ai, bj, At, Bt) do { __builtin_amdgcn_s_setprio(1); _Pragma("unroll") for (int m = 0; m < 4; ++m) _Pragma("unroll") for (int n = 0; n < 2; ++n) _Pragma("unroll") for (int k = 0; k < 2; ++k) \
        acc[ai][bj][m][n] = __builtin_amdgcn_mfma_f32_16x16x32_bf16(Bt[n][k], At[m][k], acc[ai][bj][m][n], 0, 0, 0); __builtin_amdgcn_s_setprio(0); } while (0)
#define PG8_WAIT_V(n) asm volatile("s_waitcnt vmcnt(" #n ")" ::: "memory")
#define PG8_WAIT_L(n) asm volatile("s_waitcnt lgkmcnt(" #n ")" ::: "memory")
#define PG8_BAR __builtin_amdgcn_s_barrier()
#define PG8_SCHED __builtin_amdgcn_sched_barrier(0)
    Unit cur, nxt; int ui = 0;
    if (!S.next(0, cur)) return;
    f32x4 acc[2][2][4][2];
#pragma unroll
    for (int a = 0; a < 2; ++a)
#pragma unroll
        for (int b = 0; b < 2; ++b)
#pragma unroll
            for (int m = 0; m < 4; ++m)
#pragma unroll
                for (int n = 0; n < 2; ++n) acc[a][b][m][n] = (f32x4){0.f, 0.f, 0.f, 0.f};
    bf16x8 At[4][2], B0[2][2], B1[2][2];
    const char* cA = (const char*)g.A + (size_t)cur.pm * tstepA + (size_t)cur.kc * K * 2; const char* cB = (const char*)g.Bt + (size_t)cur.pn * tstepB + (size_t)cur.kc * K * 2;
    S.a_ready(cur);
    if constexpr (SP2) {
        PG8_STAGE(PG8_SB(0, 0), cB, voffB); PG8_STAGE(PG8_SB(0, 1), cB + hstepB, voffB); PG8_STAGE(PG8_SA(0, 0), cA, voffA); PG8_STAGE(PG8_SA(0, 1), cA + hstepA, voffA);
        if (wr == 1) PG8_BAR;
        PG8_WAIT_V(2); PG8_BAR;
        PG8_STAGE(PG8_SB(1, 0), cB + kstep, voffB); PG8_STAGE(PG8_SA(1, 0), cA + kstep, voffA); PG8_STAGE(PG8_SB(1, 1), cB + hstepB + kstep, voffB);
        PG8_WAIT_V(6); PG8_BAR;
    } else {
        PG8_STAGE(PG8_SB(0, 0), cB, voffB); PG8_STAGE(PG8_SA(0, 0), cA, voffA); PG8_STAGE(PG8_SB(0, 1), cB + hstepB, voffB); PG8_STAGE(PG8_SA(0, 1), cA + hstepA, voffA);
        if (wr == 1) PG8_BAR;
        PG8_WAIT_V(4); PG8_BAR;
        PG8_STAGE(PG8_SB(1, 0), cB + kstep, voffB); PG8_STAGE(PG8_SA(1, 0), cA + kstep, voffA); PG8_STAGE(PG8_SB(1, 1), cB + hstepB + kstep, voffB);
        PG8_WAIT_V(6); PG8_BAR;
    }
    for (;;) {
        const bool has_next = S.next(ui + 1, nxt);
        const char* nA = has_next ? (const char*)g.A + (size_t)nxt.pm * tstepA + (size_t)nxt.kc * K * 2 : cA; const char* nB = has_next ? (const char*)g.Bt + (size_t)nxt.pn * tstepB + (size_t)nxt.kc * K * 2 : cB;
        for (int t = 0; t < nt; t += 2) {
            const bool last = (t == nt - 2);
            const char* a1 = cA + (size_t)(t + 1) * kstep;
            const char* a2 = last ? nA : cA + (size_t)(t + 2) * kstep; const char* b2 = last ? nB : cB + (size_t)(t + 2) * kstep;
            const char* a3 = a2 + kstep; const char* b3 = b2 + kstep;
            if (last && has_next) S.a_ready(nxt);
            if constexpr (SP2) {
            PG8_LDB(B0, 0, 0); PG8_LDB(B1, 0, 1); PG8_SCHED; PG8_LDA(At, 0, 0); PG8_STAGE(PG8_SA(1, 1), a1 + hstepA, voffA);
            PG8_WAIT_V(8); PG8_WAIT_L(0); PG8_BAR; PG8_MMA(0, 0, At, B0); PG8_MMA(0, 1, At, B1); PG8_BAR; PG8_SCHED;
            PG8_LDA(At, 0, 1); PG8_STAGE(PG8_SB(0, 0), b2, voffB); PG8_STAGE(PG8_SB(0, 1), b2 + hstepB, voffB); PG8_STAGE(PG8_SA(0, 0), a2, voffA);
            PG8_WAIT_V(8); PG8_WAIT_L(0); PG8_BAR; PG8_MMA(1, 0, At, B0); PG8_MMA(1, 1, At, B1); PG8_BAR; PG8_SCHED;
            PG8_LDB(B0, 1, 0); PG8_LDB(B1, 1, 1); PG8_SCHED; PG8_LDA(At, 1, 0); PG8_STAGE(PG8_SA(0, 1), a2 + hstepA, voffA);
            PG8_WAIT_V(8); PG8_WAIT_L(0); PG8_BAR; PG8_MMA(0, 0, At, B0); PG8_MMA(0, 1, At, B1); PG8_BAR; PG8_SCHED;
            PG8_LDA(At, 1, 1); PG8_STAGE(PG8_SB(1, 0), b3, voffB); PG8_STAGE(PG8_SB(1, 1), b3 + hstepB, voffB); PG8_STAGE(PG8_SA(1, 0), a3, voffA);
            PG8_WAIT_V(8); PG8_WAIT_L(0); PG8_BAR; PG8_MMA(1, 0, At, B0); PG8_MMA(1, 1, At, B1); PG8_BAR; PG8_SCHED;
            } else {
            PG8_LDB(B0, 0, 0); PG8_SCHED; PG8_LDA(At, 0, 0); PG8_STAGE(PG8_SA(1, 1), a1 + hstepA, voffA);
            PG8_WAIT_L(8); PG8_BAR; PG8_WAIT_L(0); PG8_MMA(0, 0, At, B0); PG8_BAR; PG8_SCHED;
            PG8_LDB(B1, 0, 1); PG8_STAGE(PG8_SB(0, 0), b2, voffB);
            PG8_BAR; PG8_WAIT_L(0); PG8_MMA(0, 1, At, B1); PG8_BAR;
            PG8_LDA(At, 0, 1); PG8_STAGE(PG8_SA(0, 0), a2, voffA);
            PG8_BAR; PG8_WAIT_L(0); PG8_MMA(1, 0, At, B0); PG8_BAR; PG8_SCHED;
            PG8_STAGE(PG8_SB(0, 1), b2 + hstepB, voffB);
            PG8_WAIT_V(6); PG8_BAR; PG8_MMA(1, 1, At, B1); PG8_BAR;
            PG8_LDB(B0, 1, 0); PG8_SCHED; PG8_LDA(At, 1, 0); PG8_STAGE(PG8_SA(0, 1), a2 + hstepA, voffA);
            PG8_WAIT_L(8); PG8_BAR; PG8_WAIT_L(0); PG8_MMA(0, 0, At, B0); PG8_BAR; PG8_SCHED;
            PG8_LDB(B1, 1, 1); PG8_STAGE(PG8_SB(1, 0), b3, voffB);
            PG8_BAR; PG8_WAIT_L(0); PG8_MMA(0, 1, At, B1); PG8_BAR;
            PG8_LDA(At, 1, 1); PG8_STAGE(PG8_SA(1, 0), a3, voffA);
            PG8_BAR; PG8_WAIT_L(0); PG8_MMA(1, 0, At, B0); PG8_BAR; PG8_SCHED;
            PG8_STAGE(PG8_SB(1, 1), b3 + hstepB, voffB);
            PG8_WAIT_V(6); PG8_BAR; PG8_MMA(1, 1, At, B1); PG8_BAR;
            }
        }
        if constexpr (ALIGN_EPI) { if (wr == 0) PG8_BAR; }
        if constexpr (!Epi::AFTER_DRAIN) { E(acc, cur, wr, wc, fr, fq); S.done(cur); }
        if (!has_next) break;
#pragma unroll
        for (int a = 0; a < 2; ++a)
#pragma unroll
            for (int b = 0; b < 2; ++b)
#pragma unroll
                for (int m = 0; m < 4; ++m)
#pragma unroll
                    for (int n = 0; n < 2; ++n) acc[a][b][m][n] = (f32x4){0.f, 0.f, 0.f, 0.f};
        cur = nxt; cA = nA; cB = nB; ++ui;
        if constexpr (ALIGN_EPI) { if (wr == 1) PG8_BAR; }
    }
    PG8_WAIT_V(0);
    if constexpr (!ALIGN_EPI) { if (wr == 0) PG8_BAR; }
    PG8_BAR;
    if constexpr (Epi::AFTER_DRAIN) { E.fused(acc, cur, wr, wc, fr, fq, lds, wid, lane); S.done(cur); }
#undef PG8_SA
#undef PG8_SB
#undef PG8_STAGE
#undef PG8_LDA
#undef PG8_LDB
#undef PG8_MMA
#undef PG8_WAIT_V
#undef PG8_WAIT_L
#undef PG8_BAR
#undef PG8_SCHED
}
}

namespace att {
typedef unsigned short bf16_t;
using bf16x8 = __attribute__((ext_vector_type(8))) short;
using s16x4  = __attribute__((ext_vector_type(4))) short;
using f32x16 = __attribute__((ext_vector_type(16))) float;
using u32x4  = __attribute__((ext_vector_type(4))) unsigned;
#define KSWZ(row, colB) ((row) * 256 + ((colB) ^ (((row) & 15) << 4)))
#define KSWZ64(row, colB) ((row) * 128 + ((colB) ^ ((((row) >> 1) & 7) << 4)))
#define SBAR() __builtin_amdgcn_sched_barrier(0)
__device__ __forceinline__ int crow(int r, int hi) { return (r & 3) + 8 * (r >> 2) + 4 * hi; }
__device__ __forceinline__ unsigned cvtpk(float lo, float hi) { unsigned r; asm volatile("v_cvt_pk_bf16_f32 %0, %1, %2" : "=v"(r) : "v"(lo), "v"(hi)); return r; }

__device__ __forceinline__ void partialSM(f32x16& p0, f32x16& p1, float& m_reg, float& alpha, const float C, const float THRS) {
  float pmax = p0[0];
#pragma unroll
  for (int r = 1; r < 16; ++r) pmax = fmaxf(pmax, p0[r]);
#pragma unroll
  for (int r = 0; r < 16; ++r) pmax = fmaxf(pmax, p1[r]);
  { auto rr = __builtin_amdgcn_permlane32_swap(__float_as_uint(pmax), __float_as_uint(pmax), false, false);
    pmax = fmaxf(__uint_as_float(rr[0]), __uint_as_float(rr[1])); }
  float mn;
  if (__builtin_expect(__all(pmax - m_reg <= THRS), 1)) { mn = m_reg; alpha = 1.f; }
  else { mn = fmaxf(m_reg, pmax); alpha = __builtin_amdgcn_exp2f((m_reg - mn) * C); m_reg = mn; }
  const float mnC = -mn * C;
#pragma unroll
  for (int r = 0; r < 16; ++r) p0[r] = fmaf(p0[r], C, mnC);
#pragma unroll
  for (int r = 0; r < 16; ++r) p1[r] = fmaf(p1[r], C, mnC);
#pragma unroll
  for (int r = 0; r < 16; ++r) p0[r] = __builtin_amdgcn_exp2f(p0[r]);
}
__device__ __forceinline__ void finishSM(f32x16& p0, f32x16& p1, float alpha, float& l_reg, bf16x8& pa0, bf16x8& pa1, bf16x8& pa2, bf16x8& pa3) {
#pragma unroll
  for (int r = 0; r < 16; ++r) p1[r] = __builtin_amdgcn_exp2f(p1[r]);
  float ps = 0;
#pragma unroll
  for (int r = 0; r < 16; ++r) ps += p0[r];
#pragma unroll
  for (int r = 0; r < 16; ++r) ps += p1[r];
  { auto rr = __builtin_amdgcn_permlane32_swap(__float_as_uint(ps), __float_as_uint(ps), false, false);
    ps = __uint_as_float(rr[0]) + __uint_as_float(rr[1]); }
  l_reg = l_reg * alpha + ps;
#define PK4(P, BASE, OUT) do { unsigned a0 = cvtpk(P[BASE + 0], P[BASE + 1]), a1 = cvtpk(P[BASE + 2], P[BASE + 3]);   \
    unsigned b0 = cvtpk(P[BASE + 4], P[BASE + 5]), b1 = cvtpk(P[BASE + 6], P[BASE + 7]);                              \
    auto r0 = __builtin_amdgcn_permlane32_swap(a0, b0, false, false); auto r1 = __builtin_amdgcn_permlane32_swap(a1, b1, false, false); \
    u32x4 w = {r0[0], r1[0], r0[1], r1[1]}; OUT = *reinterpret_cast<bf16x8*>(&w); } while (0)
  PK4(p0, 0, pa0); PK4(p0, 8, pa1); PK4(p1, 0, pa2); PK4(p1, 8, pa3);
#undef PK4
}
template <int DN>
__device__ __forceinline__ void qkt(f32x16& p0, f32x16& p1, const char* Kn, const char* Kr, const bf16x8* qr, const char* qrl, int r32, int hi) {
  p0 = f32x16{}; p1 = f32x16{};
  if constexpr (DN > 0) {
#pragma unroll
    for (int d0 = 0; d0 < DN / 16; ++d0) { const int cb = (d0 * 16 + hi * 8) * 2;
      bf16x8 b0 = *reinterpret_cast<const bf16x8*>(Kn + KSWZ(r32, cb));
      bf16x8 b1 = *reinterpret_cast<const bf16x8*>(Kn + KSWZ(32 + r32, cb));
      p0 = __builtin_amdgcn_mfma_f32_32x32x16_bf16(b0, qr[d0], p0, 0, 0, 0);
      p1 = __builtin_amdgcn_mfma_f32_32x32x16_bf16(b1, qr[d0], p1, 0, 0, 0); }
  }
#pragma unroll
  for (int d0 = 0; d0 < 4; ++d0) { const int cb = (d0 * 16 + hi * 8) * 2;
    bf16x8 b0 = *reinterpret_cast<const bf16x8*>(Kr + KSWZ64(r32, cb));
    bf16x8 b1 = *reinterpret_cast<const bf16x8*>(Kr + KSWZ64(32 + r32, cb));
    bf16x8 q; if constexpr (DN > 0) q = *reinterpret_cast<const bf16x8*>(qrl + d0 * 1024); else q = qr[d0];
    p0 = __builtin_amdgcn_mfma_f32_32x32x16_bf16(b0, q, p0, 0, 0, 0);
    p1 = __builtin_amdgcn_mfma_f32_32x32x16_bf16(b1, q, p1, 0, 0, 0); }
}
__device__ __forceinline__ void band_mask(f32x16& p0, f32x16& p1, int d) {
#pragma unroll
  for (int r = 0; r < 16; ++r) { const int v = d - ((r & 3) + 8 * (r >> 2));
    if (v > 128 || v < -128) p0[r] = -1e30f;
    if (v - 32 > 128 || v - 32 < -128) p1[r] = -1e30f; }
}
__device__ __forceinline__ int v_rd_base(int lane) { return ((lane & 3) << 3) | (((lane >> 2) & 3) << 6) | (((lane >> 4) & 1) << 5) | (((lane >> 5) & 1) << 8); }
template <int NCB> constexpr int v_rd_off(int d0, int ks, int half) { return d0 * 512 + ks * (2 * NCB * 512) + half * (NCB * 512); }
template <int OFF> __device__ __forceinline__ s16x4 tr_read(int vb) {
  s16x4 r; asm volatile("ds_read_b64_tr_b16 %0, %1 offset:%2" : "=&v"(r) : "v"(vb), "i"(OFF) : "memory"); return r;
}
template <int D0, int NCB> __device__ __forceinline__ void pv_one(f32x16& od, int vb, bf16x8 pa0, bf16x8 pa1, bf16x8 pa2, bf16x8 pa3) {
  const s16x4 l0 = tr_read<v_rd_off<NCB>(D0, 0, 0)>(vb), h0 = tr_read<v_rd_off<NCB>(D0, 0, 1)>(vb), l1 = tr_read<v_rd_off<NCB>(D0, 1, 0)>(vb), h1 = tr_read<v_rd_off<NCB>(D0, 1, 1)>(vb);
  const s16x4 l2 = tr_read<v_rd_off<NCB>(D0, 2, 0)>(vb), h2 = tr_read<v_rd_off<NCB>(D0, 2, 1)>(vb), l3 = tr_read<v_rd_off<NCB>(D0, 3, 0)>(vb), h3 = tr_read<v_rd_off<NCB>(D0, 3, 1)>(vb);
  asm volatile("s_waitcnt lgkmcnt(0)" ::: "memory"); SBAR();
#define PK(L, H) (bf16x8){L[0], L[1], L[2], L[3], H[0], H[1], H[2], H[3]}
  od = __builtin_amdgcn_mfma_f32_32x32x16_bf16(pa0, PK(l0, h0), od, 0, 0, 0);
  od = __builtin_amdgcn_mfma_f32_32x32x16_bf16(pa1, PK(l1, h1), od, 0, 0, 0);
  od = __builtin_amdgcn_mfma_f32_32x32x16_bf16(pa2, PK(l2, h2), od, 0, 0, 0);
  od = __builtin_amdgcn_mfma_f32_32x32x16_bf16(pa3, PK(l3, h3), od, 0, 0, 0);
#undef PK
}
template <int NCB> __device__ __forceinline__ void pv_all(f32x16* o, int vb, bf16x8 pa0, bf16x8 pa1, bf16x8 pa2, bf16x8 pa3) {
  pv_one<0, NCB>(o[0], vb, pa0, pa1, pa2, pa3); pv_one<1, NCB>(o[1], vb, pa0, pa1, pa2, pa3);
  if constexpr (NCB == 4) { pv_one<2, NCB>(o[2], vb, pa0, pa1, pa2, pa3); pv_one<3, NCB>(o[3], vb, pa0, pa1, pa2, pa3); }
}

#define ATT_LAS __attribute__((address_space(3)))
template <int DN, int DV, bool MASK>
__device__ __forceinline__ void attn_unit(const bf16_t* __restrict__ Qb, const int ldq, const bf16_t* __restrict__ Kn, const int ldkn,
    const bf16_t* __restrict__ Kr, const int ldkr, const bf16_t* __restrict__ Vp, const int ldv, bf16_t* __restrict__ Ob, const int ldo,
    const int NT, const int n1, const int r1, const int r2, const int qpos0, const int kt2,
    const float C, const float THRS, const float sinkl2, char* lds, ATT_LAS unsigned char* ldsL, const int wave_) {
  constexpr int NQR = DN > 0 ? DN / 16 : 4, NCB = DV / 32, VB = 64 * DV * 2, KNB = 64 * DN * 2, KRB = 64 * 64 * 2, BUF = VB + KNB + KRB;
  constexpr int NVC = VB / 8192, NKC = KNB / 8192;
  const int wid = wave_, lane = lane_id_v(), r32 = lane & 31, hi = lane >> 5;
  char* Vl = lds; char* Knl = lds + VB; char* Krl = lds + VB + KNB;
  float* wsf = (float*)(lds + 3 * BUF) + wid * 64; float* li_l = wsf; float* al_l = wsf + 32;
  float m_reg = -1e30f, l_reg = 0; f32x16 o[NCB] = {}; bf16x8 qr[NQR];
  const bf16_t* Qw = Qb + (long)(wid * 32 + r32) * ldq + hi * 8;
#pragma unroll
  for (int d0 = 0; d0 < NQR; ++d0) qr[d0] = *reinterpret_cast<const bf16x8*>(Qw + d0 * 16);
  char* qrl = lds + 3 * BUF + 2048 + wid * 4096 + lane * 16;
  if constexpr (DN > 0) {
#pragma unroll
    for (int d0 = 0; d0 < 4; ++d0) *reinterpret_cast<bf16x8*>(qrl + d0 * 1024) = *reinterpret_cast<const bf16x8*>(Qw + DN + d0 * 16);
  }
  int offV[NVC], offK[NKC > 0 ? NKC : 1], offR;
#pragma unroll
  for (int i = 0; i < NVC; ++i) { const int ch = wid * NVC + i, sub = ch * 2 + (lane >> 5), kk = (sub / NCB) * 8 + ((lane & 31) >> 2), col = (sub % NCB) * 32 + (lane & 3) * 8;
    const int k = (kk & ~0xC) | ((kk & 4) << 1) | ((kk & 8) >> 1); offV[i] = k * ldv + col; }
#pragma unroll
  for (int i = 0; i < NKC; ++i) { const int ch = wid * NKC + i, row = ch * 4 + (lane >> 4), cb = ((lane & 15) * 16) ^ ((row & 15) << 4); offK[i] = row * ldkn + (cb >> 1); }
  { const int row = wid * 8 + (lane >> 3), cb = ((lane & 7) * 16) ^ (((row >> 1) & 7) << 4); offR = row * ldkr + (cb >> 1); }
  const int vb0 = (int)(uintptr_t)Vl + v_rd_base(lane);
  const int qd = qpos0 + wid * 32 + r32 - 4 * hi;
#define TROW(j) ((j) < n1 ? r1 + 64 * (j) : r2 + 64 * ((j) - n1))
#define DMA(j, b) do { const long row0_ = TROW(j); \
    _Pragma("unroll") for (int i_ = 0; i_ < NVC; ++i_) __builtin_amdgcn_global_load_lds((const unsigned*)(Vp + row0_ * ldv + offV[i_]), (ATT_LAS unsigned*)(ldsL + (b) + (wid * NVC + i_) * 1024), 16, 0, 0); \
    _Pragma("unroll") for (int i_ = 0; i_ < NKC; ++i_) __builtin_amdgcn_global_load_lds((const unsigned*)(Kn + row0_ * ldkn + offK[i_]), (ATT_LAS unsigned*)(ldsL + (b) + VB + (wid * NKC + i_) * 1024), 16, 0, 0); \
    __builtin_amdgcn_global_load_lds((const unsigned*)(Kr + row0_ * ldkr + offR), (ATT_LAS unsigned*)(ldsL + (b) + VB + KNB + wid * 1024), 16, 0, 0); } while (0)
#define WAITV() asm volatile("s_waitcnt vmcnt(0)" ::: "memory")
#define SCORE(P0, P1, b, j) do { qkt<DN>(P0, P1, Knl + (b), Krl + (b), qr, qrl, r32, hi); \
    if constexpr (MASK) { if ((j) >= n1) band_mask(P0, P1, qd - (kt2 + 64 * ((j) - n1))); } } while (0)
#define RESC(a) do { if (__any((a) < 1.f)) { const int l_ = lane_id_v(); if (l_ < 32) al_l[l_] = (a); asm volatile("s_waitcnt lgkmcnt(0)" ::: "memory"); \
    _Pragma("unroll") for (int d = 0; d < NCB; ++d) _Pragma("unroll") for (int r = 0; r < 16; ++r) o[d][r] *= al_l[crow(r, l_ >> 5)]; } } while (0)
#define ROT() do { const int t_ = bp; bp = bc; bc = bn; bn = t_; } while (0)
  f32x16 pA0, pA1, pB0, pB1; float alA, alB; bf16x8 pa0, pa1, pa2, pa3;
  int bp = 0, bc = BUF, bn = 2 * BUF;
  DMA(0, 0); DMA(1, BUF); WAITV(); __syncthreads();
  SCORE(pA0, pA1, 0, 0); partialSM(pA0, pA1, m_reg, alA, C, THRS);
  for (int j = 1; j + 1 < NT; j += 2) {
    DMA(j + 1, bn);
    SBAR(); SCORE(pB0, pB1, bc, j);
    finishSM(pA0, pA1, alA, l_reg, pa0, pa1, pa2, pa3); SBAR();
    pv_all<NCB>(o, vb0 + bp, pa0, pa1, pa2, pa3); partialSM(pB0, pB1, m_reg, alB, C, THRS);
    RESC(alB); WAITV(); __syncthreads(); ROT();
    DMA(j + 2, bn);
    SBAR(); SCORE(pA0, pA1, bc, j + 1);
    finishSM(pB0, pB1, alB, l_reg, pa0, pa1, pa2, pa3); SBAR();
    pv_all<NCB>(o, vb0 + bp, pa0, pa1, pa2, pa3); partialSM(pA0, pA1, m_reg, alA, C, THRS);
    RESC(alA); WAITV(); __syncthreads(); ROT();
  }
  SBAR(); SCORE(pB0, pB1, bc, NT - 1);
  finishSM(pA0, pA1, alA, l_reg, pa0, pa1, pa2, pa3); SBAR();
  pv_all<NCB>(o, vb0 + bp, pa0, pa1, pa2, pa3); partialSM(pB0, pB1, m_reg, alB, C, THRS);
  RESC(alB);
  finishSM(pB0, pB1, alB, l_reg, pa0, pa1, pa2, pa3); SBAR();
  pv_all<NCB>(o, vb0 + bc, pa0, pa1, pa2, pa3);
  l_reg += __builtin_amdgcn_exp2f(sinkl2 - m_reg * C);
  const int lane2 = lane_id_v(), r32e = lane2 & 31, hie = lane2 >> 5;
  if (hie == 0) li_l[r32e] = l_reg; asm volatile("s_waitcnt lgkmcnt(0)" ::: "memory");
  float rli[16];
#pragma unroll
  for (int r = 0; r < 16; ++r) rli[r] = __builtin_amdgcn_rcpf(li_l[crow(r, hie)]);
  bf16_t* Ow = Ob + (long)(wid * 32) * ldo;
#pragma unroll
  for (int r = 0; r < 16; ++r) { const int orow = crow(r, hie);
#pragma unroll
    for (int d0 = 0; d0 < NCB; ++d0) Ow[(long)orow * ldo + d0 * 32 + r32e] = (bf16_t)(cvtpk(o[d0][r] * rli[r], 0.f) & 0xffffu); }
  __syncthreads();
#undef TROW
#undef DMA
#undef WAITV
#undef SCORE
#undef RESC
#undef ROT
}
}

constexpr size_t MiB = 1u << 20;
constexpr size_t WS_MOD = 0;
constexpr size_t WS_SSQ = 512 * 1024;
constexpr size_t WS_ROPE = 1792 * 1024;
constexpr size_t CTL_ZERO_BYTES = 2 * MiB;
constexpr size_t WS_XC = 2 * MiB;
constexpr size_t WS_WIN = 8 * MiB, WS_WQB = 13 * MiB, WS_WKVB = 16 * MiB, WS_WOM = 20 * MiB, WS_WF1 = 28 * MiB, WS_WF2 = 92 * MiB, WS_WQKV = 156 * MiB, WS_WOS = 166 * MiB;
constexpr size_t WS_S1 = 176 * MiB;
constexpr size_t WS_S2 = 306 * MiB;
constexpr size_t WS_G = 436 * MiB;
constexpr size_t WS_Q = WS_G, WS_KV = WS_G + 196 * MiB, WS_KR = WS_G + 456 * MiB;
constexpr size_t WS_PART = WS_G + 520 * MiB;
constexpr size_t WS_END = WS_PART + 64 * MiB;
static_assert((size_t)NROW * 2048 * 2 == 130 * MiB && WS_SSQ + 8 * (size_t)NROW * 4 <= WS_ROPE && (size_t)NROW * NQ * 2 <= 196 * MiB && (size_t)NROW * NKV * 2 <= 260 * MiB, "ws map");

#define LAS __attribute__((address_space(3)))
typedef unsigned short bf16_t;
typedef float f32x4 __attribute__((ext_vector_type(4)));
typedef unsigned u32x4 __attribute__((ext_vector_type(4)));
typedef unsigned u32x2 __attribute__((ext_vector_type(2)));
constexpr int LDS_BYTES = 3 * 40960 + 2048 + 32768;
constexpr int N_PHASES = 17;
#ifndef PROBE_PH
#define PROBE_PH -1
#endif
#ifndef PROBE_PH2
#define PROBE_PH2 -1
#endif
#if PROBE_PH >= 0
#define rep_PROBE0 (rep_ != 0)
#define REP(k) for (int rep_ = 0; rep_ < ((((PROBE_PH) >> (k)) & 1) ? 2 : 1); ++rep_)
#define SSQP(i) (rep_ ? SSQ + 6 * NROW : SSQ + (i) * NROW)
#else
#define rep_PROBE0 false
#define REP(k)
#define SSQP(i) (SSQ + (i) * NROW)
#endif

struct Args { const float* in[18]; float* out; unsigned char* ws; int ph_lo, ph_hi; };

__device__ __forceinline__ float wave_sum(float v) {
#pragma unroll
  for (int o = 1; o < 64; o <<= 1) v += __shfl_xor(v, o);
  return v;
}
__device__ __forceinline__ unsigned pk2(float lo, float hi) { unsigned r; asm volatile("v_cvt_pk_bf16_f32 %0, %1, %2" : "=v"(r) : "v"(lo), "v"(hi)); return r; }

__device__ __forceinline__ int dest_row(int mode, int n) {
  if (mode == 1) { if (n < 1024) return n; const int j = n - 1024; return 1024 + (((j & 31) << 1) | (j >> 5)); }
  if (mode == 2) { const int h = n / 192, d = n - h * 192; if (d < 128) return n; const int j = d - 128; return h * 192 + 128 + (((j & 31) << 1) | (j >> 5)); }
  if (mode == 3) { if (n >= 2304) return n; const int d = n & 63; return (n & ~63) + (((d & 31) << 1) | (d >> 5)); }
  return n;
}
__device__ __forceinline__ void tr_item(const float* __restrict__ W, int K, int N, bf16_t* __restrict__ WT, const float* __restrict__ ks, int mode, LAS float* scr, int item, int lane) {
  const int nkb = K / 64, nb = item / nkb, kb = item - nb * nkb, k0 = 64 * kb, n0 = 32 * nb;
  float wv[32];
#pragma unroll
  for (int i = 0; i < 32; ++i) wv[i] = W[(size_t)(k0 + 2 * i + (lane >> 5)) * N + n0 + (lane & 31)];
  if (ks) {
#pragma unroll
    for (int i = 0; i < 32; ++i) wv[i] *= ks[k0 + 2 * i + (lane >> 5)];
  }
#pragma unroll
  for (int i = 0; i < 32; ++i) scr[(2 * i + (lane >> 5)) * 33 + (lane & 31)] = wv[i];
  asm volatile("s_waitcnt lgkmcnt(0)" ::: "memory");
  const int c = lane & 7;
#pragma unroll
  for (int j = 0; j < 4; ++j) { const int n = (lane >> 3) + 8 * j; const LAS float* s = scr + (8 * c) * 33 + n;
    u32x4 o; o.x = pk2(s[0 * 33], s[1 * 33]); o.y = pk2(s[2 * 33], s[3 * 33]); o.z = pk2(s[4 * 33], s[5 * 33]); o.w = pk2(s[6 * 33], s[7 * 33]);
    *(u32x4*)(WT + (size_t)dest_row(mode, n0 + n) * K + k0 + 8 * c) = o; }
  asm volatile("s_waitcnt lgkmcnt(0)" ::: "memory");
}

__device__ __forceinline__ float silu_f(float x) { return x / (1.f + __expf(-x)); }

constexpr int TT0 = 16 * 9, TT1 = 4 * 24, TT2 = 4 * 32, TT3 = 16 * 16, TT4 = 16 * 64, TT6 = 64 * 16, TT8 = 16 * 20, TT9 = 16 * 16;
constexpr int N_TILES = TT0 + TT1 + TT2 + TT3 + 2 * TT4 + 2 * TT6 + TT8 + TT9;
__device__ __forceinline__ void tr_tile(const float* __restrict__ W, int K, int N, bf16_t* __restrict__ WT, const float* __restrict__ ks, int mode, LAS unsigned char* lds, int tile, int tid) {
  constexpr int PITCH = 264;
  const int nnb = (N + 127) / 128, kb = tile / nnb, nb = tile - kb * nnb, k0 = kb * 128, n0 = nb * 128;
  const int c4 = (tid & 31) * 4, r0 = tid >> 5; const bool colok = (n0 + c4) < N;
  f32x4 v[8];
#pragma unroll
  for (int p = 0; p < 8; ++p) v[p] = colok ? *(const f32x4*)(W + (size_t)(k0 + r0 + 16 * p) * N + n0 + c4) : (f32x4){0.f, 0.f, 0.f, 0.f};
#pragma unroll
  for (int p = 0; p < 8; ++p) { const int r = r0 + 16 * p; f32x4 x = v[p]; if (ks) x = x * ks[k0 + r];
    u32x2 w; w.x = pk2(x[0], x[1]); w.y = pk2(x[2], x[3]); *(LAS u32x2*)(lds + r * PITCH + c4 * 2) = w; }
  __syncthreads();
#pragma unroll
  for (int p = 0; p < 4; ++p) { const int q = tid + 512 * p, c16 = q & 15, n = q >> 4;
    if (n0 + n < N) { const LAS unsigned short* s = (const LAS unsigned short*)(lds + (8 * c16) * PITCH + 2 * n);
      u32x4 o;
      o.x = (unsigned)s[0 * (PITCH / 2)] | ((unsigned)s[1 * (PITCH / 2)] << 16); o.y = (unsigned)s[2 * (PITCH / 2)] | ((unsigned)s[3 * (PITCH / 2)] << 16);
      o.z = (unsigned)s[4 * (PITCH / 2)] | ((unsigned)s[5 * (PITCH / 2)] << 16); o.w = (unsigned)s[6 * (PITCH / 2)] | ((unsigned)s[7 * (PITCH / 2)] << 16);
      *(u32x4*)(WT + (size_t)dest_row(mode, n0 + n) * K + k0 + 8 * c16) = o; } }
  __syncthreads();
}
__device__ __forceinline__ void tr_dispatch(const Args& a, int it, LAS unsigned char* lds, int tid) {
  unsigned char* ws = a.ws;
  int r = it; const float* W; int K, N, mode = 0; const float* ks = nullptr; bf16_t* dst;
  if (r < TT0) { W = a.in[9]; K = 2048; N = 1088; mode = 1; dst = (bf16_t*)(ws + WS_WIN); }
  else if ((r -= TT0) < TT1) { W = a.in[12]; K = 512; N = 3072; mode = 2; ks = a.in[10]; dst = (bf16_t*)(ws + WS_WQB); }
  else if ((r -= TT1) < TT2) { W = a.in[13]; K = 512; N = 4096; ks = a.in[11]; dst = (bf16_t*)(ws + WS_WKVB); }
  else if ((r -= TT2) < TT3) { W = a.in[14]; K = 2048; N = 2048; dst = (bf16_t*)(ws + WS_WOM); }
  else if ((r -= TT3) < 2 * TT4) { const int l = r / TT4; r -= l * TT4; W = a.in[7] + (size_t)l * 2048 * 8192; K = 2048; N = 8192; dst = (bf16_t*)(ws + WS_WF1) + (size_t)l * 2048 * 8192; }
  else if ((r -= 2 * TT4) < 2 * TT6) { const int l = r / TT6; r -= l * TT6; W = a.in[8] + (size_t)l * 2048 * 8192; K = 8192; N = 2048; dst = (bf16_t*)(ws + WS_WF2) + (size_t)l * 2048 * 8192; }
  else if ((r -= 2 * TT6) < TT8) { W = a.in[15]; K = 2048; N = 2560; mode = 3; dst = (bf16_t*)(ws + WS_WQKV); }
  else { r -= TT8; W = a.in[17]; K = 2048; N = 2048; dst = (bf16_t*)(ws + WS_WOS); }
  tr_tile(W, K, N, dst, ks, mode, lds, r, tid);
}

__device__ __forceinline__ void p0_prologue(const Args& a, LAS unsigned char* lds, int gw, int NGW, int wave, int lane, bool only_transposes) {
  unsigned char* ws = a.ws;
  { const int tid = wave * 64 + lane;
    for (int it = (int)blockIdx.x; it < N_TILES; it += (int)gridDim.x) tr_dispatch(a, it, lds, tid); }
  if (only_transposes) return;
  float* MOD = (float*)(ws + WS_MOD);
  for (int it = gw; it < 2 * 48 * 64; it += NGW) {
    const int kc = it & 63, cb = (it >> 6) % 48, l = it / (64 * 48);
    const int n0 = cb * 256 + lane * 4, k0 = kc * 32;
    const float* Wm = a.in[4] + (size_t)l * 2048 * 12288 + n0;
    f32x4 a0 = {0.f, 0.f, 0.f, 0.f}, a1 = a0, a2 = a0;
#pragma unroll 16
    for (int k = 0; k < 32; ++k) { const int kk = k0 + k;
      const float s0 = silu_f(a.in[1][kk]), s1 = silu_f(a.in[1][2048 + kk]), s2 = silu_f(a.in[3][kk]);
      const f32x4 w = *(const f32x4*)(Wm + (size_t)kk * 12288);
      a0 += w * s0; a1 += w * s1; a2 += w * s2; }
    if (kc == 0) { const f32x4 b = *(const f32x4*)(a.in[5] + l * 12288 + n0); a0 += b; a1 += b; a2 += b; }
    float* mo = MOD + (size_t)(l * 3) * 12288 + n0;
#pragma unroll
    for (int e = 0; e < 4; ++e) { atomicAdd(mo + e, a0[e]); atomicAdd(mo + 12288 + e, a1[e]); atomicAdd(mo + 2 * 12288 + e, a2[e]); }
  }
  float* tab = (float*)(ws + WS_ROPE);
  for (int e = gw * 64 + lane; e < 320 * 16; e += NGW * 64) {
    const int i = e & 15, pos = e >> 4; const float p = (float)(pos < 256 ? pos : pos - 256);
    const float freq = exp2f(-(float)i * 0.8304820237218406f); const float ang = p * freq;
    tab[e * 2] = cosf(ang); tab[e * 2 + 1] = sinf(ang);
  }
}

__device__ __forceinline__ f32x4 ldf4(const float* base, unsigned boff) { return *(const f32x4*)((const char*)base + boff); }
__device__ __forceinline__ void stf4(float* base, unsigned boff, f32x4 v) { *(f32x4*)((char*)base + boff) = v; }
template <bool UPD, bool DOH, int NKC>
__device__ __forceinline__ void norm_rows(const int row0, const int nrows, const float* xin_lat, const float* xin_ctx, float* xout_lat, float* xout_ctx, const bf16_t* Y, const float* ssq,
    const float* gA, const float* gateM, const float* gB, const float* scM, const float* shM, bf16_t* H, int lane, const float* part) {
  const int b = row0 / TB, rb = row0 - b * TB; const bool isctx = rb < CTXL;
  const int v = isctx ? 2 : b;
  const size_t xoff = isctx ? (size_t)(b * CTXL + rb) * DM : (size_t)(b * SEQ + rb - CTXL) * DM;
  const float* xin = (isctx ? xin_ctx : xin_lat) + xoff;
  float* xout = UPD ? ((isctx ? xout_ctx : xout_lat) + xoff) : nullptr;
  const int lane_ = lane_id_v();
  const unsigned lo = (unsigned)lane_ * 16u, lo2 = (unsigned)lane_ * 8u;
  f32x4 GA[8], GB[8], SH[8];
#pragma unroll
  for (int j = 0; j < 8; ++j) { const unsigned o = lo + 1024u * j;
    if (UPD) GA[j] = ldf4(gateM + v * 12288, o) * ldf4(gA, o);
    if (DOH) { GB[j] = ldf4(gB, o) * (ldf4(scM + v * 12288, o) + 1.0f); SH[j] = ldf4(shM + v * 12288, o); } }
  f32x4 xn[8]; u32x2 yn[8];
#pragma unroll
  for (int j = 0; j < 8; ++j) { xn[j] = ldf4(xin, lo + 1024u * j); if (UPD && !(NKC > 0 && isctx)) yn[j] = *(const u32x2*)((const char*)(Y + (size_t)row0 * DM) + lo2 + 512u * j); }
  for (int rr = 0; rr < nrows; ++rr) {
    const int row = row0 + rr;
    f32x4 x[8]; u32x2 yc[8];
#pragma unroll
    for (int j = 0; j < 8; ++j) { x[j] = xn[j]; if (UPD) yc[j] = yn[j]; }
    if (rr + 1 < nrows) { const float* xr = xin + (size_t)(rr + 1) * DM;
#pragma unroll
      for (int j = 0; j < 8; ++j) { xn[j] = ldf4(xr, lo + 1024u * j); if (UPD && !(NKC > 0 && isctx)) yn[j] = *(const u32x2*)((const char*)(Y + (size_t)(row + 1) * DM) + lo2 + 512u * j); } }
    if (UPD && NKC > 0 && isctx) {
      f32x4 y[8]; float ys = 0.f; const float* pr = part + (size_t)(b * CTXL + rb + rr) * DM;
#pragma unroll
      for (int j = 0; j < 8; ++j) y[j] = ldf4(pr, lo + 1024u * j);
#pragma unroll 1
      for (int k = 1; k < NKC; ++k) { pr += (size_t)512 * DM;
#pragma unroll
        for (int j = 0; j < 8; ++j) y[j] += ldf4(pr, lo + 1024u * j); }
#pragma unroll
      for (int j = 0; j < 8; ++j) ys += (y[j][0] * y[j][0] + y[j][1] * y[j][1]) + (y[j][2] * y[j][2] + y[j][3] * y[j][3]);
      const float rinv = __builtin_amdgcn_rsqf(wave_sum(ys) * (1.0f / 2048.0f) + NORM_EPS);
      float* xo = xout + (size_t)rr * DM;
#pragma unroll
      for (int j = 0; j < 8; ++j) { x[j] += GA[j] * (y[j] * rinv); stf4(xo, lo + 1024u * j, x[j]); }
    } else if (UPD) {
      const float rinv = __builtin_amdgcn_rsqf(ssq[row] * (1.0f / 2048.0f) + NORM_EPS);
      float* xo = xout + (size_t)rr * DM;
#pragma unroll
      for (int j = 0; j < 8; ++j) { const u32x2 yb = yc[j];
        f32x4 y; y[0] = __uint_as_float(yb.x << 16); y[1] = __uint_as_float(yb.x & 0xffff0000u); y[2] = __uint_as_float(yb.y << 16); y[3] = __uint_as_float(yb.y & 0xffff0000u);
        x[j] += GA[j] * (y * rinv);
        stf4(xo, lo + 1024u * j, x[j]); }
    }
    if (DOH) {
      float ss = 0.f;
#pragma unroll
      for (int j = 0; j < 8; ++j) ss += (x[j][0] * x[j][0] + x[j][1] * x[j][1]) + (x[j][2] * x[j][2] + x[j][3] * x[j][3]);
      const float r = __builtin_amdgcn_rsqf(wave_sum(ss) * (1.0f / 2048.0f) + NORM_EPS);
      bf16_t* hr = H + (size_t)row * DM;
#pragma unroll
      for (int j = 0; j < 8; ++j) { const f32x4 h = x[j] * r * GB[j] + SH[j]; u32x2 w; w.x = pk2(h[0], h[1]); w.y = pk2(h[2], h[3]);
        *(u32x2*)((char*)hr + lo2 + 512u * j) = w; }
    }
  }
}
template <bool UPD, bool DOH, int NKC = 0>
__device__ __forceinline__ void norm_phase(const float* xin_lat, const float* xin_ctx, float* xout_lat, float* xout_ctx, const bf16_t* Y, const float* ssq,
    const float* gA, const float* gateM, const float* gB, const float* scM, const float* shM, bf16_t* H, bool skipctx, int gw, int NGW, int lane, const float* part = nullptr) {
  for (int ch = gw; ch < 2 * SEQ / 16; ch += NGW) { const int b = ch / (SEQ / 16), row0 = b * TB + CTXL + (ch - b * (SEQ / 16)) * 16;
    norm_rows<UPD, DOH, 0>(row0, 16, xin_lat, xin_ctx, xout_lat, xout_ctx, Y, ssq, gA, gateM, gB, scM, shM, H, lane, part); }
  if (!skipctx)
    for (int r = gw; r < 2 * CTXL; r += NGW) { const int b = r / CTXL, row0 = b * TB + (r - b * CTXL);
      norm_rows<UPD, DOH, NKC>(row0, 1, xin_lat, xin_ctx, xout_lat, xout_ctx, Y, ssq, gA, gateM, gB, scM, shM, H, lane, part); }
}

__global__ void __launch_bounds__(512, 2) mk_fwd(Args a) {
  extern __shared__ __attribute__((aligned(16))) unsigned char lds[];
  cg::grid_group grid = cg::this_grid();
  const int wave = __builtin_amdgcn_readfirstlane(threadIdx.x >> 6);
  const int G = gridDim.x, c = blockIdx.x, gw = c * 8 + wave, NGW = G * 8;
  LAS unsigned char* ldsL = (LAS unsigned char*)lds;
  unsigned char* ws = a.ws;
  const int lo = a.ph_lo, hi = a.ph_hi;
#define IN(k) (lo <= (k) && (k) < hi)
  unsigned* barw = (unsigned*)(ws + CTL_ZERO_BYTES - 256); unsigned bar_epoch = 0;
#define OWN_BAR() do { __builtin_amdgcn_fence(__ATOMIC_RELEASE, "workgroup"); __builtin_amdgcn_s_barrier(); bar_epoch += (unsigned)G; \
    if (wave == 0) { if (lane_id_v() == 0) { __builtin_amdgcn_fence(__ATOMIC_ACQUIRE, "workgroup"); __builtin_amdgcn_fence(__ATOMIC_RELEASE, "agent"); \
      __hip_atomic_fetch_add(barw, 1u, __ATOMIC_RELAXED, __HIP_MEMORY_SCOPE_AGENT); \
      while (__hip_atomic_load(barw, __ATOMIC_RELAXED, __HIP_MEMORY_SCOPE_AGENT) < bar_epoch) __builtin_amdgcn_s_sleep(1); \
      __builtin_amdgcn_fence(__ATOMIC_ACQUIRE, "agent"); __builtin_amdgcn_fence(__ATOMIC_RELEASE, "workgroup"); } } \
    __builtin_amdgcn_s_barrier(); __builtin_amdgcn_fence(__ATOMIC_ACQUIRE, "workgroup"); } while (0)
#define OWN_BAR_NF() do { __builtin_amdgcn_s_barrier(); bar_epoch += (unsigned)G; \
    if (wave == 0) { if (lane_id_v() == 0) { \
      __hip_atomic_fetch_add(barw, 1u, __ATOMIC_RELAXED, __HIP_MEMORY_SCOPE_AGENT); \
      while (__hip_atomic_load(barw, __ATOMIC_RELAXED, __HIP_MEMORY_SCOPE_AGENT) < bar_epoch) __builtin_amdgcn_s_sleep(1); } } \
    __builtin_amdgcn_s_barrier(); } while (0)
#define SEAM(k) do { if (IN(k) && IN((k) + 1)) { if ((k) == 0) grid.sync(); else { OWN_BAR(); if ((PROBE_PH >> 20) & 1) OWN_BAR(); if ((PROBE_PH >> 21) & 1) OWN_BAR_NF(); } } } while (0)
  float* MOD = (float*)(ws + WS_MOD); float* SSQ = (float*)(ws + WS_SSQ);
  const float* RT = (const float*)(ws + WS_ROPE); const float* CT = RT + 256 * 16 * 2;
  float* XC = (float*)(ws + WS_XC); float* PART = (float*)(ws + WS_PART);
  bf16_t* S1 = (bf16_t*)(ws + WS_S1); bf16_t* S2 = (bf16_t*)(ws + WS_S2);
  bf16_t* Qb = (bf16_t*)(ws + WS_Q); bf16_t* KVb = (bf16_t*)(ws + WS_KV); bf16_t* KRb = (bf16_t*)(ws + WS_KR); bf16_t* Gb = (bf16_t*)(ws + WS_G);
  const float* gn = a.in[6];
#define MODP(l, chunk) (MOD + (size_t)(l) * 3 * 12288 + (chunk) * 2048)
#define RUN_GEMM(MODE, Ap, lda_, Bp, N_, K_, skip, ...) do { pg8::Gemm g{Ap, Bp, NROW, N_, K_, lda_, K_}; pg8::RowSched S; S.init((skip) ? 128 : 130, (N_) / 256, G, c, (skip) ? 1 : 0); \
    pg8::Epi<MODE> E{__VA_ARGS__}; pg8::gemm_phase<pg8::Epi<MODE>, pg8::RowSched, true, true>(ldsL, g, S, E, wave); } while (0)
#define RUN_CTX_SPLIT(Ap, Bp, K_, NKC_) do { pg8::Gemm g{Ap, Bp, NROW, 2048, (K_) / (NKC_), K_, K_}; pg8::CtxSplitSched S; S.init(8, NKC_, G, c); \
    pg8::Epi<6> E{nullptr, 2048, nullptr, nullptr, nullptr, RT, CT, PART}; pg8::gemm_phase<pg8::Epi<6>, pg8::CtxSplitSched, true, true>(ldsL, g, S, E, wave); } while (0)

  if (IN(0)) { REP(0) p0_prologue(a, ldsL, gw, NGW, wave, lane_id_v(), rep_PROBE0); __syncthreads(); } SEAM(0);
  if (IN(1)) REP(1) norm_phase<false, true>(a.in[0], a.in[2], nullptr, nullptr, nullptr, nullptr, nullptr, nullptr, gn + 0 * 2048, MODP(0, 1), MODP(0, 0), S1, false, gw, NGW, lane_id_v());
  SEAM(1);
  if (IN(2)) REP(2) RUN_GEMM(1, S1, 2048, (const bf16_t*)(ws + WS_WIN), NP1, 2048, false, S2, NP1, SSQP(0), nullptr, KRb, RT, CT);
  SEAM(2);
  if (IN(3)) REP(3) {
    RUN_GEMM(2, S2, NP1, (const bf16_t*)(ws + WS_WQB), NQ, 512, false, Qb, NQ, nullptr, SSQ, nullptr, RT, CT);
    RUN_GEMM(3, S2 + 512, NP1, (const bf16_t*)(ws + WS_WKVB), NKV, 512, false, KVb, NKV, nullptr, SSQ + NROW, nullptr, RT, CT);
  }
  SEAM(3);
  if (IN(4)) REP(4) {
    const float SC = 0.07216878364870322f, Cc = SC * 1.4426950408889634f, THRS = 8.f / SC;
    for (int r = 0;; ++r) {
      const int u = c + r * G; if (u >= 2080) break;
      int b, h, rowq, NT;
      if (u < 2048) { int pair, qb; if (G == 256) { pair = (c & 7) * 4 + (r >> 1); qb = (c >> 3) + 32 * (r & 1); } else { pair = u >> 6; qb = u & 63; }
        b = pair >> 4; h = pair & 15; rowq = b * TB + CTXL + qb * 256; NT = TB / 64; }
      else { const int p = u - 2048; b = p >> 4; h = p & 15; rowq = b * TB; NT = CTXL / 64; }
      att::attn_unit<128, 128, false>(Qb + (size_t)rowq * NQ + h * 192, NQ, KVb + h * 256, NKV, KRb, 64, KVb + h * 256 + 128, NKV, S1 + (size_t)rowq * DM + h * 128, DM,
                                      NT, NT, b * TB, 0, 0, 0, Cc, THRS, -INFINITY, (char*)lds, ldsL, wave);
    }
  }
  SEAM(4);
  if (IN(5)) REP(5) { RUN_GEMM(0, S1, 2048, (const bf16_t*)(ws + WS_WOM), 2048, 2048, true, S2, 2048, SSQP(2), nullptr, nullptr, RT, CT);
    RUN_CTX_SPLIT(S1, (const bf16_t*)(ws + WS_WOM), 2048, 8); }
  SEAM(5);
  if (IN(6)) norm_phase<true, true, 8>(a.in[0], a.in[2], a.out, XC, S2, SSQ + 2 * NROW, gn + 1 * 2048, MODP(0, 2), gn + 2 * 2048, MODP(0, 4), MODP(0, 3), S1, false, gw, NGW, lane_id_v(), PART);
  SEAM(6);
  if (IN(7)) REP(7) RUN_GEMM(4, S1, 2048, (const bf16_t*)(ws + WS_WF1), DFF, 2048, false, Gb, DFF, nullptr, nullptr, nullptr, RT, CT);
  SEAM(7);
  if (IN(8)) REP(8) { RUN_GEMM(0, Gb, DFF, (const bf16_t*)(ws + WS_WF2), 2048, DFF, true, S2, 2048, SSQP(3), nullptr, nullptr, RT, CT);
    RUN_CTX_SPLIT(Gb, (const bf16_t*)(ws + WS_WF2), DFF, 16); }
  SEAM(8);
  if (IN(9)) norm_phase<true, true, 16>(a.out, XC, a.out, XC, S2, SSQ + 3 * NROW, gn + 3 * 2048, MODP(0, 5), gn + 4 * 2048, MODP(1, 1), MODP(1, 0), S1, false, gw, NGW, lane_id_v(), PART);
  SEAM(9);
  if (IN(10)) REP(10) RUN_GEMM(5, S1, 2048, (const bf16_t*)(ws + WS_WQKV), NQKV, 2048, false, Gb, NQKV, nullptr, nullptr, nullptr, RT, CT);
  SEAM(10);
  if (IN(11)) REP(11) {
    const float SC = 0.125f, Cc = SC * 1.4426950408889634f, THRS = 8.f / SC;
    for (int u = c; u < 4096; u += G) {
      const int pair = u >> 6, qb = u & 63, b = pair >> 5, h = pair & 31, kvh = h >> 3, t0 = qb * 256;
      int tstart = t0 - 128, nwin = 8;
      if (t0 == 0) { tstart = 0; nwin = 6; }
      if (t0 == SEQ - 256) nwin = 6;
      const int rowq = b * TB + CTXL + t0;
      att::attn_unit<0, 64, true>(Gb + (size_t)rowq * NQKV + h * 64, NQKV, nullptr, 0, Gb + 2048 + kvh * 64, NQKV, Gb + 2304 + kvh * 64, NQKV, S1 + (size_t)rowq * DM + h * 64, DM,
                                  4 + nwin, 4, b * TB, b * TB + CTXL + tstart, t0, tstart, Cc, THRS, a.in[16][h] * 1.4426950408889634f, (char*)lds, ldsL, wave);
    }
  }
  SEAM(11);
  if (IN(12)) REP(12) RUN_GEMM(0, S1, 2048, (const bf16_t*)(ws + WS_WOS), 2048, 2048, true, S2, 2048, SSQP(4), nullptr, nullptr, RT, CT);
  SEAM(12);
  if (IN(13)) norm_phase<true, true>(a.out, XC, a.out, XC, S2, SSQ + 4 * NROW, gn + 5 * 2048, MODP(1, 2), gn + 6 * 2048, MODP(1, 4), MODP(1, 3), S1, true, gw, NGW, lane_id_v());
  SEAM(13);
  if (IN(14)) REP(14) RUN_GEMM(4, S1, 2048, (const bf16_t*)(ws + WS_WF1) + (size_t)2048 * 8192, DFF, 2048, true, Gb, DFF, nullptr, nullptr, nullptr, RT, CT);
  SEAM(14);
  if (IN(15)) REP(15) RUN_GEMM(0, Gb, DFF, (const bf16_t*)(ws + WS_WF2) + (size_t)2048 * 8192, 2048, DFF, true, S2, 2048, SSQP(5), nullptr, nullptr, RT, CT);
  SEAM(15);
  if (IN(16)) norm_phase<true, false>(a.out, XC, a.out, XC, S2, SSQ + 5 * NROW, gn + 7 * 2048, MODP(1, 5), nullptr, nullptr, nullptr, nullptr, true, gw, NGW, lane_id_v());
#undef IN
#undef SEAM
}

extern "C" void kernel_launch(void* const* d_in, const int* in_sizes, int n_in, void* d_out, int out_size, void* d_ws, size_t ws_size, hipStream_t stream) {
  static int grid = 0;
  if (grid == 0) {
    if (n_in != 18 || out_size != 2 * SEQ * DM || ws_size < WS_END) { fprintf(stderr, "kernel_launch: unexpected shapes: n_in %d out %d ws %zu (need %zu)\n", n_in, out_size, ws_size, (size_t)WS_END); grid = -1; return; }
    int dev = 0, cus = 0, per_cu = 0;
    hipGetDevice(&dev); hipDeviceGetAttribute(&cus, hipDeviceAttributeMultiprocessorCount, dev);
    if (hipFuncSetAttribute((const void*)mk_fwd, hipFuncAttributeMaxDynamicSharedMemorySize, LDS_BYTES) != hipSuccess) { fprintf(stderr, "kernel_launch: hipFuncSetAttribute failed\n"); grid = -1; return; }
    if (hipOccupancyMaxActiveBlocksPerMultiprocessor(&per_cu, (const void*)mk_fwd, 512, LDS_BYTES) != hipSuccess || per_cu < 1) { fprintf(stderr, "kernel_launch: occupancy query gave %d\n", per_cu); per_cu = 1; }
    (void)hipGetLastError();
    grid = cus * per_cu;
    fprintf(stderr, "kernel_launch: grid %d (cus %d x %d)\n", grid, cus, per_cu);
  }
  if (grid < 0) return;
  hipMemsetAsync((char*)d_ws, 0, CTL_ZERO_BYTES, stream);
  Args a{};
  for (int i = 0; i < 18; ++i) a.in[i] = (const float*)d_in[i];
  a.out = (float*)d_out; a.ws = (unsigned char*)d_ws; a.ph_lo = 0; a.ph_hi = N_PHASES;
  void* args[] = {&a};
  hipError_t e = hipLaunchCooperativeKernel((const void*)mk_fwd, dim3(grid), dim3(512), args, LDS_BYTES, stream);
  if (e != hipSuccess) fprintf(stderr, "kernel_launch: cooperative launch failed: %s (grid %d)\n", hipGetErrorString(e), grid);
}
```

```cpp
#include <hip/hip_runtime.h>
#include <hip/hip_cooperative_groups.h>
#include <cstdio>
#include <cstdint>
namespace cg = cooperative_groups;

constexpr int DM = 2048, SEQ = 16384, CTXL = 256, TB = SEQ + CTXL  , NROW = 2 * TB  , DFF = 8192;
constexpr int NP1 = 1280  , NQ = 3072, NKV = 4096, NQKV = 2560;
constexpr float NORM_EPS = 1e-6f;
__device__ __forceinline__ int lane_id_v() { int l; asm volatile("v_mbcnt_lo_u32_b32 %0, -1, 0\n\tv_mbcnt_hi_u32_b32 %0, -1, %0" : "=v"(l)); return l; }
namespace pg8 {
#define PG8_LAS __attribute__((address_space(3)))
typedef unsigned short bf16_t;
typedef short bf16x8 __attribute__((ext_vector_type(8)));
typedef float f32x4 __attribute__((ext_vector_type(4)));
typedef unsigned u32x4 __attribute__((ext_vector_type(4)));
constexpr int BM = 256, BK = 64, HALF = 128, HTB = HALF * BK * 2  , STAGE_BYTES = 8 * HTB, NXCD = 8, WGM = 8;

__host__ __device__ __forceinline__ int lds_byte(int r, int c) { const int st = (r >> 4) * 2 + (c >> 5), rr = r & 15, cc = c & 31, ob = rr * 64 + cc * 2; return st * 1024 + (ob ^ (((ob >> 9) & 1) << 5)); }
__host__ __device__ __forceinline__ void stage_rc(int b, int& R, int& C) { const int st = b / 1024, sb = b % 1024, swz = sb ^ (((sb >> 9) & 1) << 5); R = (st >> 1) * 16 + swz / 64; C = (st & 1) * 32 + (swz % 64) / 2; }
__host__ __device__ __forceinline__ int perm32(int rho) { const int n = rho >> 4, i = rho & 15; return 8 * (i >> 2) + 4 * n + (i & 3); }

struct Unit { int pm, pn, kc; };
struct Gemm { const bf16_t* A; const bf16_t* Bt; int M, N, K, lda, ldb; };

struct StaticOrder {
    int nM, nN, nwg, G, c;
    __host__ __device__ void init(int M, int N, int G_, int c_) { nM = M / BM; nN = N / BM; nwg = nM * nN; G = G_; c = c_; }
    __host__ __device__ bool next(int i, Unit& u) const {
        const long L = (long)i * G + c; if (L >= nwg) return false;
        int wgid = (int)L; { const int q = nwg / NXCD, r = nwg % NXCD, xcd = wgid % NXCD, off = wgid / NXCD; wgid = (xcd < r ? xcd * (q + 1) : r * (q + 1) + (xcd - r) * q) + off; }
        const int nig = WGM * nN, gid = wgid / nig, fm = gid * WGM, gsz = (nM - fm) < WGM ? (nM - fm) : WGM;
        u.pm = fm + ((wgid % nig) % gsz); u.pn = (wgid % nig) / gsz; return true;
    }
    __device__ __forceinline__ void a_ready(const Unit&) const {}
    __device__ __forceinline__ void done(const Unit&) const {}
};


__device__ __forceinline__ unsigned cvt_pk_bf16(float lo, float hi) { unsigned r; asm volatile("v_cvt_pk_bf16_f32 %0, %1, %2" : "=v"(r) : "v"(lo), "v"(hi)); return r; }

struct RowSched {
    int nM, nN, nwg, G, c, skipctx, rev;
    __device__ void init(int nM_, int nN_, int G_, int c_, int skipctx_, int rev_ = 0) { nM = nM_; nN = nN_; nwg = nM * nN; G = G_; c = c_; skipctx = skipctx_; rev = rev_; }
    __device__ bool next(int i, Unit& u) const {
        const long L = (long)i * G + c; if (L >= nwg) return false;
        int wgid = (int)L; { const int q = nwg / NXCD, r = nwg % NXCD, xcd = wgid % NXCD, off = wgid / NXCD; wgid = (xcd < r ? xcd * (q + 1) : r * (q + 1) + (xcd - r) * q) + off; }
        const int nig = WGM * nN, gid = wgid / nig, fm = gid * WGM, gsz = (nM - fm) < WGM ? (nM - fm) : WGM;
        int pm = fm + ((wgid % nig) % gsz); u.pn = (wgid % nig) / gsz;
        if (rev) pm = nM - 1 - pm;
        if (skipctx) pm += 1 + (pm >= 64 ? 1 : 0);
        u.pm = pm; u.kc = 0; return true;
    }
    __device__ __forceinline__ void a_ready(const Unit&) const {}
    __device__ __forceinline__ void done(const Unit&) const {}
};

struct CtxSplitSched {
    int nN, NKC, nwg, G, c;
    __device__ void init(int nN_, int NKC_, int G_, int c_) { nN = nN_; NKC = NKC_; nwg = 2 * nN * NKC; G = G_; c = c_; }
    __device__ bool next(int i, Unit& u) const {
        const long L = (long)i * G + c; if (L >= nwg) return false;
        const int l = (int)L, t = l / NKC; u.kc = l - t * NKC; u.pn = t % nN; u.pm = (t / nN) ? 65 : 0; return true;
    }
    __device__ __forceinline__ void a_ready(const Unit&) const {}
    __device__ __forceinline__ void done(const Unit&) const {}
};

template <int MODE> struct Epi {
    static constexpr bool PERM = true, AFTER_DRAIN = false;
    bf16_t* O; int ldc;
    float* ssq;
    const float* rssq;
    bf16_t* KR;
    const float* rtab; const float* ctab;
    float* part;
    __device__ __forceinline__ void operator()(const f32x4 (&acc)[2][2][4][2], const Unit& u, int wr, int wc, int fr, int fq) const {
        const int pm = u.pm, pn = u.pn;
        const bool isctx = (pm == 0) || (pm == 65);
        const int tbase = (pm > 65 ? pm - 66 : pm - 1) * 256;
#pragma unroll
        for (int ai = 0; ai < 2; ++ai)
#pragma unroll
            for (int m = 0; m < 4; ++m) {
                const int rt = ai * HALF + wr * 64 + m * 16 + fr;
                const int row = pm * BM + rt;
                const int t = tbase + rt;
                float rs = 1.f;
                if (MODE == 2 || MODE == 3) rs = __builtin_amdgcn_rsqf(rssq[row] * (1.0f / 512.0f) + 1e-6f);
                float sq = 0.f;
#pragma unroll
                for (int bj = 0; bj < 2; ++bj) {
                    const int col = pn * BM + bj * HALF + wc * 32 + 8 * fq;
                    f32x4 v0 = acc[ai][bj][m][0], v1 = acc[ai][bj][m][1];
                    if (MODE == 6) { float* pp = part + ((size_t)u.kc * 512 + (pm == 65 ? 256 : 0) + rt) * ldc + col; *(f32x4*)pp = v0; *(f32x4*)(pp + 4) = v1; continue; }
                    if (MODE == 2 || MODE == 3) { v0 = v0 * rs; v1 = v1 * rs; }
                    if (MODE == 0 || MODE == 1) sq += (v0[0] * v0[0] + v0[1] * v0[1]) + (v0[2] * v0[2] + v0[3] * v0[3]) + (v1[0] * v1[0] + v1[1] * v1[1]) + (v1[2] * v1[2] + v1[3] * v1[3]);
                    bool dorope = false; int i0 = 0;
                    if (MODE == 2) { const int hc = col % 192; dorope = (!isctx) && (hc >= 128); i0 = (hc - 128) >> 1; }
                    if (MODE == 5) { dorope = (!isctx) && (col < 2304); i0 = (col & 63) >> 1; }
                    if (MODE == 1) { dorope = (!isctx) && (pn == 4) && (col < 1088); i0 = (col - 1024) >> 1; }
                    if (MODE == 1 || MODE == 2 || MODE == 5) {
                        if (dorope) {
                            const float* tb = (i0 < 16) ? (rtab + ((t >> 6) * 16 + i0) * 2) : (ctab + ((t & 63) * 16 + (i0 - 16)) * 2);
                            const f32x4 c0 = *(const f32x4*)tb, c1 = *(const f32x4*)(tb + 4);
                            f32x4 w0, w1;
                            w0[0] = v0[0] * c0[0] - v0[1] * c0[1]; w0[1] = v0[0] * c0[1] + v0[1] * c0[0];
                            w0[2] = v0[2] * c0[2] - v0[3] * c0[3]; w0[3] = v0[2] * c0[3] + v0[3] * c0[2];
                            w1[0] = v1[0] * c1[0] - v1[1] * c1[1]; w1[1] = v1[0] * c1[1] + v1[1] * c1[0];
                            w1[2] = v1[2] * c1[2] - v1[3] * c1[3]; w1[3] = v1[2] * c1[3] + v1[3] * c1[2];
                            v0 = w0; v1 = w1;
                        }
                    }
                    if (MODE == 4) {
#pragma unroll
                        for (int e = 0; e < 4; ++e) { const float a = fmaxf(v0[e], 0.f), b = fmaxf(v1[e], 0.f); v0[e] = a * a; v1[e] = b * b; }
                    }
                    u32x4 w; w.x = cvt_pk_bf16(v0[0], v0[1]); w.y = cvt_pk_bf16(v0[2], v0[3]); w.z = cvt_pk_bf16(v1[0], v1[1]); w.w = cvt_pk_bf16(v1[2], v1[3]);
                    if (MODE == 1 && pn == 4) { if (col < 1088) *(u32x4*)(KR + (size_t)row * 64 + (col - 1024)) = w; }
                    else *(u32x4*)(O + (size_t)row * ldc + col) = w;
                }
                if (MODE == 0 || MODE == 1) {
                    if (MODE == 0 || pn < 4) {
                        sq += __shfl_xor(sq, 16); sq += __shfl_xor(sq, 32);
                        if (fq == 0) atomicAdd(ssq + (MODE == 1 ? (size_t)(pn >> 1) * NROW : (size_t)0) + row, sq);
                    }
                }
            }
    }
};

template <class Epi, class Sched, bool ALIGN_EPI = false, bool SP2 = false>
__device__ __forceinline__ void gemm_phase(PG8_LAS unsigned char* lds, const Gemm g, const Sched& S, const Epi& E, const int wave_) {
    const int wid = wave_, lane = lane_id_v(), tid = wid * 64 + lane, wr = wid >> 2, wc = wid & 3, fr = lane & 15, fq = lane >> 4;
    const int K = g.K, nt = K / BK, lda = g.lda, ldb = g.ldb;
    unsigned voffA[2], voffB[2];
#pragma unroll
    for (int i = 0; i < 2; ++i) { int R, C; stage_rc(tid * 16 + i * 8192, R, C); const int Rb = Epi::PERM ? ((R & ~31) + perm32(R & 31)) : R;
        voffA[i] = (unsigned)(R * lda + C) * 2u; voffB[i] = (unsigned)(Rb * ldb + C) * 2u; }
    const size_t kstep = (size_t)(BK * 2);
    const size_t hstepA = (size_t)HALF * lda * 2, hstepB = (size_t)HALF * ldb * 2;
    const size_t tstepA = 2 * hstepA, tstepB = 2 * hstepB;
    const unsigned ldsw = (unsigned)wid * 1024u;
    const int aoff = lds_byte(wr * 64 + fr, fq * 8), boff = lds_byte(wc * 32 + fr, fq * 8);
#define PG8_SA(b, h) (((b) * 2 + (h)) * HTB)
#define PG8_SB(b, h) ((4 + (b) * 2 + (h)) * HTB)
#define PG8_STAGE(bufoff, gbase, voff) do { _Pragma("unroll") for (int _i = 0; _i < 2; ++_i) \
        __builtin_amdgcn_global_load_lds((const unsigned*)((const char*)(gbase) + (voff)[_i]), (PG8_LAS unsigned*)(lds + (bufoff) + ldsw + _i * 8192), 16, 0, 0); } while (0)
#define PG8_LDA(dst, b, h) do { _Pragma("unroll") for (int m = 0; m < 4; ++m) _Pragma("unroll") for (int k = 0; k < 2; ++k) dst[m][k] = *(const PG8_LAS bf16x8*)(lds + PG8_SA(b, h) + aoff + m * 2048 + k * 1024); } while (0)
#define PG8_LDB(dst, b, h) do { _Pragma("unroll") for (int n = 0; n < 2; ++n) _Pragma("unroll") for (int k = 0; k < 2; ++k) dst[n][k] = *(const PG8_LAS bf16x8*)(lds + PG8_SB(b, h) + boff + n * 2048 + k * 1024); } while (0)
#define PG8_MMA(ai, bj, At, Bt) do { __builtin_amdgcn_s_setprio(1); _Pragma("unroll") for (int m = 0; m < 4; ++m) _Pragma("unroll") for (int n = 0; n < 2; ++n) _Pragma("unroll") for (int k = 0; k < 2; ++k) \
        acc[ai][bj][m][n] = __builtin_amdgcn_mfma_f32_16x16x32_bf16(Bt[n][k], At[m][k], acc[ai][bj][m][n], 0, 0, 0); __builtin_amdgcn_s_setprio(0); } while (0)
#define PG8_WAIT_V(n) asm volatile("s_waitcnt vmcnt(" #n ")" ::: "memory")
#define PG8_WAIT_L(n) asm volatile("s_waitcnt lgkmcnt(" #n ")" ::: "memory")
#define PG8_BAR __builtin_amdgcn_s_barrier()
#define PG8_SCHED __builtin_amdgcn_sched_barrier(0)
    Unit cur, nxt; int ui = 0;
    if (!S.next(0, cur)) return;
    f32x4 acc[2][2][4][2];
#pragma unroll
    for (int a = 0; a < 2; ++a)
#pragma unroll
        for (int b = 0; b < 2; ++b)
#pragma unroll
            for (int m = 0; m < 4; ++m)
#pragma unroll
                for (int n = 0; n < 2; ++n) acc[a][b][m][n] = (f32x4){0.f, 0.f, 0.f, 0.f};
    bf16x8 At[4][2], B0[2][2], B1[2][2];
    const char* cA = (const char*)g.A + (size_t)cur.pm * tstepA + (size_t)cur.kc * K * 2; const char* cB = (const char*)g.Bt + (size_t)cur.pn * tstepB + (size_t)cur.kc * K * 2;
    S.a_ready(cur);
    if constexpr (SP2) {
        PG8_STAGE(PG8_SB(0, 0), cB, voffB); PG8_STAGE(PG8_SB(0, 1), cB + hstepB, voffB); PG8_STAGE(PG8_SA(0, 0), cA, voffA); PG8_STAGE(PG8_SA(0, 1), cA + hstepA, voffA);
        if (wr == 1) PG8_BAR;
        PG8_WAIT_V(2); PG8_BAR;
        PG8_STAGE(PG8_SB(1, 0), cB + kstep, voffB); PG8_STAGE(PG8_SA(1, 0), cA + kstep, voffA); PG8_STAGE(PG8_SB(1, 1), cB + hstepB + kstep, voffB);
        PG8_WAIT_V(6); PG8_BAR;
    } else {
        PG8_STAGE(PG8_SB(0, 0), cB, voffB); PG8_STAGE(PG8_SA(0, 0), cA, voffA); PG8_STAGE(PG8_SB(0, 1), cB + hstepB, voffB); PG8_STAGE(PG8_SA(0, 1), cA + hstepA, voffA);
        if (wr == 1) PG8_BAR;
        PG8_WAIT_V(4); PG8_BAR;
        PG8_STAGE(PG8_SB(1, 0), cB + kstep, voffB); PG8_STAGE(PG8_SA(1, 0), cA + kstep, voffA); PG8_STAGE(PG8_SB(1, 1), cB + hstepB + kstep, voffB);
        PG8_WAIT_V(6); PG8_BAR;
    }
    for (;;) {
        const bool has_next = S.next(ui + 1, nxt);
        const char* nA = has_next ? (const char*)g.A + (size_t)nxt.pm * tstepA + (size_t)nxt.kc * K * 2 : cA; const char* nB = has_next ? (const char*)g.Bt + (size_t)nxt.pn * tstepB + (size_t)nxt.kc * K * 2 : cB;
        for (int t = 0; t < nt; t += 2) {
            const bool last = (t == nt - 2);
            const char* a1 = cA + (size_t)(t + 1) * kstep;
            const char* a2 = last ? nA : cA + (size_t)(t + 2) * kstep; const char* b2 = last ? nB : cB + (size_t)(t + 2) * kstep;
            const char* a3 = a2 + kstep; const char* b3 = b2 + kstep;
            if (last && has_next) S.a_ready(nxt);
            if constexpr (SP2) {
            PG8_LDB(B0, 0, 0); PG8_LDB(B1, 0, 1); PG8_SCHED; PG8_LDA(At, 0, 0); PG8_STAGE(PG8_SA(1, 1), a1 + hstepA, voffA);
            PG8_WAIT_V(8); PG8_WAIT_L(0); PG8_BAR; PG8_MMA(0, 0, At, B0); PG8_MMA(0, 1, At, B1); PG8_BAR; PG8_SCHED;
            PG8_LDA(At, 0, 1); PG8_STAGE(PG8_SB(0, 0), b2, voffB); PG8_STAGE(PG8_SB(0, 1), b2 + hstepB, voffB); PG8_STAGE(PG8_SA(0, 0), a2, voffA);
            PG8_WAIT_V(8); PG8_WAIT_L(0); PG8_BAR; PG8_MMA(1, 0, At, B0); PG8_MMA(1, 1, At, B1); PG8_BAR; PG8_SCHED;
            PG8_LDB(B0, 1, 0); PG8_LDB(B1, 1, 1); PG8_SCHED; PG8_LDA(At, 1, 0); PG8_STAGE(PG8_SA(0, 1), a2 + hstepA, voffA);
            PG8_WAIT_V(8); PG8_WAIT_L(0); PG8_BAR; PG8_MMA(0, 0, At, B0); PG8_MMA(0, 1, At, B1); PG8_BAR; PG8_SCHED;
            PG8_LDA(At, 1, 1); PG8_STAGE(PG8_SB(1, 0), b3, voffB); PG8_STAGE(PG8_SB(1, 1), b3 + hstepB, voffB); PG8_STAGE(PG8_SA(1, 0), a3, voffA);
            PG8_WAIT_V(8); PG8_WAIT_L(0); PG8_BAR; PG8_MMA(1, 0, At, B0); PG8_MMA(1, 1, At, B1); PG8_BAR; PG8_SCHED;
            } else {
            PG8_LDB(B0, 0, 0); PG8_SCHED; PG8_LDA(At, 0, 0); PG8_STAGE(PG8_SA(1, 1), a1 + hstepA, voffA);
            PG8_WAIT_L(8); PG8_BAR; PG8_WAIT_L(0); PG8_MMA(0, 0, At, B0); PG8_BAR; PG8_SCHED;
            PG8_LDB(B1, 0, 1); PG8_STAGE(PG8_SB(0, 0), b2, voffB);
            PG8_BAR; PG8_WAIT_L(0); PG8_MMA(0, 1, At, B1); PG8_BAR;
            PG8_LDA(At, 0, 1); PG8_STAGE(PG8_SA(0, 0), a2, voffA);
            PG8_BAR; PG8_WAIT_L(0); PG8_MMA(1, 0, At, B0); PG8_BAR; PG8_SCHED;
            PG8_STAGE(PG8_SB(0, 1), b2 + hstepB, voffB);
            PG8_WAIT_V(6); PG8_BAR; PG8_MMA(1, 1, At, B1); PG8_BAR;
            PG8_LDB(B0, 1, 0); PG8_SCHED; PG8_LDA(At, 1, 0); PG8_STAGE(PG8_SA(0, 1), a2 + hstepA, voffA);
            PG8_WAIT_L(8); PG8_BAR; PG8_WAIT_L(0); PG8_MMA(0, 0, At, B0); PG8_BAR; PG8_SCHED;
            PG8_LDB(B1, 1, 1); PG8_STAGE(PG8_SB(1, 0), b3, voffB);
            PG8_BAR; PG8_WAIT_L(0); PG8_MMA(0, 1, At, B1); PG8_BAR;
            PG8_LDA(At, 1, 1); PG8_STAGE(PG8_SA(1, 0), a3, voffA);
            PG8_BAR; PG8_WAIT_L(0); PG8_MMA(1, 0, At, B0); PG8_BAR; PG8_SCHED;
            PG8_STAGE(PG8_SB(1, 1), b3 + hstepB, voffB);
            PG8_WAIT_V(6); PG8_BAR; PG8_MMA(1, 1, At, B1); PG8_BAR;
            }
        }
        if constexpr (ALIGN_EPI) { if (wr == 0) PG8_BAR; }
        if constexpr (!Epi::AFTER_DRAIN) { E(acc, cur, wr, wc, fr, fq); S.done(cur); }
        if (!has_next) break;
#pragma unroll
        for (int a = 0; a < 2; ++a)
#pragma unroll
            for (int b = 0; b < 2; ++b)
#pragma unroll
                for (int m = 0; m < 4; ++m)
#pragma unroll
                    for (int n = 0; n < 2; ++n) acc[a][b][m][n] = (f32x4){0.f, 0.f, 0.f, 0.f};
        cur = nxt; cA = nA; cB = nB; ++ui;
        if constexpr (ALIGN_EPI) { if (wr == 1) PG8_BAR; }
    }
    PG8_WAIT_V(0);
    if constexpr (!ALIGN_EPI) { if (wr == 0) PG8_BAR; }
    PG8_BAR;
    if constexpr (Epi::AFTER_DRAIN) { E.fused(acc, cur, wr, wc, fr, fq, lds, wid, lane); S.done(cur); }
#undef PG8_SA
#undef PG8_SB
#undef PG8_STAGE
#undef PG8_LDA
#undef PG8_LDB
#undef PG8_MMA
#undef PG8_WAIT_V
#undef PG8_WAIT_L
#undef PG8_BAR
#undef PG8_SCHED
}
}

namespace att {
typedef unsigned short bf16_t;
using bf16x8 = __attribute__((ext_vector_type(8))) short;
using s16x4  = __attribute__((ext_vector_type(4))) short;
using f32x16 = __attribute__((ext_vector_type(16))) float;
using u32x4  = __attribute__((ext_vector_type(4))) unsigned;
#define KSWZ(row, colB) ((row) * 256 + ((colB) ^ (((row) & 15) << 4)))
#define KSWZ64(row, colB) ((row) * 128 + ((colB) ^ ((((row) >> 1) & 7) << 4)))
#define SBAR() __builtin_amdgcn_sched_barrier(0)
__device__ __forceinline__ int crow(int r, int hi) { return (r & 3) + 8 * (r >> 2) + 4 * hi; }
__device__ __forceinline__ unsigned cvtpk(float lo, float hi) { unsigned r; asm volatile("v_cvt_pk_bf16_f32 %0, %1, %2" : "=v"(r) : "v"(lo), "v"(hi)); return r; }

__device__ __forceinline__ void partialSM(f32x16& p0, f32x16& p1, float& m_reg, float& alpha, const float C, const float THRS) {
  float pmax = p0[0];
#pragma unroll
  for (int r = 1; r < 16; ++r) pmax = fmaxf(pmax, p0[r]);
#pragma unroll
  for (int r = 0; r < 16; ++r) pmax = fmaxf(pmax, p1[r]);
  { auto rr = __builtin_amdgcn_permlane32_swap(__float_as_uint(pmax), __float_as_uint(pmax), false, false);
    pmax = fmaxf(__uint_as_float(rr[0]), __uint_as_float(rr[1])); }
  float mn;
  if (__builtin_expect(__all(pmax - m_reg <= THRS), 1)) { mn = m_reg; alpha = 1.f; }
  else { mn = fmaxf(m_reg, pmax); alpha = __builtin_amdgcn_exp2f((m_reg - mn) * C); m_reg = mn; }
  const float mnC = -mn * C;
#pragma unroll
  for (int r = 0; r < 16; ++r) p0[r] = fmaf(p0[r], C, mnC);
#pragma unroll
  for (int r = 0; r < 16; ++r) p1[r] = fmaf(p1[r], C, mnC);
#pragma unroll
  for (int r = 0; r < 16; ++r) p0[r] = __builtin_amdgcn_exp2f(p0[r]);
}
__device__ __forceinline__ void finishSM(f32x16& p0, f32x16& p1, float alpha, float& l_reg, bf16x8& pa0, bf16x8& pa1, bf16x8& pa2, bf16x8& pa3) {
#pragma unroll
  for (int r = 0; r < 16; ++r) p1[r] = __builtin_amdgcn_exp2f(p1[r]);
  float ps = 0;
#pragma unroll
  for (int r = 0; r < 16; ++r) ps += p0[r];
#pragma unroll
  for (int r = 0; r < 16; ++r) ps += p1[r];
  { auto rr = __builtin_amdgcn_permlane32_swap(__float_as_uint(ps), __float_as_uint(ps), false, false);
    ps = __uint_as_float(rr[0]) + __uint_as_float(rr[1]); }
  l_reg = l_reg * alpha + ps;
#define PK4(P, BASE, OUT) do { unsigned a0 = cvtpk(P[BASE + 0], P[BASE + 1]), a1 = cvtpk(P[BASE + 2], P[BASE + 3]);   \
    unsigned b0 = cvtpk(P[BASE + 4], P[BASE + 5]), b1 = cvtpk(P[BASE + 6], P[BASE + 7]);                              \
    auto r0 = __builtin_amdgcn_permlane32_swap(a0, b0, false, false); auto r1 = __builtin_amdgcn_permlane32_swap(a1, b1, false, false); \
    u32x4 w = {r0[0], r1[0], r0[1], r1[1]}; OUT = *reinterpret_cast<bf16x8*>(&w); } while (0)
  PK4(p0, 0, pa0); PK4(p0, 8, pa1); PK4(p1, 0, pa2); PK4(p1, 8, pa3);
#undef PK4
}
template <int DN>
__device__ __forceinline__ void qkt(f32x16& p0, f32x16& p1, const char* Kn, const char* Kr, const bf16x8* qr, const char* qrl, int r32, int hi) {
  p0 = f32x16{}; p1 = f32x16{};
  if constexpr (DN > 0) {
#pragma unroll
    for (int d0 = 0; d0 < DN / 16; ++d0) { const int cb = (d0 * 16 + hi * 8) * 2;
      bf16x8 b0 = *reinterpret_cast<const bf16x8*>(Kn + KSWZ(r32, cb));
      bf16x8 b1 = *reinterpret_cast<const bf16x8*>(Kn + KSWZ(32 + r32, cb));
      p0 = __builtin_amdgcn_mfma_f32_32x32x16_bf16(b0, qr[d0], p0, 0, 0, 0);
      p1 = __builtin_amdgcn_mfma_f32_32x32x16_bf16(b1, qr[d0], p1, 0, 0, 0); }
  }
#pragma unroll
  for (int d0 = 0; d0 < 4; ++d0) { const int cb = (d0 * 16 + hi * 8) * 2;
    bf16x8 b0 = *reinterpret_cast<const bf16x8*>(Kr + KSWZ64(r32, cb));
    bf16x8 b1 = *reinterpret_cast<const bf16x8*>(Kr + KSWZ64(32 + r32, cb));
    bf16x8 q; if constexpr (DN > 0) q = *reinterpret_cast<const bf16x8*>(qrl + d0 * 1024); else q = qr[d0];
    p0 = __builtin_amdgcn_mfma_f32_32x32x16_bf16(b0, q, p0, 0, 0, 0);
    p1 = __builtin_amdgcn_mfma_f32_32x32x16_bf16(b1, q, p1, 0, 0, 0); }
}
__device__ __forceinline__ void band_mask(f32x16& p0, f32x16& p1, int d) {
#pragma unroll
  for (int r = 0; r < 16; ++r) { const int v = d - ((r & 3) + 8 * (r >> 2));
    if (v > 128 || v < -128) p0[r] = -1e30f;
    if (v - 32 > 128 || v - 32 < -128) p1[r] = -1e30f; }
}
__device__ __forceinline__ int v_rd_base(int lane) { return ((lane & 3) << 3) | (((lane >> 2) & 3) << 6) | (((lane >> 4) & 1) << 5) | (((lane >> 5) & 1) << 8); }
template <int NCB> constexpr int v_rd_off(int d0, int ks, int half) { return d0 * 512 + ks * (2 * NCB * 512) + half * (NCB * 512); }
template <int OFF> __device__ __forceinline__ s16x4 tr_read(int vb) {
  s16x4 r; asm volatile("ds_read_b64_tr_b16 %0, %1 offset:%2" : "=&v"(r) : "v"(vb), "i"(OFF) : "memory"); return r;
}
template <int D0, int NCB> __device__ __forceinline__ void pv_one(f32x16& od, int vb, bf16x8 pa0, bf16x8 pa1, bf16x8 pa2, bf16x8 pa3) {
  const s16x4 l0 = tr_read<v_rd_off<NCB>(D0, 0, 0)>(vb), h0 = tr_read<v_rd_off<NCB>(D0, 0, 1)>(vb), l1 = tr_read<v_rd_off<NCB>(D0, 1, 0)>(vb), h1 = tr_read<v_rd_off<NCB>(D0, 1, 1)>(vb);
  const s16x4 l2 = tr_read<v_rd_off<NCB>(D0, 2, 0)>(vb), h2 = tr_read<v_rd_off<NCB>(D0, 2, 1)>(vb), l3 = tr_read<v_rd_off<NCB>(D0, 3, 0)>(vb), h3 = tr_read<v_rd_off<NCB>(D0, 3, 1)>(vb);
  asm volatile("s_waitcnt lgkmcnt(0)" ::: "memory"); SBAR();
#define PK(L, H) (bf16x8){L[0], L[1], L[2], L[3], H[0], H[1], H[2], H[3]}
  od = __builtin_amdgcn_mfma_f32_32x32x16_bf16(pa0, PK(l0, h0), od, 0, 0, 0);
  od = __builtin_amdgcn_mfma_f32_32x32x16_bf16(pa1, PK(l1, h1), od, 0, 0, 0);
  od = __builtin_amdgcn_mfma_f32_32x32x16_bf16(pa2, PK(l2, h2), od, 0, 0, 0);
  od = __builtin_amdgcn_mfma_f32_32x32x16_bf16(pa3, PK(l3, h3), od, 0, 0, 0);
#undef PK
}
template <int NCB> __device__ __forceinline__ void pv_all(f32x16* o, int vb, bf16x8 pa0, bf16x8 pa1, bf16x8 pa2, bf16x8 pa3) {
  pv_one<0, NCB>(o[0], vb, pa0, pa1, pa2, pa3); pv_one<1, NCB>(o[1], vb, pa0, pa1, pa2, pa3);
  if constexpr (NCB == 4) { pv_one<2, NCB>(o[2], vb, pa0, pa1, pa2, pa3); pv_one<3, NCB>(o[3], vb, pa0, pa1, pa2, pa3); }
}

#define ATT_LAS __attribute__((address_space(3)))
template <int DN, int DV, bool MASK>
__device__ __forceinline__ void attn_unit(const bf16_t* __restrict__ Qb, const int ldq, const bf16_t* __restrict__ Kn, const int ldkn,
    const bf16_t* __restrict__ Kr, const int ldkr, const bf16_t* __restrict__ Vp, const int ldv, bf16_t* __restrict__ Ob, const int ldo,
    const int NT, const int n1, const int r1, const int r2, const int qpos0, const int kt2,
    const float C, const float THRS, const float sinkl2, char* lds, ATT_LAS unsigned char* ldsL, const int wave_) {
  constexpr int NQR = DN > 0 ? DN / 16 : 4, NCB = DV / 32, VB = 64 * DV * 2, KNB = 64 * DN * 2, KRB = 64 * 64 * 2, BUF = VB + KNB + KRB;
  constexpr int NVC = VB / 8192, NKC = KNB / 8192;
  const int wid = wave_, lane = lane_id_v(), r32 = lane & 31, hi = lane >> 5;
  char* Vl = lds; char* Knl = lds + VB; char* Krl = lds + VB + KNB;
  float* wsf = (float*)(lds + 3 * BUF) + wid * 64; float* li_l = wsf; float* al_l = wsf + 32;
  float m_reg = -1e30f, l_reg = 0; f32x16 o[NCB] = {}; bf16x8 qr[NQR];
  const bf16_t* Qw = Qb + (long)(wid * 32 + r32) * ldq + hi * 8;
#pragma unroll
  for (int d0 = 0; d0 < NQR; ++d0) qr[d0] = *reinterpret_cast<const bf16x8*>(Qw + d0 * 16);
  char* qrl = lds + 3 * BUF + 2048 + wid * 4096 + lane * 16;
  if constexpr (DN > 0) {
#pragma unroll
    for (int d0 = 0; d0 < 4; ++d0) *reinterpret_cast<bf16x8*>(qrl + d0 * 1024) = *reinterpret_cast<const bf16x8*>(Qw + DN + d0 * 16);
  }
  int offV[NVC], offK[NKC > 0 ? NKC : 1], offR;
#pragma unroll
  for (int i = 0; i < NVC; ++i) { const int ch = wid * NVC + i, sub = ch * 2 + (lane >> 5), kk = (sub / NCB) * 8 + ((lane & 31) >> 2), col = (sub % NCB) * 32 + (lane & 3) * 8;
    const int k = (kk & ~0xC) | ((kk & 4) << 1) | ((kk & 8) >> 1); offV[i] = k * ldv + col; }
#pragma unroll
  for (int i = 0; i < NKC; ++i) { const int ch = wid * NKC + i, row = ch * 4 + (lane >> 4), cb = ((lane & 15) * 16) ^ ((row & 15) << 4); offK[i] = row * ldkn + (cb >> 1); }
  { const int row = wid * 8 + (lane >> 3), cb = ((lane & 7) * 16) ^ (((row >> 1) & 7) << 4); offR = row * ldkr + (cb >> 1); }
  const int vb0 = (int)(uintptr_t)Vl + v_rd_base(lane);
  const int qd = qpos0 + wid * 32 + r32 - 4 * hi;
#define TROW(j) ((j) < n1 ? r1 + 64 * (j) : r2 + 64 * ((j) - n1))
#define DMA(j, b) do { const long row0_ = TROW(j); \
    _Pragma("unroll") for (int i_ = 0; i_ < NVC; ++i_) __builtin_amdgcn_global_load_lds((const unsigned*)(Vp + row0_ * ldv + offV[i_]), (ATT_LAS unsigned*)(ldsL + (b) + (wid * NVC + i_) * 1024), 16, 0, 0); \
    _Pragma("unroll") for (int i_ = 0; i_ < NKC; ++i_) __builtin_amdgcn_global_load_lds((const unsigned*)(Kn + row0_ * ldkn + offK[i_]), (ATT_LAS unsigned*)(ldsL + (b) + VB + (wid * NKC + i_) * 1024), 16, 0, 0); \
    __builtin_amdgcn_global_load_lds((const unsigned*)(Kr + row0_ * ldkr + offR), (ATT_LAS unsigned*)(ldsL + (b) + VB + KNB + wid * 1024), 16, 0, 0); } while (0)
#define WAITV() asm volatile("s_waitcnt vmcnt(0)" ::: "memory")
#define SCORE(P0, P1, b, j) do { qkt<DN>(P0, P1, Knl + (b), Krl + (b), qr, qrl, r32, hi); \
    if constexpr (MASK) { if ((j) >= n1) band_mask(P0, P1, qd - (kt2 + 64 * ((j) - n1))); } } while (0)
#define RESC(a) do { if (__any((a) < 1.f)) { const int l_ = lane_id_v(); if (l_ < 32) al_l[l_] = (a); asm volatile("s_waitcnt lgkmcnt(0)" ::: "memory"); \
    _Pragma("unroll") for (int d = 0; d < NCB; ++d) _Pragma("unroll") for (int r = 0; r < 16; ++r) o[d][r] *= al_l[crow(r, l_ >> 5)]; } } while (0)
#define ROT() do { const int t_ = bp; bp = bc; bc = bn; bn = t_; } while (0)
  f32x16 pA0, pA1, pB0, pB1; float alA, alB; bf16x8 pa0, pa1, pa2, pa3;
  int bp = 0, bc = BUF, bn = 2 * BUF;
  DMA(0, 0); DMA(1, BUF); WAITV(); __syncthreads();
  SCORE(pA0, pA1, 0, 0); partialSM(pA0, pA1, m_reg, alA, C, THRS);
  for (int j = 1; j + 1 < NT; j += 2) {
    DMA(j + 1, bn);
    SBAR(); SCORE(pB0, pB1, bc, j);
    finishSM(pA0, pA1, alA, l_reg, pa0, pa1, pa2, pa3); SBAR();
    pv_all<NCB>(o, vb0 + bp, pa0, pa1, pa2, pa3); partialSM(pB0, pB1, m_reg, alB, C, THRS);
    RESC(alB); WAITV(); __syncthreads(); ROT();
    DMA(j + 2, bn);
    SBAR(); SCORE(pA0, pA1, bc, j + 1);
    finishSM(pB0, pB1, alB, l_reg, pa0, pa1, pa2, pa3); SBAR();
    pv_all<NCB>(o, vb0 + bp, pa0, pa1, pa2, pa3); partialSM(pA0, pA1, m_reg, alA, C, THRS);
    RESC(alA); WAITV(); __syncthreads(); ROT();
  }
  SBAR(); SCORE(pB0, pB1, bc, NT - 1);
  finishSM(pA0, pA1, alA, l_reg, pa0, pa1, pa2, pa3); SBAR();
  pv_all<NCB>(o, vb0 + bp, pa0, pa1, pa2, pa3); partialSM(pB0, pB1, m_reg, alB, C, THRS);
  RESC(alB);
  finishSM(pB0, pB1, alB, l_reg, pa0, pa1, pa2, pa3); SBAR();
  pv_all<NCB>(o, vb0 + bc, pa0, pa1, pa2, pa3);
  l_reg += __builtin_amdgcn_exp2f(sinkl2 - m_reg * C);
  const int lane2 = lane_id_v(), r32e = lane2 & 31, hie = lane2 >> 5;
  if (hie == 0) li_l[r32e] = l_reg; asm volatile("s_waitcnt lgkmcnt(0)" ::: "memory");
  float rli[16];
#pragma unroll
  for (int r = 0; r < 16; ++r) rli[r] = __builtin_amdgcn_rcpf(li_l[crow(r, hie)]);
  bf16_t* Ow = Ob + (long)(wid * 32) * ldo;
#pragma unroll
  for (int r = 0; r < 16; ++r) { const int orow = crow(r, hie);
#pragma unroll
    for (int d0 = 0; d0 < NCB; ++d0) Ow[(long)orow * ldo + d0 * 32 + r32e] = (bf16_t)(cvtpk(o[d0][r] * rli[r], 0.f) & 0xffffu); }
  __syncthreads();
#undef TROW
#undef DMA
#undef WAITV
#undef SCORE
#undef RESC
#undef ROT
}
}

constexpr size_t MiB = 1u << 20;
constexpr size_t WS_MOD = 0;
constexpr size_t WS_SSQ = 512 * 1024;
constexpr size_t WS_ROPE = 1792 * 1024;
constexpr size_t CTL_ZERO_BYTES = 2 * MiB;
constexpr size_t WS_XC = 2 * MiB;
constexpr size_t WS_WIN = 8 * MiB, WS_WQB = 13 * MiB, WS_WKVB = 16 * MiB, WS_WOM = 20 * MiB, WS_WF1 = 28 * MiB, WS_WF2 = 92 * MiB, WS_WQKV = 156 * MiB, WS_WOS = 166 * MiB;
constexpr size_t WS_S1 = 176 * MiB;
constexpr size_t WS_S2 = 306 * MiB;
constexpr size_t WS_G = 436 * MiB;
constexpr size_t WS_Q = WS_G, WS_KV = WS_G + 196 * MiB, WS_KR = WS_G + 456 * MiB;
constexpr size_t WS_PART = WS_G + 520 * MiB;
constexpr size_t WS_END = WS_PART + 64 * MiB;
static_assert((size_t)NROW * 2048 * 2 == 130 * MiB && WS_SSQ + 8 * (size_t)NROW * 4 <= WS_ROPE && (size_t)NROW * NQ * 2 <= 196 * MiB && (size_t)NROW * NKV * 2 <= 260 * MiB, "ws map");

#define LAS __attribute__((address_space(3)))
typedef unsigned short bf16_t;
typedef float f32x4 __attribute__((ext_vector_type(4)));
typedef unsigned u32x4 __attribute__((ext_vector_type(4)));
typedef unsigned u32x2 __attribute__((ext_vector_type(2)));
constexpr int LDS_BYTES = 3 * 40960 + 2048 + 32768;
constexpr int N_PHASES = 17;
#ifndef PROBE_PH
#define PROBE_PH -1
#endif
#ifndef PROBE_PH2
#define PROBE_PH2 -1
#endif
#if PROBE_PH >= 0
#define rep_PROBE0 (rep_ != 0)
#define REP(k) for (int rep_ = 0; rep_ < ((((PROBE_PH) >> (k)) & 1) ? 2 : 1); ++rep_)
#define SSQP(i) (rep_ ? SSQ + 6 * NROW : SSQ + (i) * NROW)
#else
#define rep_PROBE0 false
#define REP(k)
#define SSQP(i) (SSQ + (i) * NROW)
#endif

struct Args { const float* in[18]; float* out; unsigned char* ws; int ph_lo, ph_hi; };

__device__ __forceinline__ float wave_sum(float v) {
#pragma unroll
  for (int o = 1; o < 64; o <<= 1) v += __shfl_xor(v, o);
  return v;
}
__device__ __forceinline__ unsigned pk2(float lo, float hi) { unsigned r; asm volatile("v_cvt_pk_bf16_f32 %0, %1, %2" : "=v"(r) : "v"(lo), "v"(hi)); return r; }

__device__ __forceinline__ int dest_row(int mode, int n) {
  if (mode == 1) { if (n < 1024) return n; const int j = n - 1024; return 1024 + (((j & 31) << 1) | (j >> 5)); }
  if (mode == 2) { const int h = n / 192, d = n - h * 192; if (d < 128) return n; const int j = d - 128; return h * 192 + 128 + (((j & 31) << 1) | (j >> 5)); }
  if (mode == 3) { if (n >= 2304) return n; const int d = n & 63; return (n & ~63) + (((d & 31) << 1) | (d >> 5)); }
  return n;
}
__device__ __forceinline__ void tr_item(const float* __restrict__ W, int K, int N, bf16_t* __restrict__ WT, const float* __restrict__ ks, int mode, LAS float* scr, int item, int lane) {
  const int nblk = N / 32, kb = item / nblk, nb = item - kb * nblk, k0 = 64 * kb, n0 = 32 * nb;
  float wv[32];
#pragma unroll
  for (int i = 0; i < 32; ++i) wv[i] = W[(size_t)(k0 + 2 * i + (lane >> 5)) * N + n0 + (lane & 31)];
  if (ks) {
#pragma unroll
    for (int i = 0; i < 32; ++i) wv[i] *= ks[k0 + 2 * i + (lane >> 5)];
  }
#pragma unroll
  for (int i = 0; i < 32; ++i) scr[(2 * i + (lane >> 5)) * 33 + (lane & 31)] = wv[i];
  asm volatile("s_waitcnt lgkmcnt(0)" ::: "memory");
  const int c = lane & 7;
#pragma unroll
  for (int j = 0; j < 4; ++j) { const int n = (lane >> 3) + 8 * j; const LAS float* s = scr + (8 * c) * 33 + n;
    u32x4 o; o.x = pk2(s[0 * 33], s[1 * 33]); o.y = pk2(s[2 * 33], s[3 * 33]); o.z = pk2(s[4 * 33], s[5 * 33]); o.w = pk2(s[6 * 33], s[7 * 33]);
    *(u32x4*)(WT + (size_t)dest_row(mode, n0 + n) * K + k0 + 8 * c) = o; }
  asm volatile("s_waitcnt lgkmcnt(0)" ::: "memory");
}

__device__ __forceinline__ float silu_f(float x) { return x / (1.f + __expf(-x)); }

constexpr int TI0 = 32 * 34, TI1 = 8 * 96, TI2 = 8 * 128, TI3 = 32 * 64, TI4 = 32 * 256, TI6 = 128 * 64, TI8 = 32 * 80, TI9 = 32 * 64;
constexpr int N_EARLY = TI0 + TI1 + TI2, N_LATE = TI3 + 2 * TI4 + 2 * TI6 + TI8 + TI9;
__device__ __forceinline__ void tr_dispatch(const Args& a, int it  , LAS float* scr, int lane) {
  unsigned char* ws = a.ws;
  int r = it; const float* W; int K, N, mode = 0; const float* ks = nullptr; bf16_t* dst;
  if (r < TI0) { W = a.in[9]; K = 2048; N = 1088; mode = 1; dst = (bf16_t*)(ws + WS_WIN); }
  else if ((r -= TI0) < TI1) { W = a.in[12]; K = 512; N = 3072; mode = 2; ks = a.in[10]; dst = (bf16_t*)(ws + WS_WQB); }
  else if ((r -= TI1) < TI2) { W = a.in[13]; K = 512; N = 4096; ks = a.in[11]; dst = (bf16_t*)(ws + WS_WKVB); }
  else if ((r -= TI2) < TI3) { W = a.in[14]; K = 2048; N = 2048; dst = (bf16_t*)(ws + WS_WOM); }
  else if ((r -= TI3) < 2 * TI4) { const int l = r / TI4; r -= l * TI4; W = a.in[7] + (size_t)l * 2048 * 8192; K = 2048; N = 8192; dst = (bf16_t*)(ws + WS_WF1) + (size_t)l * 2048 * 8192; }
  else if ((r -= 2 * TI4) < 2 * TI6) { const int l = r / TI6; r -= l * TI6; W = a.in[8] + (size_t)l * 2048 * 8192; K = 8192; N = 2048; dst = (bf16_t*)(ws + WS_WF2) + (size_t)l * 2048 * 8192; }
  else if ((r -= 2 * TI6) < TI8) { W = a.in[15]; K = 2048; N = 2560; mode = 3; dst = (bf16_t*)(ws + WS_WQKV); }
  else { r -= TI8; W = a.in[17]; K = 2048; N = 2048; dst = (bf16_t*)(ws + WS_WOS); }
  tr_item(W, K, N, dst, ks, mode, scr, r, lane);
}

__device__ __forceinline__ void p0_prologue(const Args& a, LAS unsigned char* lds, int gw, int NGW, int wave, int lane, bool only_transposes) {
  unsigned char* ws = a.ws;
  LAS float* scr = (LAS float*)(lds + wave * 16384);
  for (int it = gw; it < N_EARLY + N_LATE; it += NGW) tr_dispatch(a, it, scr, lane);
  if (only_transposes) return;
  float* MOD = (float*)(ws + WS_MOD);
  for (int it = gw; it < 2 * 48 * 64; it += NGW) {
    const int kc = it & 63, cb = (it >> 6) % 48, l = it / (64 * 48);
    const int n0 = cb * 256 + lane * 4, k0 = kc * 32;
    const float* Wm = a.in[4] + (size_t)l * 2048 * 12288 + n0;
    f32x4 a0 = {0.f, 0.f, 0.f, 0.f}, a1 = a0, a2 = a0;
#pragma unroll 16
    for (int k = 0; k < 32; ++k) { const int kk = k0 + k;
      const float s0 = silu_f(a.in[1][kk]), s1 = silu_f(a.in[1][2048 + kk]), s2 = silu_f(a.in[3][kk]);
      const f32x4 w = *(const f32x4*)(Wm + (size_t)kk * 12288);
      a0 += w * s0; a1 += w * s1; a2 += w * s2; }
    if (kc == 0) { const f32x4 b = *(const f32x4*)(a.in[5] + l * 12288 + n0); a0 += b; a1 += b; a2 += b; }
    float* mo = MOD + (size_t)(l * 3) * 12288 + n0;
#pragma unroll
    for (int e = 0; e < 4; ++e) { atomicAdd(mo + e, a0[e]); atomicAdd(mo + 12288 + e, a1[e]); atomicAdd(mo + 2 * 12288 + e, a2[e]); }
  }
  float* tab = (float*)(ws + WS_ROPE);
  for (int e = gw * 64 + lane; e < 320 * 16; e += NGW * 64) {
    const int i = e & 15, pos = e >> 4; const float p = (float)(pos < 256 ? pos : pos - 256);
    const float freq = exp2f(-(float)i * 0.8304820237218406f); const float ang = p * freq;
    tab[e * 2] = cosf(ang); tab[e * 2 + 1] = sinf(ang);
  }
}

__device__ __forceinline__ f32x4 ldf4(const float* base, unsigned boff) { return *(const f32x4*)((const char*)base + boff); }
__device__ __forceinline__ void stf4(float* base, unsigned boff, f32x4 v) { *(f32x4*)((char*)base + boff) = v; }
template <bool UPD, bool DOH, int NKC>
__device__ __forceinline__ void norm_rows(const int row0, const int nrows, const float* xin_lat, const float* xin_ctx, float* xout_lat, float* xout_ctx, const bf16_t* Y, const float* ssq,
    const float* gA, const float* gateM, const float* gB, const float* scM, const float* shM, bf16_t* H, int lane, const float* part) {
  const int b = row0 / TB, rb = row0 - b * TB; const bool isctx = rb < CTXL;
  const int v = isctx ? 2 : b;
  const size_t xoff = isctx ? (size_t)(b * CTXL + rb) * DM : (size_t)(b * SEQ + rb - CTXL) * DM;
  const float* xin = (isctx ? xin_ctx : xin_lat) + xoff;
  float* xout = UPD ? ((isctx ? xout_ctx : xout_lat) + xoff) : nullptr;
  const int lane_ = lane_id_v();
  const unsigned lo = (unsigned)lane_ * 16u, lo2 = (unsigned)lane_ * 8u;
  f32x4 GA[8], GB[8], SH[8];
#pragma unroll
  for (int j = 0; j < 8; ++j) { const unsigned o = lo + 1024u * j;
    if (UPD) GA[j] = ldf4(gateM + v * 12288, o) * ldf4(gA, o);
    if (DOH) { GB[j] = ldf4(gB, o) * (ldf4(scM + v * 12288, o) + 1.0f); SH[j] = ldf4(shM + v * 12288, o); } }
  f32x4 xn[8]; u32x2 yn[8];
#pragma unroll
  for (int j = 0; j < 8; ++j) { xn[j] = ldf4(xin, lo + 1024u * j); if (UPD && !(NKC > 0 && isctx)) yn[j] = *(const u32x2*)((const char*)(Y + (size_t)row0 * DM) + lo2 + 512u * j); }
  for (int rr = 0; rr < nrows; ++rr) {
    const int row = row0 + rr;
    f32x4 x[8]; u32x2 yc[8];
#pragma unroll
    for (int j = 0; j < 8; ++j) { x[j] = xn[j]; if (UPD) yc[j] = yn[j]; }
    if (rr + 1 < nrows) { const float* xr = xin + (size_t)(rr + 1) * DM;
#pragma unroll
      for (int j = 0; j < 8; ++j) { xn[j] = ldf4(xr, lo + 1024u * j); if (UPD && !(NKC > 0 && isctx)) yn[j] = *(const u32x2*)((const char*)(Y + (size_t)(row + 1) * DM) + lo2 + 512u * j); } }
    if (UPD && NKC > 0 && isctx) {
      f32x4 y[8]; float ys = 0.f; const float* pr = part + (size_t)(b * CTXL + rb + rr) * DM;
#pragma unroll
      for (int j = 0; j < 8; ++j) y[j] = ldf4(pr, lo + 1024u * j);
#pragma unroll 1
      for (int k = 1; k < NKC; ++k) { pr += (size_t)512 * DM;
#pragma unroll
        for (int j = 0; j < 8; ++j) y[j] += ldf4(pr, lo + 1024u * j); }
#pragma unroll
      for (int j = 0; j < 8; ++j) ys += (y[j][0] * y[j][0] + y[j][1] * y[j][1]) + (y[j][2] * y[j][2] + y[j][3] * y[j][3]);
      const float rinv = __builtin_amdgcn_rsqf(wave_sum(ys) * (1.0f / 2048.0f) + NORM_EPS);
      float* xo = xout + (size_t)rr * DM;
#pragma unroll
      for (int j = 0; j < 8; ++j) { x[j] += GA[j] * (y[j] * rinv); stf4(xo, lo + 1024u * j, x[j]); }
    } else if (UPD) {
      const float rinv = __builtin_amdgcn_rsqf(ssq[row] * (1.0f / 2048.0f) + NORM_EPS);
      float* xo = xout + (size_t)rr * DM;
#pragma unroll
      for (int j = 0; j < 8; ++j) { const u32x2 yb = yc[j];
        f32x4 y; y[0] = __uint_as_float(yb.x << 16); y[1] = __uint_as_float(yb.x & 0xffff0000u); y[2] = __uint_as_float(yb.y << 16); y[3] = __uint_as_float(yb.y & 0xffff0000u);
        x[j] += GA[j] * (y * rinv);
        stf4(xo, lo + 1024u * j, x[j]); }
    }
    if (DOH) {
      float ss = 0.f;
#pragma unroll
      for (int j = 0; j < 8; ++j) ss += (x[j][0] * x[j][0] + x[j][1] * x[j][1]) + (x[j][2] * x[j][2] + x[j][3] * x[j][3]);
      const float r = __builtin_amdgcn_rsqf(wave_sum(ss) * (1.0f / 2048.0f) + NORM_EPS);
      bf16_t* hr = H + (size_t)row * DM;
#pragma unroll
      for (int j = 0; j < 8; ++j) { const f32x4 h = x[j] * r * GB[j] + SH[j]; u32x2 w; w.x = pk2(h[0], h[1]); w.y = pk2(h[2], h[3]);
        *(u32x2*)((char*)hr + lo2 + 512u * j) = w; }
    }
  }
}
template <bool UPD, bool DOH, int NKC = 0>
__device__ __forceinline__ void norm_phase(const float* xin_lat, const float* xin_ctx, float* xout_lat, float* xout_ctx, const bf16_t* Y, const float* ssq,
    const float* gA, const float* gateM, const float* gB, const float* scM, const float* shM, bf16_t* H, bool skipctx, int gw, int NGW, int lane, const float* part = nullptr) {
  for (int ch = gw; ch < 2 * SEQ / 16; ch += NGW) { const int b = ch / (SEQ / 16), row0 = b * TB + CTXL + (ch - b * (SEQ / 16)) * 16;
    norm_rows<UPD, DOH, 0>(row0, 16, xin_lat, xin_ctx, xout_lat, xout_ctx, Y, ssq, gA, gateM, gB, scM, shM, H, lane, part); }
  if (!skipctx)
    for (int r = gw; r < 2 * CTXL; r += NGW) { const int b = r / CTXL, row0 = b * TB + (r - b * CTXL);
      norm_rows<UPD, DOH, NKC>(row0, 1, xin_lat, xin_ctx, xout_lat, xout_ctx, Y, ssq, gA, gateM, gB, scM, shM, H, lane, part); }
}

__global__ void __launch_bounds__(512, 2) mk_fwd(Args a) {
  extern __shared__ __attribute__((aligned(16))) unsigned char lds[];
  cg::grid_group grid = cg::this_grid();
  const int wave = __builtin_amdgcn_readfirstlane(threadIdx.x >> 6);
  const int G = gridDim.x, c = blockIdx.x, gw = c * 8 + wave, NGW = G * 8;
  LAS unsigned char* ldsL = (LAS unsigned char*)lds;
  unsigned char* ws = a.ws;
  const int lo = a.ph_lo, hi = a.ph_hi;
#define IN(k) (lo <= (k) && (k) < hi)
  unsigned* barw = (unsigned*)(ws + CTL_ZERO_BYTES - 256); unsigned bar_epoch = 0;
#define OWN_BAR() do { __builtin_amdgcn_fence(__ATOMIC_RELEASE, "workgroup"); __builtin_amdgcn_s_barrier(); bar_epoch += (unsigned)G; \
    if (wave == 0) { if (lane_id_v() == 0) { __builtin_amdgcn_fence(__ATOMIC_ACQUIRE, "workgroup"); __builtin_amdgcn_fence(__ATOMIC_RELEASE, "agent"); \
      __hip_atomic_fetch_add(barw, 1u, __ATOMIC_RELAXED, __HIP_MEMORY_SCOPE_AGENT); \
      while (__hip_atomic_load(barw, __ATOMIC_RELAXED, __HIP_MEMORY_SCOPE_AGENT) < bar_epoch) __builtin_amdgcn_s_sleep(1); \
      __builtin_amdgcn_fence(__ATOMIC_ACQUIRE, "agent"); __builtin_amdgcn_fence(__ATOMIC_RELEASE, "workgroup"); } } \
    __builtin_amdgcn_s_barrier(); __builtin_amdgcn_fence(__ATOMIC_ACQUIRE, "workgroup"); } while (0)
#define SEAM(k) do { if (IN(k) && IN((k) + 1)) { if ((k) == 0) grid.sync(); else { OWN_BAR(); if ((PROBE_PH >> 20) & 1) OWN_BAR(); } } } while (0)
  float* MOD = (float*)(ws + WS_MOD); float* SSQ = (float*)(ws + WS_SSQ);
  const float* RT = (const float*)(ws + WS_ROPE); const float* CT = RT + 256 * 16 * 2;
  float* XC = (float*)(ws + WS_XC); float* PART = (float*)(ws + WS_PART);
  bf16_t* S1 = (bf16_t*)(ws + WS_S1); bf16_t* S2 = (bf16_t*)(ws + WS_S2);
  bf16_t* Qb = (bf16_t*)(ws + WS_Q); bf16_t* KVb = (bf16_t*)(ws + WS_KV); bf16_t* KRb = (bf16_t*)(ws + WS_KR); bf16_t* Gb = (bf16_t*)(ws + WS_G);
  const float* gn = a.in[6];
#define MODP(l, chunk) (MOD + (size_t)(l) * 3 * 12288 + (chunk) * 2048)
#define RUN_GEMM(MODE, Ap, lda_, Bp, N_, K_, skip, ...) do { pg8::Gemm g{Ap, Bp, NROW, N_, K_, lda_, K_}; pg8::RowSched S; S.init((skip) ? 128 : 130, (N_) / 256, G, c, (skip) ? 1 : 0, (K_) == DFF ? 1 : 0); \
    pg8::Epi<MODE> E{__VA_ARGS__}; pg8::gemm_phase<pg8::Epi<MODE>, pg8::RowSched, true, true>(ldsL, g, S, E, wave); } while (0)
#define RUN_CTX_SPLIT(Ap, Bp, K_, NKC_) do { pg8::Gemm g{Ap, Bp, NROW, 2048, (K_) / (NKC_), K_, K_}; pg8::CtxSplitSched S; S.init(8, NKC_, G, c); \
    pg8::Epi<6> E{nullptr, 2048, nullptr, nullptr, nullptr, RT, CT, PART}; pg8::gemm_phase<pg8::Epi<6>, pg8::CtxSplitSched, true, true>(ldsL, g, S, E, wave); } while (0)

  if (IN(0)) { REP(0) p0_prologue(a, ldsL, gw, NGW, wave, lane_id_v(), rep_PROBE0); __syncthreads(); } SEAM(0);
  if (IN(1)) REP(1) norm_phase<false, true>(a.in[0], a.in[2], nullptr, nullptr, nullptr, nullptr, nullptr, nullptr, gn + 0 * 2048, MODP(0, 1), MODP(0, 0), S1, false, gw, NGW, lane_id_v());
  SEAM(1);
  if (IN(2)) REP(2) RUN_GEMM(1, S1, 2048, (const bf16_t*)(ws + WS_WIN), NP1, 2048, false, S2, NP1, SSQP(0), nullptr, KRb, RT, CT);
  SEAM(2);
  if (IN(3)) REP(3) {
    RUN_GEMM(2, S2, NP1, (const bf16_t*)(ws + WS_WQB), NQ, 512, false, Qb, NQ, nullptr, SSQ, nullptr, RT, CT);
    RUN_GEMM(3, S2 + 512, NP1, (const bf16_t*)(ws + WS_WKVB), NKV, 512, false, KVb, NKV, nullptr, SSQ + NROW, nullptr, RT, CT);
  }
  SEAM(3);
  if (IN(4)) REP(4) {
    const float SC = 0.07216878364870322f, Cc = SC * 1.4426950408889634f, THRS = 8.f / SC;
    for (int r = 0;; ++r) {
      const int u = c + r * G; if (u >= 2080) break;
      int b, h, rowq, NT;
      if (u < 2048) { int pair, qb; if (G == 256) { pair = (c & 7) * 4 + (r >> 1); qb = (c >> 3) + 32 * (r & 1); } else { pair = u >> 6; qb = u & 63; }
        b = pair >> 4; h = pair & 15; rowq = b * TB + CTXL + qb * 256; NT = TB / 64; }
      else { const int p = u - 2048; b = p >> 4; h = p & 15; rowq = b * TB; NT = CTXL / 64; }
      att::attn_unit<128, 128, false>(Qb + (size_t)rowq * NQ + h * 192, NQ, KVb + h * 256, NKV, KRb, 64, KVb + h * 256 + 128, NKV, S1 + (size_t)rowq * DM + h * 128, DM,
                                      NT, NT, b * TB, 0, 0, 0, Cc, THRS, -INFINITY, (char*)lds, ldsL, wave);
    }
  }
  SEAM(4);
  if (IN(5)) REP(5) { RUN_GEMM(0, S1, 2048, (const bf16_t*)(ws + WS_WOM), 2048, 2048, true, S2, 2048, SSQP(2), nullptr, nullptr, RT, CT);
    RUN_CTX_SPLIT(S1, (const bf16_t*)(ws + WS_WOM), 2048, 8); }
  SEAM(5);
  if (IN(6)) norm_phase<true, true, 8>(a.in[0], a.in[2], a.out, XC, S2, SSQ + 2 * NROW, gn + 1 * 2048, MODP(0, 2), gn + 2 * 2048, MODP(0, 4), MODP(0, 3), S1, false, gw, NGW, lane_id_v(), PART);
  SEAM(6);
  if (IN(7)) REP(7) RUN_GEMM(4, S1, 2048, (const bf16_t*)(ws + WS_WF1), DFF, 2048, false, Gb, DFF, nullptr, nullptr, nullptr, RT, CT);
  SEAM(7);
  if (IN(8)) REP(8) { RUN_GEMM(0, Gb, DFF, (const bf16_t*)(ws + WS_WF2), 2048, DFF, true, S2, 2048, SSQP(3), nullptr, nullptr, RT, CT);
    RUN_CTX_SPLIT(Gb, (const bf16_t*)(ws + WS_WF2), DFF, 16); }
  SEAM(8);
  if (IN(9)) norm_phase<true, true, 16>(a.out, XC, a.out, XC, S2, SSQ + 3 * NROW, gn + 3 * 2048, MODP(0, 5), gn + 4 * 2048, MODP(1, 1), MODP(1, 0), S1, false, gw, NGW, lane_id_v(), PART);
  SEAM(9);
  if (IN(10)) REP(10) RUN_GEMM(5, S1, 2048, (const bf16_t*)(ws + WS_WQKV), NQKV, 2048, false, Gb, NQKV, nullptr, nullptr, nullptr, RT, CT);
  SEAM(10);
  if (IN(11)) REP(11) {
    const float SC = 0.125f, Cc = SC * 1.4426950408889634f, THRS = 8.f / SC;
    for (int u = c; u < 4096; u += G) {
      const int pair = u >> 6, qb = u & 63, b = pair >> 5, h = pair & 31, kvh = h >> 3, t0 = qb * 256;
      int tstart = t0 - 128, nwin = 8;
      if (t0 == 0) { tstart = 0; nwin = 6; }
      if (t0 == SEQ - 256) nwin = 6;
      const int rowq = b * TB + CTXL + t0;
      att::attn_unit<0, 64, true>(Gb + (size_t)rowq * NQKV + h * 64, NQKV, nullptr, 0, Gb + 2048 + kvh * 64, NQKV, Gb + 2304 + kvh * 64, NQKV, S1 + (size_t)rowq * DM + h * 64, DM,
                                  4 + nwin, 4, b * TB, b * TB + CTXL + tstart, t0, tstart, Cc, THRS, a.in[16][h] * 1.4426950408889634f, (char*)lds, ldsL, wave);
    }
  }
  SEAM(11);
  if (IN(12)) REP(12) RUN_GEMM(0, S1, 2048, (const bf16_t*)(ws + WS_WOS), 2048, 2048, true, S2, 2048, SSQP(4), nullptr, nullptr, RT, CT);
  SEAM(12);
  if (IN(13)) norm_phase<true, true>(a.out, XC, a.out, XC, S2, SSQ + 4 * NROW, gn + 5 * 2048, MODP(1, 2), gn + 6 * 2048, MODP(1, 4), MODP(1, 3), S1, true, gw, NGW, lane_id_v());
  SEAM(13);
  if (IN(14)) REP(14) RUN_GEMM(4, S1, 2048, (const bf16_t*)(ws + WS_WF1) + (size_t)2048 * 8192, DFF, 2048, true, Gb, DFF, nullptr, nullptr, nullptr, RT, CT);
  SEAM(14);
  if (IN(15)) REP(15) RUN_GEMM(0, Gb, DFF, (const bf16_t*)(ws + WS_WF2) + (size_t)2048 * 8192, 2048, DFF, true, S2, 2048, SSQP(5), nullptr, nullptr, RT, CT);
  SEAM(15);
  if (IN(16)) norm_phase<true, false>(a.out, XC, a.out, XC, S2, SSQ + 5 * NROW, gn + 7 * 2048, MODP(1, 5), nullptr, nullptr, nullptr, nullptr, true, gw, NGW, lane_id_v());
#undef IN
#undef SEAM
}

extern "C" void kernel_launch(void* const* d_in, const int* in_sizes, int n_in, void* d_out, int out_size, void* d_ws, size_t ws_size, hipStream_t stream) {
  static int grid = 0;
  if (grid == 0) {
    if (n_in != 18 || out_size != 2 * SEQ * DM || ws_size < WS_END) { fprintf(stderr, "kernel_launch: unexpected shapes: n_in %d out %d ws %zu (need %zu)\n", n_in, out_size, ws_size, (size_t)WS_END); grid = -1; return; }
    int dev = 0, cus = 0, per_cu = 0;
    hipGetDevice(&dev); hipDeviceGetAttribute(&cus, hipDeviceAttributeMultiprocessorCount, dev);
    if (hipFuncSetAttribute((const void*)mk_fwd, hipFuncAttributeMaxDynamicSharedMemorySize, LDS_BYTES) != hipSuccess) { fprintf(stderr, "kernel_launch: hipFuncSetAttribute failed\n"); grid = -1; return; }
    if (hipOccupancyMaxActiveBlocksPerMultiprocessor(&per_cu, (const void*)mk_fwd, 512, LDS_BYTES) != hipSuccess || per_cu < 1) { fprintf(stderr, "kernel_launch: occupancy query gave %d\n", per_cu); per_cu = 1; }
    (void)hipGetLastError();
    grid = cus * per_cu;
    fprintf(stderr, "kernel_launch: grid %d (cus %d x %d)\n", grid, cus, per_cu);
  }
  if (grid < 0) return;
  hipMemsetAsync((char*)d_ws, 0, CTL_ZERO_BYTES, stream);
  Args a{};
  for (int i = 0; i < 18; ++i) a.in[i] = (const float*)d_in[i];
  a.out = (float*)d_out; a.ws = (unsigned char*)d_ws; a.ph_lo = 0; a.ph_hi = N_PHASES;
  void* args[] = {&a};
  hipError_t e = hipLaunchCooperativeKernel((const void*)mk_fwd, dim3(grid), dim3(512), args, LDS_BYTES, stream);
  if (e != hipSuccess) fprintf(stderr, "kernel_launch: cooperative launch failed: %s (grid %d)\n", hipGetErrorString(e), grid);
}
```

```cpp
#include <hip/hip_runtime.h>
#include <hip/hip_cooperative_groups.h>
#include <cstdio>
#include <cstdint>
namespace cg = cooperative_groups;

constexpr int DM = 2048, SEQ = 16384, CTXL = 256, TB = SEQ + CTXL  , NROW = 2 * TB  , DFF = 8192;
constexpr int NP1 = 1280  , NQ = 3072, NKV = 4096, NQKV = 2560;
constexpr float NORM_EPS = 1e-6f;
__device__ __forceinline__ int lane_id_v() { int l; asm volatile("v_mbcnt_lo_u32_b32 %0, -1, 0\n\tv_mbcnt_hi_u32_b32 %0, -1, %0" : "=v"(l)); return l; }
namespace pg8 {
#define PG8_LAS __attribute__((address_space(3)))
typedef unsigned short bf16_t;
typedef short bf16x8 __attribute__((ext_vector_type(8)));
typedef float f32x4 __attribute__((ext_vector_type(4)));
typedef unsigned u32x4 __attribute__((ext_vector_type(4)));
constexpr int BM = 256, BK = 64, HALF = 128, HTB = HALF * BK * 2  , STAGE_BYTES = 8 * HTB, NXCD = 8, WGM = 8;

__host__ __device__ __forceinline__ int lds_byte(int r, int c) { const int st = (r >> 4) * 2 + (c >> 5), rr = r & 15, cc = c & 31, ob = rr * 64 + cc * 2; return st * 1024 + (ob ^ (((ob >> 9) & 1) << 5)); }
__host__ __device__ __forceinline__ void stage_rc(int b, int& R, int& C) { const int st = b / 1024, sb = b % 1024, swz = sb ^ (((sb >> 9) & 1) << 5); R = (st >> 1) * 16 + swz / 64; C = (st & 1) * 32 + (swz % 64) / 2; }
__host__ __device__ __forceinline__ int perm32(int rho) { const int n = rho >> 4, i = rho & 15; return 8 * (i >> 2) + 4 * n + (i & 3); }

struct Unit { int pm, pn, kc; };
struct Gemm { const bf16_t* A; const bf16_t* Bt; int M, N, K, lda, ldb; };

struct StaticOrder {
    int nM, nN, nwg, G, c;
    __host__ __device__ void init(int M, int N, int G_, int c_) { nM = M / BM; nN = N / BM; nwg = nM * nN; G = G_; c = c_; }
    __host__ __device__ bool next(int i, Unit& u) const {
        const long L = (long)i * G + c; if (L >= nwg) return false;
        int wgid = (int)L; { const int q = nwg / NXCD, r = nwg % NXCD, xcd = wgid % NXCD, off = wgid / NXCD; wgid = (xcd < r ? xcd * (q + 1) : r * (q + 1) + (xcd - r) * q) + off; }
        const int nig = WGM * nN, gid = wgid / nig, fm = gid * WGM, gsz = (nM - fm) < WGM ? (nM - fm) : WGM;
        u.pm = fm + ((wgid % nig) % gsz); u.pn = (wgid % nig) / gsz; return true;
    }
    __device__ __forceinline__ void a_ready(const Unit&) const {}
    __device__ __forceinline__ void done(const Unit&) const {}
};


__device__ __forceinline__ unsigned cvt_pk_bf16(float lo, float hi) { unsigned r; asm volatile("v_cvt_pk_bf16_f32 %0, %1, %2" : "=v"(r) : "v"(lo), "v"(hi)); return r; }

struct RowSched {
    int nM, nN, nwg, G, c, skipctx;
    __device__ void init(int nM_, int nN_, int G_, int c_, int skipctx_) { nM = nM_; nN = nN_; nwg = nM * nN; G = G_; c = c_; skipctx = skipctx_; }
    __device__ bool next(int i, Unit& u) const {
        const long L = (long)i * G + c; if (L >= nwg) return false;
        int wgid = (int)L; { const int q = nwg / NXCD, r = nwg % NXCD, xcd = wgid % NXCD, off = wgid / NXCD; wgid = (xcd < r ? xcd * (q + 1) : r * (q + 1) + (xcd - r) * q) + off; }
        const int nig = WGM * nN, gid = wgid / nig, fm = gid * WGM, gsz = (nM - fm) < WGM ? (nM - fm) : WGM;
        int pm = fm + ((wgid % nig) % gsz); u.pn = (wgid % nig) / gsz;
        if (skipctx) pm += 1 + (pm >= 64 ? 1 : 0);
        u.pm = pm; u.kc = 0; return true;
    }
    __device__ __forceinline__ void a_ready(const Unit&) const {}
    __device__ __forceinline__ void done(const Unit&) const {}
};

struct CtxSplitSched {
    int nN, NKC, nwg, G, c;
    __device__ void init(int nN_, int NKC_, int G_, int c_) { nN = nN_; NKC = NKC_; nwg = 2 * nN * NKC; G = G_; c = c_; }
    __device__ bool next(int i, Unit& u) const {
        const long L = (long)i * G + c; if (L >= nwg) return false;
        const int l = (int)L, t = l / NKC; u.kc = l - t * NKC; u.pn = t % nN; u.pm = (t / nN) ? 65 : 0; return true;
    }
    __device__ __forceinline__ void a_ready(const Unit&) const {}
    __device__ __forceinline__ void done(const Unit&) const {}
};

template <int MODE> struct Epi {
    static constexpr bool PERM = true, AFTER_DRAIN = false;
    bf16_t* O; int ldc;
    float* ssq;
    const float* rssq;
    bf16_t* KR;
    const float* rtab; const float* ctab;
    float* part;
    __device__ __forceinline__ void operator()(const f32x4 (&acc)[2][2][4][2], const Unit& u, int wr, int wc, int fr, int fq) const {
        const int pm = u.pm, pn = u.pn;
        const bool isctx = (pm == 0) || (pm == 65);
        const int tbase = (pm > 65 ? pm - 66 : pm - 1) * 256;
#pragma unroll
        for (int ai = 0; ai < 2; ++ai)
#pragma unroll
            for (int m = 0; m < 4; ++m) {
                const int rt = ai * HALF + wr * 64 + m * 16 + fr;
                const int row = pm * BM + rt;
                const int t = tbase + rt;
                float rs = 1.f;
                if (MODE == 2 || MODE == 3) rs = __builtin_amdgcn_rsqf(rssq[row] * (1.0f / 512.0f) + 1e-6f);
                float sq = 0.f;
#pragma unroll
                for (int bj = 0; bj < 2; ++bj) {
                    const int col = pn * BM + bj * HALF + wc * 32 + 8 * fq;
                    f32x4 v0 = acc[ai][bj][m][0], v1 = acc[ai][bj][m][1];
                    if (MODE == 6) { float* pp = part + ((size_t)u.kc * 512 + (pm == 65 ? 256 : 0) + rt) * ldc + col; *(f32x4*)pp = v0; *(f32x4*)(pp + 4) = v1; continue; }
                    if (MODE == 2 || MODE == 3) { v0 = v0 * rs; v1 = v1 * rs; }
                    if (MODE == 0 || MODE == 1) sq += (v0[0] * v0[0] + v0[1] * v0[1]) + (v0[2] * v0[2] + v0[3] * v0[3]) + (v1[0] * v1[0] + v1[1] * v1[1]) + (v1[2] * v1[2] + v1[3] * v1[3]);
                    bool dorope = false; int i0 = 0;
                    if (MODE == 2) { const int hc = col % 192; dorope = (!isctx) && (hc >= 128); i0 = (hc - 128) >> 1; }
                    if (MODE == 5) { dorope = (!isctx) && (col < 2304); i0 = (col & 63) >> 1; }
                    if (MODE == 1) { dorope = (!isctx) && (pn == 4) && (col < 1088); i0 = (col - 1024) >> 1; }
                    if (MODE == 1 || MODE == 2 || MODE == 5) {
                        if (dorope) {
                            const float* tb = (i0 < 16) ? (rtab + ((t >> 6) * 16 + i0) * 2) : (ctab + ((t & 63) * 16 + (i0 - 16)) * 2);
                            const f32x4 c0 = *(const f32x4*)tb, c1 = *(const f32x4*)(tb + 4);
                            f32x4 w0, w1;
                            w0[0] = v0[0] * c0[0] - v0[1] * c0[1]; w0[1] = v0[0] * c0[1] + v0[1] * c0[0];
                            w0[2] = v0[2] * c0[2] - v0[3] * c0[3]; w0[3] = v0[2] * c0[3] + v0[3] * c0[2];
                            w1[0] = v1[0] * c1[0] - v1[1] * c1[1]; w1[1] = v1[0] * c1[1] + v1[1] * c1[0];
                            w1[2] = v1[2] * c1[2] - v1[3] * c1[3]; w1[3] = v1[2] * c1[3] + v1[3] * c1[2];
                            v0 = w0; v1 = w1;
                        }
                    }
                    if (MODE == 4) {
#pragma unroll
                        for (int e = 0; e < 4; ++e) { const float a = fmaxf(v0[e], 0.f), b = fmaxf(v1[e], 0.f); v0[e] = a * a; v1[e] = b * b; }
                    }
                    u32x4 w; w.x = cvt_pk_bf16(v0[0], v0[1]); w.y = cvt_pk_bf16(v0[2], v0[3]); w.z = cvt_pk_bf16(v1[0], v1[1]); w.w = cvt_pk_bf16(v1[2], v1[3]);
                    if (MODE == 1 && pn == 4) { if (col < 1088) *(u32x4*)(KR + (size_t)row * 64 + (col - 1024)) = w; }
                    else *(u32x4*)(O + (size_t)row * ldc + col) = w;
                }
                if (MODE == 0 || MODE == 1) {
                    if (MODE == 0 || pn < 4) {
                        sq += __shfl_xor(sq, 16); sq += __shfl_xor(sq, 32);
                        if (fq == 0) atomicAdd(ssq + (MODE == 1 ? (size_t)(pn >> 1) * NROW : (size_t)0) + row, sq);
                    }
                }
            }
    }
};

template <class Epi, class Sched, bool ALIGN_EPI = false, bool SP2 = false>
__device__ __forceinline__ void gemm_phase(PG8_LAS unsigned char* lds, const Gemm g, const Sched& S, const Epi& E, const int wave_) {
    const int wid = wave_, lane = lane_id_v(), tid = wid * 64 + lane, wr = wid >> 2, wc = wid & 3, fr = lane & 15, fq = lane >> 4;
    const int K = g.K, nt = K / BK, lda = g.lda, ldb = g.ldb;
    unsigned voffA[2], voffB[2];
#pragma unroll
    for (int i = 0; i < 2; ++i) { int R, C; stage_rc(tid * 16 + i * 8192, R, C); const int Rb = Epi::PERM ? ((R & ~31) + perm32(R & 31)) : R;
        voffA[i] = (unsigned)(R * lda + C) * 2u; voffB[i] = (unsigned)(Rb * ldb + C) * 2u; }
    const size_t kstep = (size_t)(BK * 2);
    const size_t hstepA = (size_t)HALF * lda * 2, hstepB = (size_t)HALF * ldb * 2;
    const size_t tstepA = 2 * hstepA, tstepB = 2 * hstepB;
    const unsigned ldsw = (unsigned)wid * 1024u;
    const int aoff = lds_byte(wr * 64 + fr, fq * 8), boff = lds_byte(wc * 32 + fr, fq * 8);
#define PG8_SA(b, h) (((b) * 2 + (h)) * HTB)
#define PG8_SB(b, h) ((4 + (b) * 2 + (h)) * HTB)
#define PG8_STAGE(bufoff, gbase, voff) do { _Pragma("unroll") for (int _i = 0; _i < 2; ++_i) \
        __builtin_amdgcn_global_load_lds((const unsigned*)((const char*)(gbase) + (voff)[_i]), (PG8_LAS unsigned*)(lds + (bufoff) + ldsw + _i * 8192), 16, 0, 0); } while (0)
#define PG8_LDA(dst, b, h) do { _Pragma("unroll") for (int m = 0; m < 4; ++m) _Pragma("unroll") for (int k = 0; k < 2; ++k) dst[m][k] = *(const PG8_LAS bf16x8*)(lds + PG8_SA(b, h) + aoff + m * 2048 + k * 1024); } while (0)
#define PG8_LDB(dst, b, h) do { _Pragma("unroll") for (int n = 0; n < 2; ++n) _Pragma("unroll") for (int k = 0; k < 2; ++k) dst[n][k] = *(const PG8_LAS bf16x8*)(lds + PG8_SB(b, h) + boff + n * 2048 + k * 1024); } while (0)
#define PG8_MMA(ai, bj, At, Bt) do { __builtin_amdgcn_s_setprio(1); _Pragma("unroll") for (int m = 0; m < 4; ++m) _Pragma("unroll") for (int n = 0; n < 2; ++n) _Pragma("unroll") for (int k = 0; k < 2; ++k) \
        acc[ai][bj][m][n] = __builtin_amdgcn_mfma_f32_16x16x32_bf16(Bt[n][k], At[m][k], acc[ai][bj][m][n], 0, 0, 0); __builtin_amdgcn_s_setprio(0); } while (0)
#define PG8_WAIT_V(n) asm volatile("s_waitcnt vmcnt(" #n ")" ::: "memory")
#define PG8_WAIT_L(n) asm volatile("s_waitcnt lgkmcnt(" #n ")" ::: "memory")
#define PG8_BAR __builtin_amdgcn_s_barrier()
#define PG8_SCHED __builtin_amdgcn_sched_barrier(0)
    Unit cur, nxt; int ui = 0;
    if (!S.next(0, cur)) return;
    f32x4 acc[2][2][4][2];
#pragma unroll
    for (int a = 0; a < 2; ++a)
#pragma unroll
        for (int b = 0; b < 2; ++b)
#pragma unroll
            for (int m = 0; m < 4; ++m)
#pragma unroll
                for (int n = 0; n < 2; ++n) acc[a][b][m][n] = (f32x4){0.f, 0.f, 0.f, 0.f};
    bf16x8 At[4][2], B0[2][2], B1[2][2];
    const char* cA = (const char*)g.A + (size_t)cur.pm * tstepA + (size_t)cur.kc * K * 2; const char* cB = (const char*)g.Bt + (size_t)cur.pn * tstepB + (size_t)cur.kc * K * 2;
    S.a_ready(cur);
    if constexpr (SP2) {
        PG8_STAGE(PG8_SB(0, 0), cB, voffB); PG8_STAGE(PG8_SB(0, 1), cB + hstepB, voffB); PG8_STAGE(PG8_SA(0, 0), cA, voffA); PG8_STAGE(PG8_SA(0, 1), cA + hstepA, voffA);
        if (wr == 1) PG8_BAR;
        PG8_WAIT_V(2); PG8_BAR;
        PG8_STAGE(PG8_SB(1, 0), cB + kstep, voffB); PG8_STAGE(PG8_SA(1, 0), cA + kstep, voffA); PG8_STAGE(PG8_SB(1, 1), cB + hstepB + kstep, voffB);
        PG8_WAIT_V(6); PG8_BAR;
    } else {
        PG8_STAGE(PG8_SB(0, 0), cB, voffB); PG8_STAGE(PG8_SA(0, 0), cA, voffA); PG8_STAGE(PG8_SB(0, 1), cB + hstepB, voffB); PG8_STAGE(PG8_SA(0, 1), cA + hstepA, voffA);
        if (wr == 1) PG8_BAR;
        PG8_WAIT_V(4); PG8_BAR;
        PG8_STAGE(PG8_SB(1, 0), cB + kstep, voffB); PG8_STAGE(PG8_SA(1, 0), cA + kstep, voffA); PG8_STAGE(PG8_SB(1, 1), cB + hstepB + kstep, voffB);
        PG8_WAIT_V(6); PG8_BAR;
    }
    for (;;) {
        const bool has_next = S.next(ui + 1, nxt);
        const char* nA = has_next ? (const char*)g.A + (size_t)nxt.pm * tstepA + (size_t)nxt.kc * K * 2 : cA; const char* nB = has_next ? (const char*)g.Bt + (size_t)nxt.pn * tstepB + (size_t)nxt.kc * K * 2 : cB;
        for (int t = 0; t < nt; t += 2) {
            const bool last = (t == nt - 2);
            const char* a1 = cA + (size_t)(t + 1) * kstep;
            const char* a2 = last ? nA : cA + (size_t)(t + 2) * kstep; const char* b2 = last ? nB : cB + (size_t)(t + 2) * kstep;
            const char* a3 = a2 + kstep; const char* b3 = b2 + kstep;
            if (last && has_next) S.a_ready(nxt);
            if constexpr (SP2) {
            PG8_LDB(B0, 0, 0); PG8_LDB(B1, 0, 1); PG8_SCHED; PG8_LDA(At, 0, 0); PG8_STAGE(PG8_SA(1, 1), a1 + hstepA, voffA);
            PG8_WAIT_V(8); PG8_WAIT_L(0); PG8_BAR; PG8_MMA(0, 0, At, B0); PG8_MMA(0, 1, At, B1); PG8_BAR; PG8_SCHED;
            PG8_LDA(At, 0, 1); PG8_STAGE(PG8_SB(0, 0), b2, voffB); PG8_STAGE(PG8_SB(0, 1), b2 + hstepB, voffB); PG8_STAGE(PG8_SA(0, 0), a2, voffA);
            PG8_WAIT_V(8); PG8_WAIT_L(0); PG8_BAR; PG8_MMA(1, 0, At, B0); PG8_MMA(1, 1, At, B1); PG8_BAR; PG8_SCHED;
            PG8_LDB(B0, 1, 0); PG8_LDB(B1, 1, 1); PG8_SCHED; PG8_LDA(At, 1, 0); PG8_STAGE(PG8_SA(0, 1), a2 + hstepA, voffA);
            PG8_WAIT_V(8); PG8_WAIT_L(0); PG8_BAR; PG8_MMA(0, 0, At, B0); PG8_MMA(0, 1, At, B1); PG8_BAR; PG8_SCHED;
            PG8_LDA(At, 1, 1); PG8_STAGE(PG8_SB(1, 0), b3, voffB); PG8_STAGE(PG8_SB(1, 1), b3 + hstepB, voffB); PG8_STAGE(PG8_SA(1, 0), a3, voffA);
            PG8_WAIT_V(8); PG8_WAIT_L(0); PG8_BAR; PG8_MMA(1, 0, At, B0); PG8_MMA(1, 1, At, B1); PG8_BAR; PG8_SCHED;
            } else {
            PG8_LDB(B0, 0, 0); PG8_SCHED; PG8_LDA(At, 0, 0); PG8_STAGE(PG8_SA(1, 1), a1 + hstepA, voffA);
            PG8_WAIT_L(8); PG8_BAR; PG8_WAIT_L(0); PG8_MMA(0, 0, At, B0); PG8_BAR; PG8_SCHED;
            PG8_LDB(B1, 0, 1); PG8_STAGE(PG8_SB(0, 0), b2, voffB);
            PG8_BAR; PG8_WAIT_L(0); PG8_MMA(0, 1, At, B1); PG8_BAR;
            PG8_LDA(At, 0, 1); PG8_STAGE(PG8_SA(0, 0), a2, voffA);
            PG8_BAR; PG8_WAIT_L(0); PG8_MMA(1, 0, At, B0); PG8_BAR; PG8_SCHED;
            PG8_STAGE(PG8_SB(0, 1), b2 + hstepB, voffB);
            PG8_WAIT_V(6); PG8_BAR; PG8_MMA(1, 1, At, B1); PG8_BAR;
            PG8_LDB(B0, 1, 0); PG8_SCHED; PG8_LDA(At, 1, 0); PG8_STAGE(PG8_SA(0, 1), a2 + hstepA, voffA);
            PG8_WAIT_L(8); PG8_BAR; PG8_WAIT_L(0); PG8_MMA(0, 0, At, B0); PG8_BAR; PG8_SCHED;
            PG8_LDB(B1, 1, 1); PG8_STAGE(PG8_SB(1, 0), b3, voffB);
            PG8_BAR; PG8_WAIT_L(0); PG8_MMA(0, 1, At, B1); PG8_BAR;
            PG8_LDA(At, 1, 1); PG8_STAGE(PG8_SA(1, 0), a3, voffA);
            PG8_BAR; PG8_WAIT_L(0); PG8_MMA(1, 0, At, B0); PG8_BAR; PG8_SCHED;
            PG8_STAGE(PG8_SB(1, 1), b3 + hstepB, voffB);
            PG8_WAIT_V(6); PG8_BAR; PG8_MMA(1, 1, At, B1); PG8_BAR;
            }
        }
        if constexpr (ALIGN_EPI) { if (wr == 0) PG8_BAR; }
        if constexpr (!Epi::AFTER_DRAIN) { E(acc, cur, wr, wc, fr, fq); S.done(cur); }
        if (!has_next) break;
#pragma unroll
        for (int a = 0; a < 2; ++a)
#pragma unroll
            for (int b = 0; b < 2; ++b)
#pragma unroll
                for (int m = 0; m < 4; ++m)
#pragma unroll
                    for (int n = 0; n < 2; ++n) acc[a][b][m][n] = (f32x4){0.f, 0.f, 0.f, 0.f};
        cur = nxt; cA = nA; cB = nB; ++ui;
        if constexpr (ALIGN_EPI) { if (wr == 1) PG8_BAR; }
    }
    PG8_WAIT_V(0);
    if constexpr (!ALIGN_EPI) { if (wr == 0) PG8_BAR; }
    PG8_BAR;
    if constexpr (Epi::AFTER_DRAIN) { E.fused(acc, cur, wr, wc, fr, fq, lds, wid, lane); S.done(cur); }
#undef PG8_SA
#undef PG8_SB
#undef PG8_STAGE
#undef PG8_LDA
#undef PG8_LDB
#undef PG8_MMA
#undef PG8_WAIT_V
#undef PG8_WAIT_L
#undef PG8_BAR
#undef PG8_SCHED
}
}

namespace att {
typedef unsigned short bf16_t;
using bf16x8 = __attribute__((ext_vector_type(8))) short;
using s16x4  = __attribute__((ext_vector_type(4))) short;
using f32x16 = __attribute__((ext_vector_type(16))) float;
using u32x4  = __attribute__((ext_vector_type(4))) unsigned;
#define KSWZ(row, colB) ((row) * 256 + ((colB) ^ (((row) & 15) << 4)))
#define KSWZ64(row, colB) ((row) * 128 + ((colB) ^ ((((row) >> 1) & 7) << 4)))
#define SBAR() __builtin_amdgcn_sched_barrier(0)
__device__ __forceinline__ int crow(int r, int hi) { return (r & 3) + 8 * (r >> 2) + 4 * hi; }
__device__ __forceinline__ unsigned cvtpk(float lo, float hi) { unsigned r; asm volatile("v_cvt_pk_bf16_f32 %0, %1, %2" : "=v"(r) : "v"(lo), "v"(hi)); return r; }

__device__ __forceinline__ void partialSM(f32x16& p0, f32x16& p1, float& m_reg, float& alpha, const float C, const float THRS) {
  float pmax = p0[0];
#pragma unroll
  for (int r = 1; r < 16; ++r) pmax = fmaxf(pmax, p0[r]);
#pragma unroll
  for (int r = 0; r < 16; ++r) pmax = fmaxf(pmax, p1[r]);
  { auto rr = __builtin_amdgcn_permlane32_swap(__float_as_uint(pmax), __float_as_uint(pmax), false, false);
    pmax = fmaxf(__uint_as_float(rr[0]), __uint_as_float(rr[1])); }
  float mn;
  if (__builtin_expect(__all(pmax - m_reg <= THRS), 1)) { mn = m_reg; alpha = 1.f; }
  else { mn = fmaxf(m_reg, pmax); alpha = __builtin_amdgcn_exp2f((m_reg - mn) * C); m_reg = mn; }
  const float mnC = -mn * C;
#pragma unroll
  for (int r = 0; r < 16; ++r) p0[r] = fmaf(p0[r], C, mnC);
#pragma unroll
  for (int r = 0; r < 16; ++r) p1[r] = fmaf(p1[r], C, mnC);
#pragma unroll
  for (int r = 0; r < 16; ++r) p0[r] = __builtin_amdgcn_exp2f(p0[r]);
}
__device__ __forceinline__ void finishSM(f32x16& p0, f32x16& p1, float alpha, float& l_reg, bf16x8& pa0, bf16x8& pa1, bf16x8& pa2, bf16x8& pa3) {
#pragma unroll
  for (int r = 0; r < 16; ++r) p1[r] = __builtin_amdgcn_exp2f(p1[r]);
  float ps = 0;
#pragma unroll
  for (int r = 0; r < 16; ++r) ps += p0[r];
#pragma unroll
  for (int r = 0; r < 16; ++r) ps += p1[r];
  { auto rr = __builtin_amdgcn_permlane32_swap(__float_as_uint(ps), __float_as_uint(ps), false, false);
    ps = __uint_as_float(rr[0]) + __uint_as_float(rr[1]); }
  l_reg = l_reg * alpha + ps;
#define PK4(P, BASE, OUT) do { unsigned a0 = cvtpk(P[BASE + 0], P[BASE + 1]), a1 = cvtpk(P[BASE + 2], P[BASE + 3]);   \
    unsigned b0 = cvtpk(P[BASE + 4], P[BASE + 5]), b1 = cvtpk(P[BASE + 6], P[BASE + 7]);                              \
    auto r0 = __builtin_amdgcn_permlane32_swap(a0, b0, false, false); auto r1 = __builtin_amdgcn_permlane32_swap(a1, b1, false, false); \
    u32x4 w = {r0[0], r1[0], r0[1], r1[1]}; OUT = *reinterpret_cast<bf16x8*>(&w); } while (0)
  PK4(p0, 0, pa0); PK4(p0, 8, pa1); PK4(p1, 0, pa2); PK4(p1, 8, pa3);
#undef PK4
}
template <int DN>
__device__ __forceinline__ void qkt(f32x16& p0, f32x16& p1, const char* Kn, const char* Kr, const bf16x8* qr, const char* qrl, int r32, int hi) {
  p0 = f32x16{}; p1 = f32x16{};
  if constexpr (DN > 0) {
#pragma unroll
    for (int d0 = 0; d0 < DN / 16; ++d0) { const int cb = (d0 * 16 + hi * 8) * 2;
      bf16x8 b0 = *reinterpret_cast<const bf16x8*>(Kn + KSWZ(r32, cb));
      bf16x8 b1 = *reinterpret_cast<const bf16x8*>(Kn + KSWZ(32 + r32, cb));
      p0 = __builtin_amdgcn_mfma_f32_32x32x16_bf16(b0, qr[d0], p0, 0, 0, 0);
      p1 = __builtin_amdgcn_mfma_f32_32x32x16_bf16(b1, qr[d0], p1, 0, 0, 0); }
  }
#pragma unroll
  for (int d0 = 0; d0 < 4; ++d0) { const int cb = (d0 * 16 + hi * 8) * 2;
    bf16x8 b0 = *reinterpret_cast<const bf16x8*>(Kr + KSWZ64(r32, cb));
    bf16x8 b1 = *reinterpret_cast<const bf16x8*>(Kr + KSWZ64(32 + r32, cb));
    bf16x8 q; if constexpr (DN > 0) q = *reinterpret_cast<const bf16x8*>(qrl + d0 * 1024); else q = qr[d0];
    p0 = __builtin_amdgcn_mfma_f32_32x32x16_bf16(b0, q, p0, 0, 0, 0);
    p1 = __builtin_amdgcn_mfma_f32_32x32x16_bf16(b1, q, p1, 0, 0, 0); }
}
__device__ __forceinline__ void band_mask(f32x16& p0, f32x16& p1, int d) {
#pragma unroll
  for (int r = 0; r < 16; ++r) { const int v = d - ((r & 3) + 8 * (r >> 2));
    if (v > 128 || v < -128) p0[r] = -1e30f;
    if (v - 32 > 128 || v - 32 < -128) p1[r] = -1e30f; }
}
__device__ __forceinline__ int v_rd_base(int lane) { return ((lane & 3) << 3) | (((lane >> 2) & 3) << 6) | (((lane >> 4) & 1) << 5) | (((lane >> 5) & 1) << 8); }
template <int NCB> constexpr int v_rd_off(int d0, int ks, int half) { return d0 * 512 + ks * (2 * NCB * 512) + half * (NCB * 512); }
template <int OFF> __device__ __forceinline__ s16x4 tr_read(int vb) {
  s16x4 r; asm volatile("ds_read_b64_tr_b16 %0, %1 offset:%2" : "=&v"(r) : "v"(vb), "i"(OFF) : "memory"); return r;
}
template <int D0, int NCB> __device__ __forceinline__ void pv_one(f32x16& od, int vb, bf16x8 pa0, bf16x8 pa1, bf16x8 pa2, bf16x8 pa3) {
  const s16x4 l0 = tr_read<v_rd_off<NCB>(D0, 0, 0)>(vb), h0 = tr_read<v_rd_off<NCB>(D0, 0, 1)>(vb), l1 = tr_read<v_rd_off<NCB>(D0, 1, 0)>(vb), h1 = tr_read<v_rd_off<NCB>(D0, 1, 1)>(vb);
  const s16x4 l2 = tr_read<v_rd_off<NCB>(D0, 2, 0)>(vb), h2 = tr_read<v_rd_off<NCB>(D0, 2, 1)>(vb), l3 = tr_read<v_rd_off<NCB>(D0, 3, 0)>(vb), h3 = tr_read<v_rd_off<NCB>(D0, 3, 1)>(vb);
  asm volatile("s_waitcnt lgkmcnt(0)" ::: "memory"); SBAR();
#define PK(L, H) (bf16x8){L[0], L[1], L[2], L[3], H[0], H[1], H[2], H[3]}
  od = __builtin_amdgcn_mfma_f32_32x32x16_bf16(pa0, PK(l0, h0), od, 0, 0, 0);
  od = __builtin_amdgcn_mfma_f32_32x32x16_bf16(pa1, PK(l1, h1), od, 0, 0, 0);
  od = __builtin_amdgcn_mfma_f32_32x32x16_bf16(pa2, PK(l2, h2), od, 0, 0, 0);
  od = __builtin_amdgcn_mfma_f32_32x32x16_bf16(pa3, PK(l3, h3), od, 0, 0, 0);
#undef PK
}
template <int NCB> __device__ __forceinline__ void pv_all(f32x16* o, int vb, bf16x8 pa0, bf16x8 pa1, bf16x8 pa2, bf16x8 pa3) {
  pv_one<0, NCB>(o[0], vb, pa0, pa1, pa2, pa3); pv_one<1, NCB>(o[1], vb, pa0, pa1, pa2, pa3);
  if constexpr (NCB == 4) { pv_one<2, NCB>(o[2], vb, pa0, pa1, pa2, pa3); pv_one<3, NCB>(o[3], vb, pa0, pa1, pa2, pa3); }
}

#define ATT_LAS __attribute__((address_space(3)))
template <int DN, int DV, bool MASK>
__device__ __forceinline__ void attn_unit(const bf16_t* __restrict__ Qb, const int ldq, const bf16_t* __restrict__ Kn, const int ldkn,
    const bf16_t* __restrict__ Kr, const int ldkr, const bf16_t* __restrict__ Vp, const int ldv, bf16_t* __restrict__ Ob, const int ldo,
    const int NT, const int n1, const int r1, const int r2, const int qpos0, const int kt2,
    const float C, const float THRS, const float sinkl2, char* lds, ATT_LAS unsigned char* ldsL, const int wave_) {
  constexpr int NQR = DN > 0 ? DN / 16 : 4, NCB = DV / 32, VB = 64 * DV * 2, KNB = 64 * DN * 2, KRB = 64 * 64 * 2, BUF = VB + KNB + KRB;
  constexpr int NVC = VB / 8192, NKC = KNB / 8192;
  const int wid = wave_, lane = lane_id_v(), r32 = lane & 31, hi = lane >> 5;
  char* Vl = lds; char* Knl = lds + VB; char* Krl = lds + VB + KNB;
  float* wsf = (float*)(lds + 3 * BUF) + wid * 64; float* li_l = wsf; float* al_l = wsf + 32;
  float m_reg = -1e30f, l_reg = 0; f32x16 o[NCB] = {}; bf16x8 qr[NQR];
  const bf16_t* Qw = Qb + (long)(wid * 32 + r32) * ldq + hi * 8;
#pragma unroll
  for (int d0 = 0; d0 < NQR; ++d0) qr[d0] = *reinterpret_cast<const bf16x8*>(Qw + d0 * 16);
  char* qrl = lds + 3 * BUF + 2048 + wid * 4096 + lane * 16;
  if constexpr (DN > 0) {
#pragma unroll
    for (int d0 = 0; d0 < 4; ++d0) *reinterpret_cast<bf16x8*>(qrl + d0 * 1024) = *reinterpret_cast<const bf16x8*>(Qw + DN + d0 * 16);
  }
  int offV[NVC], offK[NKC > 0 ? NKC : 1], offR;
#pragma unroll
  for (int i = 0; i < NVC; ++i) { const int ch = wid * NVC + i, sub = ch * 2 + (lane >> 5), kk = (sub / NCB) * 8 + ((lane & 31) >> 2), col = (sub % NCB) * 32 + (lane & 3) * 8;
    const int k = (kk & ~0xC) | ((kk & 4) << 1) | ((kk & 8) >> 1); offV[i] = k * ldv + col; }
#pragma unroll
  for (int i = 0; i < NKC; ++i) { const int ch = wid * NKC + i, row = ch * 4 + (lane >> 4), cb = ((lane & 15) * 16) ^ ((row & 15) << 4); offK[i] = row * ldkn + (cb >> 1); }
  { const int row = wid * 8 + (lane >> 3), cb = ((lane & 7) * 16) ^ (((row >> 1) & 7) << 4); offR = row * ldkr + (cb >> 1); }
  const int vb0 = (int)(uintptr_t)Vl + v_rd_base(lane);
  const int qd = qpos0 + wid * 32 + r32 - 4 * hi;
#define TROW(j) ((j) < n1 ? r1 + 64 * (j) : r2 + 64 * ((j) - n1))
#define DMA(j, b) do { const long row0_ = TROW(j); \
    _Pragma("unroll") for (int i_ = 0; i_ < NVC; ++i_) __builtin_amdgcn_global_load_lds((const unsigned*)(Vp + row0_ * ldv + offV[i_]), (ATT_LAS unsigned*)(ldsL + (b) + (wid * NVC + i_) * 1024), 16, 0, 0); \
    _Pragma("unroll") for (int i_ = 0; i_ < NKC; ++i_) __builtin_amdgcn_global_load_lds((const unsigned*)(Kn + row0_ * ldkn + offK[i_]), (ATT_LAS unsigned*)(ldsL + (b) + VB + (wid * NKC + i_) * 1024), 16, 0, 0); \
    __builtin_amdgcn_global_load_lds((const unsigned*)(Kr + row0_ * ldkr + offR), (ATT_LAS unsigned*)(ldsL + (b) + VB + KNB + wid * 1024), 16, 0, 0); } while (0)
#define WAITV() asm volatile("s_waitcnt vmcnt(0)" ::: "memory")
  const int q0w = qpos0 + wid * 32;
#define KP(j) (kt2 + 64 * ((j) - n1))
#define NEED(j) (!MASK || (j) < n1 || (KP(j) <= q0w + 159 && KP(j) + 63 >= q0w - 128))
#define SCORE(P0, P1, b, j) do { qkt<DN>(P0, P1, Knl + (b), Krl + (b), qr, qrl, r32, hi); \
    if constexpr (MASK) { if ((j) >= n1 && !(KP(j) >= q0w - 97 && KP(j) <= q0w + 65)) band_mask(P0, P1, qd - KP(j)); } } while (0)
#define RESC(a) do { if (__any((a) < 1.f)) { const int l_ = lane_id_v(); if (l_ < 32) al_l[l_] = (a); asm volatile("s_waitcnt lgkmcnt(0)" ::: "memory"); \
    _Pragma("unroll") for (int d = 0; d < NCB; ++d) _Pragma("unroll") for (int r = 0; r < 16; ++r) o[d][r] *= al_l[crow(r, l_ >> 5)]; } } while (0)
#define ROT() do { const int t_ = bp; bp = bc; bc = bn; bn = t_; } while (0)
  f32x16 pA0, pA1, pB0, pB1; float alA, alB; bf16x8 pa0, pa1, pa2, pa3;
  int bp = 0, bc = BUF, bn = 2 * BUF;
  DMA(0, 0); DMA(1, BUF); WAITV(); __syncthreads();
  SCORE(pA0, pA1, 0, 0); partialSM(pA0, pA1, m_reg, alA, C, THRS);
  bool nA = true, nB = true;
  for (int j = 1; j + 1 < NT; j += 2) {
    DMA(j + 1, bn);
    nB = NEED(j);
    SBAR(); if (nB) SCORE(pB0, pB1, bc, j);
    if (nA) finishSM(pA0, pA1, alA, l_reg, pa0, pa1, pa2, pa3); SBAR();
    if (nA) pv_all<NCB>(o, vb0 + bp, pa0, pa1, pa2, pa3);
    if (nB) { partialSM(pB0, pB1, m_reg, alB, C, THRS); RESC(alB); }
    WAITV(); __syncthreads(); ROT();
    DMA(j + 2, bn);
    nA = NEED(j + 1);
    SBAR(); if (nA) SCORE(pA0, pA1, bc, j + 1);
    if (nB) finishSM(pB0, pB1, alB, l_reg, pa0, pa1, pa2, pa3); SBAR();
    if (nB) pv_all<NCB>(o, vb0 + bp, pa0, pa1, pa2, pa3);
    if (nA) { partialSM(pA0, pA1, m_reg, alA, C, THRS); RESC(alA); }
    WAITV(); __syncthreads(); ROT();
  }
  nB = NEED(NT - 1);
  SBAR(); if (nB) SCORE(pB0, pB1, bc, NT - 1);
  if (nA) finishSM(pA0, pA1, alA, l_reg, pa0, pa1, pa2, pa3); SBAR();
  if (nA) pv_all<NCB>(o, vb0 + bp, pa0, pa1, pa2, pa3);
  if (nB) { partialSM(pB0, pB1, m_reg, alB, C, THRS);
    RESC(alB);
    finishSM(pB0, pB1, alB, l_reg, pa0, pa1, pa2, pa3); SBAR();
    pv_all<NCB>(o, vb0 + bc, pa0, pa1, pa2, pa3); }
  l_reg += __builtin_amdgcn_exp2f(sinkl2 - m_reg * C);
  const int lane2 = lane_id_v(), r32e = lane2 & 31, hie = lane2 >> 5;
  if (hie == 0) li_l[r32e] = l_reg; asm volatile("s_waitcnt lgkmcnt(0)" ::: "memory");
  float rli[16];
#pragma unroll
  for (int r = 0; r < 16; ++r) rli[r] = __builtin_amdgcn_rcpf(li_l[crow(r, hie)]);
  bf16_t* Ow = Ob + (long)(wid * 32) * ldo;
#pragma unroll
  for (int r = 0; r < 16; ++r) { const int orow = crow(r, hie);
#pragma unroll
    for (int d0 = 0; d0 < NCB; ++d0) Ow[(long)orow * ldo + d0 * 32 + r32e] = (bf16_t)(cvtpk(o[d0][r] * rli[r], 0.f) & 0xffffu); }
  __syncthreads();
#undef TROW
#undef DMA
#undef WAITV
#undef SCORE
#undef RESC
#undef ROT
#undef KP
#undef NEED
}
}

constexpr size_t MiB = 1u << 20;
constexpr size_t WS_MOD = 0;
constexpr size_t WS_SSQ = 512 * 1024;
constexpr size_t WS_ROPE = 1792 * 1024;
constexpr size_t CTL_ZERO_BYTES = 2 * MiB;
constexpr size_t WS_XC = 2 * MiB;
constexpr size_t WS_WIN = 8 * MiB, WS_WQB = 13 * MiB, WS_WKVB = 16 * MiB, WS_WOM = 20 * MiB, WS_WF1 = 28 * MiB, WS_WF2 = 92 * MiB, WS_WQKV = 156 * MiB, WS_WOS = 166 * MiB;
constexpr size_t WS_S1 = 176 * MiB;
constexpr size_t WS_S2 = 306 * MiB;
constexpr size_t WS_G = 436 * MiB;
constexpr size_t WS_Q = WS_G, WS_KV = WS_G + 196 * MiB, WS_KR = WS_G + 456 * MiB;
constexpr size_t WS_PART = WS_G + 520 * MiB;
constexpr size_t WS_END = WS_PART + 64 * MiB;
static_assert((size_t)NROW * 2048 * 2 == 130 * MiB && WS_SSQ + 8 * (size_t)NROW * 4 <= WS_ROPE && (size_t)NROW * NQ * 2 <= 196 * MiB && (size_t)NROW * NKV * 2 <= 260 * MiB, "ws map");

#define LAS __attribute__((address_space(3)))
typedef unsigned short bf16_t;
typedef float f32x4 __attribute__((ext_vector_type(4)));
typedef unsigned u32x4 __attribute__((ext_vector_type(4)));
typedef unsigned u32x2 __attribute__((ext_vector_type(2)));
constexpr int LDS_BYTES = 3 * 40960 + 2048 + 32768;
constexpr int N_PHASES = 17;
#ifndef PROBE_PH
#define PROBE_PH -1
#endif
#ifndef PROBE_PH2
#define PROBE_PH2 -1
#endif
#if PROBE_PH >= 0
#define rep_PROBE0 (rep_ != 0)
#define REP(k) for (int rep_ = 0; rep_ < ((((PROBE_PH) >> (k)) & 1) ? 2 : 1); ++rep_)
#define SSQP(i) (rep_ ? SSQ + 6 * NROW : SSQ + (i) * NROW)
#else
#define rep_PROBE0 false
#define REP(k)
#define SSQP(i) (SSQ + (i) * NROW)
#endif

struct Args { const float* in[18]; float* out; unsigned char* ws; int ph_lo, ph_hi; };

__device__ __forceinline__ float wave_sum(float v) {
#pragma unroll
  for (int o = 1; o < 64; o <<= 1) v += __shfl_xor(v, o);
  return v;
}
__device__ __forceinline__ unsigned pk2(float lo, float hi) { unsigned r; asm volatile("v_cvt_pk_bf16_f32 %0, %1, %2" : "=v"(r) : "v"(lo), "v"(hi)); return r; }

__device__ __forceinline__ int dest_row(int mode, int n) {
  if (mode == 1) { if (n < 1024) return n; const int j = n - 1024; return 1024 + (((j & 31) << 1) | (j >> 5)); }
  if (mode == 2) { const int h = n / 192, d = n - h * 192; if (d < 128) return n; const int j = d - 128; return h * 192 + 128 + (((j & 31) << 1) | (j >> 5)); }
  if (mode == 3) { if (n >= 2304) return n; const int d = n & 63; return (n & ~63) + (((d & 31) << 1) | (d >> 5)); }
  return n;
}
__device__ __forceinline__ void tr_item(const float* __restrict__ W, int K, int N, bf16_t* __restrict__ WT, const float* __restrict__ ks, int mode, LAS float* scr, int item, int lane) {
  const int nblk = N / 32, kb = item / nblk, nb = item - kb * nblk, k0 = 64 * kb, n0 = 32 * nb;
  float wv[32];
#pragma unroll
  for (int i = 0; i < 32; ++i) wv[i] = W[(size_t)(k0 + 2 * i + (lane >> 5)) * N + n0 + (lane & 31)];
  if (ks) {
#pragma unroll
    for (int i = 0; i < 32; ++i) wv[i] *= ks[k0 + 2 * i + (lane >> 5)];
  }
#pragma unroll
  for (int i = 0; i < 32; ++i) scr[(2 * i + (lane >> 5)) * 33 + (lane & 31)] = wv[i];
  asm volatile("s_waitcnt lgkmcnt(0)" ::: "memory");
  const int c = lane & 7;
#pragma unroll
  for (int j = 0; j < 4; ++j) { const int n = (lane >> 3) + 8 * j; const LAS float* s = scr + (8 * c) * 33 + n;
    u32x4 o; o.x = pk2(s[0 * 33], s[1 * 33]); o.y = pk2(s[2 * 33], s[3 * 33]); o.z = pk2(s[4 * 33], s[5 * 33]); o.w = pk2(s[6 * 33], s[7 * 33]);
    *(u32x4*)(WT + (size_t)dest_row(mode, n0 + n) * K + k0 + 8 * c) = o; }
  asm volatile("s_waitcnt lgkmcnt(0)" ::: "memory");
}

__device__ __forceinline__ float silu_f(float x) { return x / (1.f + __expf(-x)); }

constexpr int TI0 = 32 * 34, TI1 = 8 * 96, TI2 = 8 * 128, TI3 = 32 * 64, TI4 = 32 * 256, TI6 = 128 * 64, TI8 = 32 * 80, TI9 = 32 * 64;
constexpr int N_EARLY = TI0 + TI1 + TI2, N_LATE = TI3 + 2 * TI4 + 2 * TI6 + TI8 + TI9;
__device__ __forceinline__ void tr_dispatch(const Args& a, int it  , LAS float* scr, int lane) {
  unsigned char* ws = a.ws;
  int r = it; const float* W; int K, N, mode = 0; const float* ks = nullptr; bf16_t* dst;
  if (r < TI0) { W = a.in[9]; K = 2048; N = 1088; mode = 1; dst = (bf16_t*)(ws + WS_WIN); }
  else if ((r -= TI0) < TI1) { W = a.in[12]; K = 512; N = 3072; mode = 2; ks = a.in[10]; dst = (bf16_t*)(ws + WS_WQB); }
  else if ((r -= TI1) < TI2) { W = a.in[13]; K = 512; N = 4096; ks = a.in[11]; dst = (bf16_t*)(ws + WS_WKVB); }
  else if ((r -= TI2) < TI3) { W = a.in[14]; K = 2048; N = 2048; dst = (bf16_t*)(ws + WS_WOM); }
  else if ((r -= TI3) < 2 * TI4) { const int l = r / TI4; r -= l * TI4; W = a.in[7] + (size_t)l * 2048 * 8192; K = 2048; N = 8192; dst = (bf16_t*)(ws + WS_WF1) + (size_t)l * 2048 * 8192; }
  else if ((r -= 2 * TI4) < 2 * TI6) { const int l = r / TI6; r -= l * TI6; W = a.in[8] + (size_t)l * 2048 * 8192; K = 8192; N = 2048; dst = (bf16_t*)(ws + WS_WF2) + (size_t)l * 2048 * 8192; }
  else if ((r -= 2 * TI6) < TI8) { W = a.in[15]; K = 2048; N = 2560; mode = 3; dst = (bf16_t*)(ws + WS_WQKV); }
  else { r -= TI8; W = a.in[17]; K = 2048; N = 2048; dst = (bf16_t*)(ws + WS_WOS); }
  tr_item(W, K, N, dst, ks, mode, scr, r, lane);
}

__device__ __forceinline__ void p0_prologue(const Args& a, LAS unsigned char* lds, int gw, int NGW, int wave, int lane, bool only_transposes) {
  unsigned char* ws = a.ws;
  LAS float* scr = (LAS float*)(lds + wave * 16384);
  for (int it = gw; it < N_EARLY + N_LATE; it += NGW) tr_dispatch(a, it, scr, lane);
  if (only_transposes) return;
  float* MOD = (float*)(ws + WS_MOD);
  for (int it = gw; it < 2 * 48 * 64; it += NGW) {
    const int kc = it & 63, cb = (it >> 6) % 48, l = it / (64 * 48);
    const int n0 = cb * 256 + lane * 4, k0 = kc * 32;
    const float* Wm = a.in[4] + (size_t)l * 2048 * 12288 + n0;
    f32x4 a0 = {0.f, 0.f, 0.f, 0.f}, a1 = a0, a2 = a0;
#pragma unroll 16
    for (int k = 0; k < 32; ++k) { const int kk = k0 + k;
      const float s0 = silu_f(a.in[1][kk]), s1 = silu_f(a.in[1][2048 + kk]), s2 = silu_f(a.in[3][kk]);
      const f32x4 w = *(const f32x4*)(Wm + (size_t)kk * 12288);
      a0 += w * s0; a1 += w * s1; a2 += w * s2; }
    if (kc == 0) { const f32x4 b = *(const f32x4*)(a.in[5] + l * 12288 + n0); a0 += b; a1 += b; a2 += b; }
    float* mo = MOD + (size_t)(l * 3) * 12288 + n0;
#pragma unroll
    for (int e = 0; e < 4; ++e) { atomicAdd(mo + e, a0[e]); atomicAdd(mo + 12288 + e, a1[e]); atomicAdd(mo + 2 * 12288 + e, a2[e]); }
  }
  float* tab = (float*)(ws + WS_ROPE);
  for (int e = gw * 64 + lane; e < 320 * 16; e += NGW * 64) {
    const int i = e & 15, pos = e >> 4; const float p = (float)(pos < 256 ? pos : pos - 256);
    const float freq = exp2f(-(float)i * 0.8304820237218406f); const float ang = p * freq;
    tab[e * 2] = cosf(ang); tab[e * 2 + 1] = sinf(ang);
  }
}

__device__ __forceinline__ f32x4 ldf4(const float* base, unsigned boff) { return *(const f32x4*)((const char*)base + boff); }
__device__ __forceinline__ void stf4(float* base, unsigned boff, f32x4 v) { *(f32x4*)((char*)base + boff) = v; }
template <bool UPD, bool DOH, int NKC>
__device__ __forceinline__ void norm_rows(const int row0, const int nrows, const float* xin_lat, const float* xin_ctx, float* xout_lat, float* xout_ctx, const bf16_t* Y, const float* ssq,
    const float* gA, const float* gateM, const float* gB, const float* scM, const float* shM, bf16_t* H, int lane, const float* part) {
  const int b = row0 / TB, rb = row0 - b * TB; const bool isctx = rb < CTXL;
  const int v = isctx ? 2 : b;
  const size_t xoff = isctx ? (size_t)(b * CTXL + rb) * DM : (size_t)(b * SEQ + rb - CTXL) * DM;
  const float* xin = (isctx ? xin_ctx : xin_lat) + xoff;
  float* xout = UPD ? ((isctx ? xout_ctx : xout_lat) + xoff) : nullptr;
  const int lane_ = lane_id_v();
  const unsigned lo = (unsigned)lane_ * 16u, lo2 = (unsigned)lane_ * 8u;
  f32x4 GA[8], GB[8], SH[8];
#pragma unroll
  for (int j = 0; j < 8; ++j) { const unsigned o = lo + 1024u * j;
    if (UPD) GA[j] = ldf4(gateM + v * 12288, o) * ldf4(gA, o);
    if (DOH) { GB[j] = ldf4(gB, o) * (ldf4(scM + v * 12288, o) + 1.0f); SH[j] = ldf4(shM + v * 12288, o); } }
  f32x4 xn[8]; u32x2 yn[8];
#pragma unroll
  for (int j = 0; j < 8; ++j) { xn[j] = ldf4(xin, lo + 1024u * j); if (UPD && !(NKC > 0 && isctx)) yn[j] = *(const u32x2*)((const char*)(Y + (size_t)row0 * DM) + lo2 + 512u * j); }
  for (int rr = 0; rr < nrows; ++rr) {
    const int row = row0 + rr;
    f32x4 x[8]; u32x2 yc[8];
#pragma unroll
    for (int j = 0; j < 8; ++j) { x[j] = xn[j]; if (UPD) yc[j] = yn[j]; }
    if (rr + 1 < nrows) { const float* xr = xin + (size_t)(rr + 1) * DM;
#pragma unroll
      for (int j = 0; j < 8; ++j) { xn[j] = ldf4(xr, lo + 1024u * j); if (UPD && !(NKC > 0 && isctx)) yn[j] = *(const u32x2*)((const char*)(Y + (size_t)(row + 1) * DM) + lo2 + 512u * j); } }
    if (UPD && NKC > 0 && isctx) {
      f32x4 y[8]; float ys = 0.f; const float* pr = part + (size_t)(b * CTXL + rb + rr) * DM;
#pragma unroll
      for (int j = 0; j < 8; ++j) y[j] = ldf4(pr, lo + 1024u * j);
#pragma unroll 1
      for (int k = 1; k < NKC; ++k) { pr += (size_t)512 * DM;
#pragma unroll
        for (int j = 0; j < 8; ++j) y[j] += ldf4(pr, lo + 1024u * j); }
#pragma unroll
      for (int j = 0; j < 8; ++j) ys += (y[j][0] * y[j][0] + y[j][1] * y[j][1]) + (y[j][2] * y[j][2] + y[j][3] * y[j][3]);
      const float rinv = __builtin_amdgcn_rsqf(wave_sum(ys) * (1.0f / 2048.0f) + NORM_EPS);
      float* xo = xout + (size_t)rr * DM;
#pragma unroll
      for (int j = 0; j < 8; ++j) { x[j] += GA[j] * (y[j] * rinv); stf4(xo, lo + 1024u * j, x[j]); }
    } else if (UPD) {
      const float rinv = __builtin_amdgcn_rsqf(ssq[row] * (1.0f / 2048.0f) + NORM_EPS);
      float* xo = xout + (size_t)rr * DM;
#pragma unroll
      for (int j = 0; j < 8; ++j) { const u32x2 yb = yc[j];
        f32x4 y; y[0] = __uint_as_float(yb.x << 16); y[1] = __uint_as_float(yb.x & 0xffff0000u); y[2] = __uint_as_float(yb.y << 16); y[3] = __uint_as_float(yb.y & 0xffff0000u);
        x[j] += GA[j] * (y * rinv);
        stf4(xo, lo + 1024u * j, x[j]); }
    }
    if (DOH) {
      float ss = 0.f;
#pragma unroll
      for (int j = 0; j < 8; ++j) ss += (x[j][0] * x[j][0] + x[j][1] * x[j][1]) + (x[j][2] * x[j][2] + x[j][3] * x[j][3]);
      const float r = __builtin_amdgcn_rsqf(wave_sum(ss) * (1.0f / 2048.0f) + NORM_EPS);
      bf16_t* hr = H + (size_t)row * DM;
#pragma unroll
      for (int j = 0; j < 8; ++j) { const f32x4 h = x[j] * r * GB[j] + SH[j]; u32x2 w; w.x = pk2(h[0], h[1]); w.y = pk2(h[2], h[3]);
        *(u32x2*)((char*)hr + lo2 + 512u * j) = w; }
    }
  }
}
template <bool UPD, bool DOH, int NKC = 0>
__device__ __forceinline__ void norm_phase(const float* xin_lat, const float* xin_ctx, float* xout_lat, float* xout_ctx, const bf16_t* Y, const float* ssq,
    const float* gA, const float* gateM, const float* gB, const float* scM, const float* shM, bf16_t* H, bool skipctx, int gw, int NGW, int lane, const float* part = nullptr) {
  for (int ch = gw; ch < 2 * SEQ / 16; ch += NGW) { const int b = ch / (SEQ / 16), row0 = b * TB + CTXL + (ch - b * (SEQ / 16)) * 16;
    norm_rows<UPD, DOH, 0>(row0, 16, xin_lat, xin_ctx, xout_lat, xout_ctx, Y, ssq, gA, gateM, gB, scM, shM, H, lane, part); }
  if (!skipctx)
    for (int r = gw; r < 2 * CTXL; r += NGW) { const int b = r / CTXL, row0 = b * TB + (r - b * CTXL);
      norm_rows<UPD, DOH, NKC>(row0, 1, xin_lat, xin_ctx, xout_lat, xout_ctx, Y, ssq, gA, gateM, gB, scM, shM, H, lane, part); }
}

__global__ void __launch_bounds__(512, 2) mk_fwd(Args a) {
  extern __shared__ __attribute__((aligned(16))) unsigned char lds[];
  cg::grid_group grid = cg::this_grid();
  const int wave = __builtin_amdgcn_readfirstlane(threadIdx.x >> 6);
  const int G = gridDim.x, c = blockIdx.x, gw = c * 8 + wave, NGW = G * 8;
  LAS unsigned char* ldsL = (LAS unsigned char*)lds;
  unsigned char* ws = a.ws;
  const int lo = a.ph_lo, hi = a.ph_hi;
#define IN(k) (lo <= (k) && (k) < hi)
  unsigned* barw = (unsigned*)(ws + CTL_ZERO_BYTES - 256); unsigned bar_epoch = 0;
#define OWN_BAR() do { __builtin_amdgcn_fence(__ATOMIC_RELEASE, "workgroup"); __builtin_amdgcn_s_barrier(); bar_epoch += (unsigned)G; \
    if (wave == 0) { if (lane_id_v() == 0) { __builtin_amdgcn_fence(__ATOMIC_ACQUIRE, "workgroup"); __builtin_amdgcn_fence(__ATOMIC_RELEASE, "agent"); \
      __hip_atomic_fetch_add(barw, 1u, __ATOMIC_RELAXED, __HIP_MEMORY_SCOPE_AGENT); \
      while (__hip_atomic_load(barw, __ATOMIC_RELAXED, __HIP_MEMORY_SCOPE_AGENT) < bar_epoch) __builtin_amdgcn_s_sleep(1); \
      __builtin_amdgcn_fence(__ATOMIC_ACQUIRE, "agent"); __builtin_amdgcn_fence(__ATOMIC_RELEASE, "workgroup"); } } \
    __builtin_amdgcn_s_barrier(); __builtin_amdgcn_fence(__ATOMIC_ACQUIRE, "workgroup"); } while (0)
#define SEAM(k) do { if (IN(k) && IN((k) + 1)) { if ((k) == 0) grid.sync(); else { OWN_BAR(); if ((PROBE_PH >> 20) & 1) OWN_BAR(); } } } while (0)
  float* MOD = (float*)(ws + WS_MOD); float* SSQ = (float*)(ws + WS_SSQ);
  const float* RT = (const float*)(ws + WS_ROPE); const float* CT = RT + 256 * 16 * 2;
  float* XC = (float*)(ws + WS_XC); float* PART = (float*)(ws + WS_PART);
  bf16_t* S1 = (bf16_t*)(ws + WS_S1); bf16_t* S2 = (bf16_t*)(ws + WS_S2);
  bf16_t* Qb = (bf16_t*)(ws + WS_Q); bf16_t* KVb = (bf16_t*)(ws + WS_KV); bf16_t* KRb = (bf16_t*)(ws + WS_KR); bf16_t* Gb = (bf16_t*)(ws + WS_G);
  const float* gn = a.in[6];
#define MODP(l, chunk) (MOD + (size_t)(l) * 3 * 12288 + (chunk) * 2048)
#define RUN_GEMM(MODE, Ap, lda_, Bp, N_, K_, skip, ...) do { pg8::Gemm g{Ap, Bp, NROW, N_, K_, lda_, K_}; pg8::RowSched S; S.init((skip) ? 128 : 130, (N_) / 256, G, c, (skip) ? 1 : 0); \
    pg8::Epi<MODE> E{__VA_ARGS__}; pg8::gemm_phase<pg8::Epi<MODE>, pg8::RowSched, true, true>(ldsL, g, S, E, wave); } while (0)
#define RUN_CTX_SPLIT(Ap, Bp, K_, NKC_) do { pg8::Gemm g{Ap, Bp, NROW, 2048, (K_) / (NKC_), K_, K_}; pg8::CtxSplitSched S; S.init(8, NKC_, G, c); \
    pg8::Epi<6> E{nullptr, 2048, nullptr, nullptr, nullptr, RT, CT, PART}; pg8::gemm_phase<pg8::Epi<6>, pg8::CtxSplitSched, true, true>(ldsL, g, S, E, wave); } while (0)

  if (IN(0)) { REP(0) p0_prologue(a, ldsL, gw, NGW, wave, lane_id_v(), rep_PROBE0); __syncthreads(); } SEAM(0);
  if (IN(1)) REP(1) norm_phase<false, true>(a.in[0], a.in[2], nullptr, nullptr, nullptr, nullptr, nullptr, nullptr, gn + 0 * 2048, MODP(0, 1), MODP(0, 0), S1, false, gw, NGW, lane_id_v());
  SEAM(1);
  if (IN(2)) REP(2) RUN_GEMM(1, S1, 2048, (const bf16_t*)(ws + WS_WIN), NP1, 2048, false, S2, NP1, SSQP(0), nullptr, KRb, RT, CT);
  SEAM(2);
  if (IN(3)) REP(3) {
    RUN_GEMM(2, S2, NP1, (const bf16_t*)(ws + WS_WQB), NQ, 512, false, Qb, NQ, nullptr, SSQ, nullptr, RT, CT);
    RUN_GEMM(3, S2 + 512, NP1, (const bf16_t*)(ws + WS_WKVB), NKV, 512, false, KVb, NKV, nullptr, SSQ + NROW, nullptr, RT, CT);
  }
  SEAM(3);
  if (IN(4)) REP(4) {
    const float SC = 0.07216878364870322f, Cc = SC * 1.4426950408889634f, THRS = 8.f / SC;
    for (int r = 0;; ++r) {
      const int u = c + r * G; if (u >= 2080) break;
      int b, h, rowq, NT;
      if (u < 2048) { int pair, qb; if (G == 256) { pair = (c & 7) * 4 + (r >> 1); qb = (c >> 3) + 32 * (r & 1); } else { pair = u >> 6; qb = u & 63; }
        b = pair >> 4; h = pair & 15; rowq = b * TB + CTXL + qb * 256; NT = TB / 64; }
      else { const int p = u - 2048; b = p >> 4; h = p & 15; rowq = b * TB; NT = CTXL / 64; }
      att::attn_unit<128, 128, false>(Qb + (size_t)rowq * NQ + h * 192, NQ, KVb + h * 256, NKV, KRb, 64, KVb + h * 256 + 128, NKV, S1 + (size_t)rowq * DM + h * 128, DM,
                                      NT, NT, b * TB, 0, 0, 0, Cc, THRS, -INFINITY, (char*)lds, ldsL, wave);
    }
  }
  SEAM(4);
  if (IN(5)) REP(5) { RUN_GEMM(0, S1, 2048, (const bf16_t*)(ws + WS_WOM), 2048, 2048, true, S2, 2048, SSQP(2), nullptr, nullptr, RT, CT);
    RUN_CTX_SPLIT(S1, (const bf16_t*)(ws + WS_WOM), 2048, 8); }
  SEAM(5);
  if (IN(6)) norm_phase<true, true, 8>(a.in[0], a.in[2], a.out, XC, S2, SSQ + 2 * NROW, gn + 1 * 2048, MODP(0, 2), gn + 2 * 2048, MODP(0, 4), MODP(0, 3), S1, false, gw, NGW, lane_id_v(), PART);
  SEAM(6);
  if (IN(7)) REP(7) RUN_GEMM(4, S1, 2048, (const bf16_t*)(ws + WS_WF1), DFF, 2048, false, Gb, DFF, nullptr, nullptr, nullptr, RT, CT);
  SEAM(7);
  if (IN(8)) REP(8) { RUN_GEMM(0, Gb, DFF, (const bf16_t*)(ws + WS_WF2), 2048, DFF, true, S2, 2048, SSQP(3), nullptr, nullptr, RT, CT);
    RUN_CTX_SPLIT(Gb, (const bf16_t*)(ws + WS_WF2), DFF, 16); }
  SEAM(8);
  if (IN(9)) norm_phase<true, true, 16>(a.out, XC, a.out, XC, S2, SSQ + 3 * NROW, gn + 3 * 2048, MODP(0, 5), gn + 4 * 2048, MODP(1, 1), MODP(1, 0), S1, false, gw, NGW, lane_id_v(), PART);
  SEAM(9);
  if (IN(10)) REP(10) RUN_GEMM(5, S1, 2048, (const bf16_t*)(ws + WS_WQKV), NQKV, 2048, false, Gb, NQKV, nullptr, nullptr, nullptr, RT, CT);
  SEAM(10);
  if (IN(11)) REP(11) {
    const float SC = 0.125f, Cc = SC * 1.4426950408889634f, THRS = 8.f / SC;
    for (int u = c; u < 4096; u += G) {
      const int pair = u >> 6, qb = u & 63, b = pair >> 5, h = pair & 31, kvh = h >> 3, t0 = qb * 256;
      int tstart = t0 - 128, nwin = 8;
      if (t0 == 0) { tstart = 0; nwin = 6; }
      if (t0 == SEQ - 256) nwin = 6;
      const int rowq = b * TB + CTXL + t0;
      att::attn_unit<0, 64, true>(Gb + (size_t)rowq * NQKV + h * 64, NQKV, nullptr, 0, Gb + 2048 + kvh * 64, NQKV, Gb + 2304 + kvh * 64, NQKV, S1 + (size_t)rowq * DM + h * 64, DM,
                                  4 + nwin, 4, b * TB, b * TB + CTXL + tstart, t0, tstart, Cc, THRS, a.in[16][h] * 1.4426950408889634f, (char*)lds, ldsL, wave);
    }
  }
  SEAM(11);
  if (IN(12)) REP(12) RUN_GEMM(0, S1, 2048, (const bf16_t*)(ws + WS_WOS), 2048, 2048, true, S2, 2048, SSQP(4), nullptr, nullptr, RT, CT);
  SEAM(12);
  if (IN(13)) norm_phase<true, true>(a.out, XC, a.out, XC, S2, SSQ + 4 * NROW, gn + 5 * 2048, MODP(1, 2), gn + 6 * 2048, MODP(1, 4), MODP(1, 3), S1, true, gw, NGW, lane_id_v());
  SEAM(13);
  if (IN(14)) REP(14) RUN_GEMM(4, S1, 2048, (const bf16_t*)(ws + WS_WF1) + (size_t)2048 * 8192, DFF, 2048, true, Gb, DFF, nullptr, nullptr, nullptr, RT, CT);
  SEAM(14);
  if (IN(15)) REP(15) RUN_GEMM(0, Gb, DFF, (const bf16_t*)(ws + WS_WF2) + (size_t)2048 * 8192, 2048, DFF, true, S2, 2048, SSQP(5), nullptr, nullptr, RT, CT);
  SEAM(15);
  if (IN(16)) norm_phase<true, false>(a.out, XC, a.out, XC, S2, SSQ + 5 * NROW, gn + 7 * 2048, MODP(1, 5), nullptr, nullptr, nullptr, nullptr, true, gw, NGW, lane_id_v());
#undef IN
#undef SEAM
}

extern "C" void kernel_launch(void* const* d_in, const int* in_sizes, int n_in, void* d_out, int out_size, void* d_ws, size_t ws_size, hipStream_t stream) {
  static int grid = 0;
  if (grid == 0) {
    if (n_in != 18 || out_size != 2 * SEQ * DM || ws_size < WS_END) { fprintf(stderr, "kernel_launch: unexpected shapes: n_in %d out %d ws %zu (need %zu)\n", n_in, out_size, ws_size, (size_t)WS_END); grid = -1; return; }
    int dev = 0, cus = 0, per_cu = 0;
    hipGetDevice(&dev); hipDeviceGetAttribute(&cus, hipDeviceAttributeMultiprocessorCount, dev);
    if (hipFuncSetAttribute((const void*)mk_fwd, hipFuncAttributeMaxDynamicSharedMemorySize, LDS_BYTES) != hipSuccess) { fprintf(stderr, "kernel_launch: hipFuncSetAttribute failed\n"); grid = -1; return; }
    if (hipOccupancyMaxActiveBlocksPerMultiprocessor(&per_cu, (const void*)mk_fwd, 512, LDS_BYTES) != hipSuccess || per_cu < 1) { fprintf(stderr, "kernel_launch: occupancy query gave %d\n", per_cu); per_cu = 1; }
    (void)hipGetLastError();
    grid = cus * per_cu;
    fprintf(stderr, "kernel_launch: grid %d (cus %d x %d)\n", grid, cus, per_cu);
  }
  if (grid < 0) return;
  hipMemsetAsync((char*)d_ws, 0, CTL_ZERO_BYTES, stream);
  Args a{};
  for (int i = 0; i < 18; ++i) a.in[i] = (const float*)d_in[i];
  a.out = (float*)d_out; a.ws = (unsigned char*)d_ws; a.ph_lo = 0; a.ph_hi = N_PHASES;
  void* args[] = {&a};
  hipError_t e = hipLaunchCooperativeKernel((const void*)mk_fwd, dim3(grid), dim3(512), args, LDS_BYTES, stream);
  if (e != hipSuccess) fprintf(stderr, "kernel_launch: cooperative launch failed: %s (grid %d)\n", hipGetErrorString(e), grid);
}
```

```cpp
#include <hip/hip_runtime.h>
#include <hip/hip_cooperative_groups.h>
#include <cstdio>
#include <cstdint>
namespace cg = cooperative_groups;

constexpr int DM = 2048, SEQ = 16384, CTXL = 256, TB = SEQ + CTXL  , NROW = 2 * TB  , DFF = 8192;
constexpr int NP1 = 1280  , NQ = 3072, NKV = 4096, NQKV = 2560;
constexpr float NORM_EPS = 1e-6f;
__device__ __forceinline__ int lane_id_v() { int l; asm volatile("v_mbcnt_lo_u32_b32 %0, -1, 0\n\tv_mbcnt_hi_u32_b32 %0, -1, %0" : "=v"(l)); return l; }
namespace pg8 {
#define PG8_LAS __attribute__((address_space(3)))
typedef unsigned short bf16_t;
typedef short bf16x8 __attribute__((ext_vector_type(8)));
typedef float f32x4 __attribute__((ext_vector_type(4)));
typedef unsigned u32x4 __attribute__((ext_vector_type(4)));
constexpr int BM = 256, BK = 64, HALF = 128, HTB = HALF * BK * 2  , STAGE_BYTES = 8 * HTB, NXCD = 8, WGM = 8;

__host__ __device__ __forceinline__ int lds_byte(int r, int c) { const int st = (r >> 4) * 2 + (c >> 5), rr = r & 15, cc = c & 31, ob = rr * 64 + cc * 2; return st * 1024 + (ob ^ (((ob >> 9) & 1) << 5)); }
__host__ __device__ __forceinline__ void stage_rc(int b, int& R, int& C) { const int st = b / 1024, sb = b % 1024, swz = sb ^ (((sb >> 9) & 1) << 5); R = (st >> 1) * 16 + swz / 64; C = (st & 1) * 32 + (swz % 64) / 2; }
__host__ __device__ __forceinline__ int perm32(int rho) { const int n = rho >> 4, i = rho & 15; return 8 * (i >> 2) + 4 * n + (i & 3); }

struct Unit { int pm, pn, kc; };
struct Gemm { const bf16_t* A; const bf16_t* Bt; int M, N, K, lda, ldb; };

struct StaticOrder {
    int nM, nN, nwg, G, c;
    __host__ __device__ void init(int M, int N, int G_, int c_) { nM = M / BM; nN = N / BM; nwg = nM * nN; G = G_; c = c_; }
    __host__ __device__ bool next(int i, Unit& u) const {
        const long L = (long)i * G + c; if (L >= nwg) return false;
        int wgid = (int)L; { const int q = nwg / NXCD, r = nwg % NXCD, xcd = wgid % NXCD, off = wgid / NXCD; wgid = (xcd < r ? xcd * (q + 1) : r * (q + 1) + (xcd - r) * q) + off; }
        const int nig = WGM * nN, gid = wgid / nig, fm = gid * WGM, gsz = (nM - fm) < WGM ? (nM - fm) : WGM;
        u.pm = fm + ((wgid % nig) % gsz); u.pn = (wgid % nig) / gsz; return true;
    }
    __device__ __forceinline__ void a_ready(const Unit&) const {}
    __device__ __forceinline__ void done(const Unit&) const {}
};


__device__ __forceinline__ unsigned cvt_pk_bf16(float lo, float hi) { unsigned r; asm volatile("v_cvt_pk_bf16_f32 %0, %1, %2" : "=v"(r) : "v"(lo), "v"(hi)); return r; }

struct RowSched {
    int nM, nN, nwg, G, c, skipctx;
    __device__ void init(int nM_, int nN_, int G_, int c_, int skipctx_) { nM = nM_; nN = nN_; nwg = nM * nN; G = G_; c = c_; skipctx = skipctx_; }
    __device__ bool next(int i, Unit& u) const {
        const long L = (long)i * G + c; if (L >= nwg) return false;
        int wgid = (int)L; { const int q = nwg / NXCD, r = nwg % NXCD, xcd = wgid % NXCD, off = wgid / NXCD; wgid = (xcd < r ? xcd * (q + 1) : r * (q + 1) + (xcd - r) * q) + off; }
        const int nig = WGM * nN, gid = wgid / nig, fm = gid * WGM, gsz = (nM - fm) < WGM ? (nM - fm) : WGM;
        int pm = fm + ((wgid % nig) % gsz); u.pn = (wgid % nig) / gsz;
        if (skipctx) pm += 1 + (pm >= 64 ? 1 : 0);
        u.pm = pm; u.kc = 0; return true;
    }
    __device__ __forceinline__ void a_ready(const Unit&) const {}
    __device__ __forceinline__ void done(const Unit&) const {}
};

struct CtxSplitSched {
    int nN, NKC, nwg, G, c;
    __device__ void init(int nN_, int NKC_, int G_, int c_) { nN = nN_; NKC = NKC_; nwg = 2 * nN * NKC; G = G_; c = c_; }
    __device__ bool next(int i, Unit& u) const {
        const long L = (long)i * G + c; if (L >= nwg) return false;
        const int l = (int)L, t = l / NKC; u.kc = l - t * NKC; u.pn = t % nN; u.pm = (t / nN) ? 65 : 0; return true;
    }
    __device__ __forceinline__ void a_ready(const Unit&) const {}
    __device__ __forceinline__ void done(const Unit&) const {}
};

template <int MODE> struct Epi {
    static constexpr bool PERM = true, AFTER_DRAIN = false;
    bf16_t* O; int ldc;
    float* ssq;
    const float* rssq;
    bf16_t* KR;
    const float* rtab; const float* ctab;
    float* part;
    __device__ __forceinline__ void operator()(const f32x4 (&acc)[2][2][4][2], const Unit& u, int wr, int wc, int fr, int fq) const {
        const int pm = u.pm, pn = u.pn;
        const bool isctx = (pm == 0) || (pm == 65);
        const int tbase = (pm > 65 ? pm - 66 : pm - 1) * 256;
#pragma unroll
        for (int ai = 0; ai < 2; ++ai)
#pragma unroll
            for (int m = 0; m < 4; ++m) {
                const int rt = ai * HALF + wr * 64 + m * 16 + fr;
                const int row = pm * BM + rt;
                const int t = tbase + rt;
                float rs = 1.f;
                if (MODE == 2 || MODE == 3) rs = __builtin_amdgcn_rsqf(rssq[row] * (1.0f / 512.0f) + 1e-6f);
                float sq = 0.f;
#pragma unroll
                for (int bj = 0; bj < 2; ++bj) {
                    const int col = pn * BM + bj * HALF + wc * 32 + 8 * fq;
                    f32x4 v0 = acc[ai][bj][m][0], v1 = acc[ai][bj][m][1];
                    if (MODE == 6) { float* pp = part + ((size_t)u.kc * 512 + (pm == 65 ? 256 : 0) + rt) * ldc + col; *(f32x4*)pp = v0; *(f32x4*)(pp + 4) = v1; continue; }
                    if (MODE == 2 || MODE == 3) { v0 = v0 * rs; v1 = v1 * rs; }
                    if (MODE == 0 || MODE == 1) sq += (v0[0] * v0[0] + v0[1] * v0[1]) + (v0[2] * v0[2] + v0[3] * v0[3]) + (v1[0] * v1[0] + v1[1] * v1[1]) + (v1[2] * v1[2] + v1[3] * v1[3]);
                    bool dorope = false; int i0 = 0;
                    if (MODE == 2) { const int hc = col % 192; dorope = (!isctx) && (hc >= 128); i0 = (hc - 128) >> 1; }
                    if (MODE == 5) { dorope = (!isctx) && (col < 2304); i0 = (col & 63) >> 1; }
                    if (MODE == 1) { dorope = (!isctx) && (pn == 4) && (col < 1088); i0 = (col - 1024) >> 1; }
                    if (MODE == 1 || MODE == 2 || MODE == 5) {
                        if (dorope) {
                            const float* tb = (i0 < 16) ? (rtab + ((t >> 6) * 16 + i0) * 2) : (ctab + ((t & 63) * 16 + (i0 - 16)) * 2);
                            const f32x4 c0 = *(const f32x4*)tb, c1 = *(const f32x4*)(tb + 4);
                            f32x4 w0, w1;
                            w0[0] = v0[0] * c0[0] - v0[1] * c0[1]; w0[1] = v0[0] * c0[1] + v0[1] * c0[0];
                            w0[2] = v0[2] * c0[2] - v0[3] * c0[3]; w0[3] = v0[2] * c0[3] + v0[3] * c0[2];
                            w1[0] = v1[0] * c1[0] - v1[1] * c1[1]; w1[1] = v1[0] * c1[1] + v1[1] * c1[0];
                            w1[2] = v1[2] * c1[2] - v1[3] * c1[3]; w1[3] = v1[2] * c1[3] + v1[3] * c1[2];
                            v0 = w0; v1 = w1;
                        }
                    }
                    if (MODE == 4) {
#pragma unroll
                        for (int e = 0; e < 4; ++e) { const float a = fmaxf(v0[e], 0.f), b = fmaxf(v1[e], 0.f); v0[e] = a * a; v1[e] = b * b; }
                    }
                    u32x4 w; w.x = cvt_pk_bf16(v0[0], v0[1]); w.y = cvt_pk_bf16(v0[2], v0[3]); w.z = cvt_pk_bf16(v1[0], v1[1]); w.w = cvt_pk_bf16(v1[2], v1[3]);
                    if (MODE == 1 && pn == 4) { if (col < 1088) *(u32x4*)(KR + (size_t)row * 64 + (col - 1024)) = w; }
                    else *(u32x4*)(O + (size_t)row * ldc + col) = w;
                }
                if (MODE == 0 || MODE == 1) {
                    if (MODE == 0 || pn < 4) {
                        sq += __shfl_xor(sq, 16); sq += __shfl_xor(sq, 32);
                        if (fq == 0) atomicAdd(ssq + (MODE == 1 ? (size_t)(pn >> 1) * NROW : (size_t)0) + row, sq);
                    }
                }
            }
    }
};

template <class Epi, class Sched, bool ALIGN_EPI = false, bool SP2 = false>
__device__ __forceinline__ void gemm_phase(PG8_LAS unsigned char* lds, const Gemm g, const Sched& S, const Epi& E, const int wave_) {
    const int wid = wave_, lane = lane_id_v(), tid = wid * 64 + lane, wr = wid >> 2, wc = wid & 3, fr = lane & 15, fq = lane >> 4;
    const int K = g.K, nt = K / BK, lda = g.lda, ldb = g.ldb;
    unsigned voffA[2], voffB[2];
#pragma unroll
    for (int i = 0; i < 2; ++i) { int R, C; stage_rc(tid * 16 + i * 8192, R, C); const int Rb = Epi::PERM ? ((R & ~31) + perm32(R & 31)) : R;
        voffA[i] = (unsigned)(R * lda + C) * 2u; voffB[i] = (unsigned)(Rb * ldb + C) * 2u; }
    const size_t kstep = (size_t)(BK * 2);
    const size_t hstepA = (size_t)HALF * lda * 2, hstepB = (size_t)HALF * ldb * 2;
    const size_t tstepA = 2 * hstepA, tstepB = 2 * hstepB;
    const unsigned ldsw = (unsigned)wid * 1024u;
    const int aoff = lds_byte(wr * 64 + fr, fq * 8), boff = lds_byte(wc * 32 + fr, fq * 8);
#define PG8_SA(b, h) (((b) * 2 + (h)) * HTB)
#define PG8_SB(b, h) ((4 + (b) * 2 + (h)) * HTB)
#define PG8_STAGE(bufoff, gbase, voff) do { _Pragma("unroll") for (int _i = 0; _i < 2; ++_i) \
        __builtin_amdgcn_global_load_lds((const unsigned*)((const char*)(gbase) + (voff)[_i]), (PG8_LAS unsigned*)(lds + (bufoff) + ldsw + _i * 8192), 16, 0, 0); } while (0)
#define PG8_LDA(dst, b, h) do { _Pragma("unroll") for (int m = 0; m < 4; ++m) _Pragma("unroll") for (int k = 0; k < 2; ++k) dst[m][k] = *(const PG8_LAS bf16x8*)(lds + PG8_SA(b, h) + aoff + m * 2048 + k * 1024); } while (0)
#define PG8_LDB(dst, b, h) do { _Pragma("unroll") for (int n = 0; n < 2; ++n) _Pragma("unroll") for (int k = 0; k < 2; ++k) dst[n][k] = *(const PG8_LAS bf16x8*)(lds + PG8_SB(b, h) + boff + n * 2048 + k * 1024); } while (0)
#define PG8_MMA(ai, bj, At, Bt) do { __builtin_amdgcn_s_setprio(1); _Pragma("unroll") for (int m = 0; m < 4; ++m) _Pragma("unroll") for (int n = 0; n < 2; ++n) _Pragma("unroll") for (int k = 0; k < 2; ++k) \
        acc[ai][bj][m][n] = __builtin_amdgcn_mfma_f32_16x16x32_bf16(Bt[n][k], At[m][k], acc[ai][bj][m][n], 0, 0, 0); __builtin_amdgcn_s_setprio(0); } while (0)
#define PG8_WAIT_V(n) asm volatile("s_waitcnt vmcnt(" #n ")" ::: "memory")
#define PG8_WAIT_L(n) asm volatile("s_waitcnt lgkmcnt(" #n ")" ::: "memory")
#define PG8_BAR __builtin_amdgcn_s_barrier()
#define PG8_SCHED __builtin_amdgcn_sched_barrier(0)
    Unit cur, nxt; int ui = 0;
    if (!S.next(0, cur)) return;
    f32x4 acc[2][2][4][2];
#pragma unroll
    for (int a = 0; a < 2; ++a)
#pragma unroll
        for (int b = 0; b < 2; ++b)
#pragma unroll
            for (int m = 0; m < 4; ++m)
#pragma unroll
                for (int n = 0; n < 2; ++n) acc[a][b][m][n] = (f32x4){0.f, 0.f, 0.f, 0.f};
    bf16x8 At[4][2], B0[2][2], B1[2][2];
    const char* cA = (const char*)g.A + (size_t)cur.pm * tstepA + (size_t)cur.kc * K * 2; const char* cB = (const char*)g.Bt + (size_t)cur.pn * tstepB + (size_t)cur.kc * K * 2;
    S.a_ready(cur);
    if constexpr (SP2) {
        PG8_STAGE(PG8_SB(0, 0), cB, voffB); PG8_STAGE(PG8_SB(0, 1), cB + hstepB, voffB); PG8_STAGE(PG8_SA(0, 0), cA, voffA); PG8_STAGE(PG8_SA(0, 1), cA + hstepA, voffA);
        if (wr == 1) PG8_BAR;
        PG8_WAIT_V(2); PG8_BAR;
        PG8_STAGE(PG8_SB(1, 0), cB + kstep, voffB); PG8_STAGE(PG8_SA(1, 0), cA + kstep, voffA); PG8_STAGE(PG8_SB(1, 1), cB + hstepB + kstep, voffB);
        PG8_WAIT_V(6); PG8_BAR;
    } else {
        PG8_STAGE(PG8_SB(0, 0), cB, voffB); PG8_STAGE(PG8_SA(0, 0), cA, voffA); PG8_STAGE(PG8_SB(0, 1), cB + hstepB, voffB); PG8_STAGE(PG8_SA(0, 1), cA + hstepA, voffA);
        if (wr == 1) PG8_BAR;
        PG8_WAIT_V(4); PG8_BAR;
        PG8_STAGE(PG8_SB(1, 0), cB + kstep, voffB); PG8_STAGE(PG8_SA(1, 0), cA + kstep, voffA); PG8_STAGE(PG8_SB(1, 1), cB + hstepB + kstep, voffB);
        PG8_WAIT_V(6); PG8_BAR;
    }
    for (;;) {
        const bool has_next = S.next(ui + 1, nxt);
        const char* nA = has_next ? (const char*)g.A + (size_t)nxt.pm * tstepA + (size_t)nxt.kc * K * 2 : cA; const char* nB = has_next ? (const char*)g.Bt + (size_t)nxt.pn * tstepB + (size_t)nxt.kc * K * 2 : cB;
        for (int t = 0; t < nt; t += 2) {
            const bool last = (t == nt - 2);
            const char* a1 = cA + (size_t)(t + 1) * kstep;
            const char* a2 = last ? nA : cA + (size_t)(t + 2) * kstep; const char* b2 = last ? nB : cB + (size_t)(t + 2) * kstep;
            const char* a3 = a2 + kstep; const char* b3 = b2 + kstep;
            if (last && has_next) S.a_ready(nxt);
            if constexpr (SP2) {
            PG8_LDB(B0, 0, 0); PG8_LDB(B1, 0, 1); PG8_SCHED; PG8_LDA(At, 0, 0); PG8_STAGE(PG8_SA(1, 1), a1 + hstepA, voffA);
            PG8_WAIT_V(8); PG8_WAIT_L(0); PG8_BAR; PG8_MMA(0, 0, At, B0); PG8_MMA(0, 1, At, B1); PG8_BAR; PG8_SCHED;
            PG8_LDA(At, 0, 1); PG8_STAGE(PG8_SB(0, 0), b2, voffB); PG8_STAGE(PG8_SB(0, 1), b2 + hstepB, voffB); PG8_STAGE(PG8_SA(0, 0), a2, voffA);
            PG8_WAIT_V(8); PG8_WAIT_L(0); PG8_BAR; PG8_MMA(1, 0, At, B0); PG8_MMA(1, 1, At, B1); PG8_BAR; PG8_SCHED;
            PG8_LDB(B0, 1, 0); PG8_LDB(B1, 1, 1); PG8_SCHED; PG8_LDA(At, 1, 0); PG8_STAGE(PG8_SA(0, 1), a2 + hstepA, voffA);
            PG8_WAIT_V(8); PG8_WAIT_L(0); PG8_BAR; PG8_MMA(0, 0, At, B0); PG8_MMA(0, 1, At, B1); PG8_BAR; PG8_SCHED;
            PG8_LDA(At, 1, 1); PG8_STAGE(PG8_SB(1, 0), b3, voffB); PG8_STAGE(PG8_SB(1, 1), b3 + hstepB, voffB); PG8_STAGE(PG8_SA(1, 0), a3, voffA);
            PG8_WAIT_V(8); PG8_WAIT_L(0); PG8_BAR; PG8_MMA(1, 0, At, B0); PG8_MMA(1, 1, At, B1); PG8_BAR; PG8_SCHED;
            } else {
            PG8_LDB(B0, 0, 0); PG8_SCHED; PG8_LDA(At, 0, 0); PG8_STAGE(PG8_SA(1, 1), a1 + hstepA, voffA);
            PG8_WAIT_L(8); PG8_BAR; PG8_WAIT_L(0); PG8_MMA(0, 0, At, B0); PG8_BAR; PG8_SCHED;
            PG8_LDB(B1, 0, 1); PG8_STAGE(PG8_SB(0, 0), b2, voffB);
            PG8_BAR; PG8_WAIT_L(0); PG8_MMA(0, 1, At, B1); PG8_BAR;
            PG8_LDA(At, 0, 1); PG8_STAGE(PG8_SA(0, 0), a2, voffA);
            PG8_BAR; PG8_WAIT_L(0); PG8_MMA(1, 0, At, B0); PG8_BAR; PG8_SCHED;
            PG8_STAGE(PG8_SB(0, 1), b2 + hstepB, voffB);
            PG8_WAIT_V(6); PG8_BAR; PG8_MMA(1, 1, At, B1); PG8_BAR;
            PG8_LDB(B0, 1, 0); PG8_SCHED; PG8_LDA(At, 1, 0); PG8_STAGE(PG8_SA(0, 1), a2 + hstepA, voffA);
            PG8_WAIT_L(8); PG8_BAR; PG8_WAIT_L(0); PG8_MMA(0, 0, At, B0); PG8_BAR; PG8_SCHED;
            PG8_LDB(B1, 1, 1); PG8_STAGE(PG8_SB(1, 0), b3, voffB);
            PG8_BAR; PG8_WAIT_L(0); PG8_MMA(0, 1, At, B1); PG8_BAR;
            PG8_LDA(At, 1, 1); PG8_STAGE(PG8_SA(1, 0), a3, voffA);
            PG8_BAR; PG8_WAIT_L(0); PG8_MMA(1, 0, At, B0); PG8_BAR; PG8_SCHED;
            PG8_STAGE(PG8_SB(1, 1), b3 + hstepB, voffB);
            PG8_WAIT_V(6); PG8_BAR; PG8_MMA(1, 1, At, B1); PG8_BAR;
            }
        }
        if constexpr (ALIGN_EPI) { if (wr == 0) PG8_BAR; }
        if constexpr (!Epi::AFTER_DRAIN) { E(acc, cur, wr, wc, fr, fq); S.done(cur); }
        if (!has_next) break;
#pragma unroll
        for (int a = 0; a < 2; ++a)
#pragma unroll
            for (int b = 0; b < 2; ++b)
#pragma unroll
                for (int m = 0; m < 4; ++m)
#pragma unroll
                    for (int n = 0; n < 2; ++n) acc[a][b][m][n] = (f32x4){0.f, 0.f, 0.f, 0.f};
        cur = nxt; cA = nA; cB = nB; ++ui;
        if constexpr (ALIGN_EPI) { if (wr == 1) PG8_BAR; }
    }
    PG8_WAIT_V(0);
    if constexpr (!ALIGN_EPI) { if (wr == 0) PG8_BAR; }
    PG8_BAR;
    if constexpr (Epi::AFTER_DRAIN) { E.fused(acc, cur, wr, wc, fr, fq, lds, wid, lane); S.done(cur); }
#undef PG8_SA
#undef PG8_SB
#undef PG8_STAGE
#undef PG8_LDA
#undef PG8_LDB
#undef PG8_MMA
#undef PG8_WAIT_V
#undef PG8_WAIT_L
#undef PG8_BAR
#undef PG8_SCHED
}
}

namespace att {
typedef unsigned short bf16_t;
using bf16x8 = __attribute__((ext_vector_type(8))) short;
using s16x4  = __attribute__((ext_vector_type(4))) short;
using f32x16 = __attribute__((ext_vector_type(16))) float;
using u32x4  = __attribute__((ext_vector_type(4))) unsigned;
#define KSWZ(row, colB) ((row) * 256 + ((colB) ^ (((row) & 15) << 4)))
#define KSWZ64(row, colB) ((row) * 128 + ((colB) ^ ((((row) >> 1) & 7) << 4)))
#define SBAR() __builtin_amdgcn_sched_barrier(0)
__device__ __forceinline__ int crow(int r, int hi) { return (r & 3) + 8 * (r >> 2) + 4 * hi; }
__device__ __forceinline__ unsigned cvtpk(float lo, float hi) { unsigned r; asm volatile("v_cvt_pk_bf16_f32 %0, %1, %2" : "=v"(r) : "v"(lo), "v"(hi)); return r; }

__device__ __forceinline__ void partialSM(f32x16& p0, f32x16& p1, float& m_reg, float& alpha, const float C, const float THRS) {
  float pmax = p0[0];
#pragma unroll
  for (int r = 1; r < 16; ++r) pmax = fmaxf(pmax, p0[r]);
#pragma unroll
  for (int r = 0; r < 16; ++r) pmax = fmaxf(pmax, p1[r]);
  { auto rr = __builtin_amdgcn_permlane32_swap(__float_as_uint(pmax), __float_as_uint(pmax), false, false);
    pmax = fmaxf(__uint_as_float(rr[0]), __uint_as_float(rr[1])); }
  float mn;
  if (__builtin_expect(__all(pmax - m_reg <= THRS), 1)) { mn = m_reg; alpha = 1.f; }
  else { mn = fmaxf(m_reg, pmax); alpha = __builtin_amdgcn_exp2f((m_reg - mn) * C); m_reg = mn; }
  const float mnC = -mn * C;
#pragma unroll
  for (int r = 0; r < 16; ++r) p0[r] = fmaf(p0[r], C, mnC);
#pragma unroll
  for (int r = 0; r < 16; ++r) p1[r] = fmaf(p1[r], C, mnC);
#pragma unroll
  for (int r = 0; r < 16; ++r) p0[r] = __builtin_amdgcn_exp2f(p0[r]);
}
__device__ __forceinline__ void finishSM(f32x16& p0, f32x16& p1, float alpha, float& l_reg, bf16x8& pa0, bf16x8& pa1, bf16x8& pa2, bf16x8& pa3) {
#pragma unroll
  for (int r = 0; r < 16; ++r) p1[r] = __builtin_amdgcn_exp2f(p1[r]);
  float ps = 0;
#pragma unroll
  for (int r = 0; r < 16; ++r) ps += p0[r];
#pragma unroll
  for (int r = 0; r < 16; ++r) ps += p1[r];
  { auto rr = __builtin_amdgcn_permlane32_swap(__float_as_uint(ps), __float_as_uint(ps), false, false);
    ps = __uint_as_float(rr[0]) + __uint_as_float(rr[1]); }
  l_reg = l_reg * alpha + ps;
#define PK4(P, BASE, OUT) do { unsigned a0 = cvtpk(P[BASE + 0], P[BASE + 1]), a1 = cvtpk(P[BASE + 2], P[BASE + 3]);   \
    unsigned b0 = cvtpk(P[BASE + 4], P[BASE + 5]), b1 = cvtpk(P[BASE + 6], P[BASE + 7]);                              \
    auto r0 = __builtin_amdgcn_permlane32_swap(a0, b0, false, false); auto r1 = __builtin_amdgcn_permlane32_swap(a1, b1, false, false); \
    u32x4 w = {r0[0], r1[0], r0[1], r1[1]}; OUT = *reinterpret_cast<bf16x8*>(&w); } while (0)
  PK4(p0, 0, pa0); PK4(p0, 8, pa1); PK4(p1, 0, pa2); PK4(p1, 8, pa3);
#undef PK4
}
template <int DN>
__device__ __forceinline__ void qkt(f32x16& p0, f32x16& p1, const char* Kn, const char* Kr, const bf16x8* qr, const char* qrl, int r32, int hi) {
  p0 = f32x16{}; p1 = f32x16{};
  if constexpr (DN > 0) {
#pragma unroll
    for (int d0 = 0; d0 < DN / 16; ++d0) { const int cb = (d0 * 16 + hi * 8) * 2;
      bf16x8 b0 = *reinterpret_cast<const bf16x8*>(Kn + KSWZ(r32, cb));
      bf16x8 b1 = *reinterpret_cast<const bf16x8*>(Kn + KSWZ(32 + r32, cb));
      p0 = __builtin_amdgcn_mfma_f32_32x32x16_bf16(b0, qr[d0], p0, 0, 0, 0);
      p1 = __builtin_amdgcn_mfma_f32_32x32x16_bf16(b1, qr[d0], p1, 0, 0, 0); }
  }
#pragma unroll
  for (int d0 = 0; d0 < 4; ++d0) { const int cb = (d0 * 16 + hi * 8) * 2;
    bf16x8 b0 = *reinterpret_cast<const bf16x8*>(Kr + KSWZ64(r32, cb));
    bf16x8 b1 = *reinterpret_cast<const bf16x8*>(Kr + KSWZ64(32 + r32, cb));
    bf16x8 q; if constexpr (DN > 0) q = *reinterpret_cast<const bf16x8*>(qrl + d0 * 1024); else q = qr[d0];
    p0 = __builtin_amdgcn_mfma_f32_32x32x16_bf16(b0, q, p0, 0, 0, 0);
    p1 = __builtin_amdgcn_mfma_f32_32x32x16_bf16(b1, q, p1, 0, 0, 0); }
}
__device__ __forceinline__ void band_mask(f32x16& p0, f32x16& p1, int d) {
#pragma unroll
  for (int r = 0; r < 16; ++r) { const int v = d - ((r & 3) + 8 * (r >> 2));
    if (v > 128 || v < -128) p0[r] = -1e30f;
    if (v - 32 > 128 || v - 32 < -128) p1[r] = -1e30f; }
}
__device__ __forceinline__ int v_rd_base(int lane) { return ((lane & 3) << 3) | (((lane >> 2) & 3) << 6) | (((lane >> 4) & 1) << 5) | (((lane >> 5) & 1) << 8); }
template <int NCB> constexpr int v_rd_off(int d0, int ks, int half) { return d0 * 512 + ks * (2 * NCB * 512) + half * (NCB * 512); }
template <int OFF> __device__ __forceinline__ s16x4 tr_read(int vb) {
  s16x4 r; asm volatile("ds_read_b64_tr_b16 %0, %1 offset:%2" : "=&v"(r) : "v"(vb), "i"(OFF) : "memory"); return r;
}
template <int D0, int NCB> __device__ __forceinline__ void pv_one(f32x16& od, int vb, bf16x8 pa0, bf16x8 pa1, bf16x8 pa2, bf16x8 pa3) {
  const s16x4 l0 = tr_read<v_rd_off<NCB>(D0, 0, 0)>(vb), h0 = tr_read<v_rd_off<NCB>(D0, 0, 1)>(vb), l1 = tr_read<v_rd_off<NCB>(D0, 1, 0)>(vb), h1 = tr_read<v_rd_off<NCB>(D0, 1, 1)>(vb);
  const s16x4 l2 = tr_read<v_rd_off<NCB>(D0, 2, 0)>(vb), h2 = tr_read<v_rd_off<NCB>(D0, 2, 1)>(vb), l3 = tr_read<v_rd_off<NCB>(D0, 3, 0)>(vb), h3 = tr_read<v_rd_off<NCB>(D0, 3, 1)>(vb);
  asm volatile("s_waitcnt lgkmcnt(0)" ::: "memory"); SBAR();
#define PK(L, H) (bf16x8){L[0], L[1], L[2], L[3], H[0], H[1], H[2], H[3]}
  od = __builtin_amdgcn_mfma_f32_32x32x16_bf16(pa0, PK(l0, h0), od, 0, 0, 0);
  od = __builtin_amdgcn_mfma_f32_32x32x16_bf16(pa1, PK(l1, h1), od, 0, 0, 0);
  od = __builtin_amdgcn_mfma_f32_32x32x16_bf16(pa2, PK(l2, h2), od, 0, 0, 0);
  od = __builtin_amdgcn_mfma_f32_32x32x16_bf16(pa3, PK(l3, h3), od, 0, 0, 0);
#undef PK
}
template <int NCB> __device__ __forceinline__ void pv_all(f32x16* o, int vb, bf16x8 pa0, bf16x8 pa1, bf16x8 pa2, bf16x8 pa3) {
  pv_one<0, NCB>(o[0], vb, pa0, pa1, pa2, pa3); pv_one<1, NCB>(o[1], vb, pa0, pa1, pa2, pa3);
  if constexpr (NCB == 4) { pv_one<2, NCB>(o[2], vb, pa0, pa1, pa2, pa3); pv_one<3, NCB>(o[3], vb, pa0, pa1, pa2, pa3); }
}

#define ATT_LAS __attribute__((address_space(3)))
template <int DN, int DV, bool MASK>
__device__ __forceinline__ void attn_unit(const bf16_t* __restrict__ Qb, const int ldq, const bf16_t* __restrict__ Kn, const int ldkn,
    const bf16_t* __restrict__ Kr, const int ldkr, const bf16_t* __restrict__ Vp, const int ldv, bf16_t* __restrict__ Ob, const int ldo,
    const int NT, const int n1, const int r1, const int r2, const int qpos0, const int kt2,
    const float C, const float THRS, const float sinkl2, char* lds, ATT_LAS unsigned char* ldsL, const int wave_) {
  constexpr int NQR = DN > 0 ? DN / 16 : 4, NCB = DV / 32, VB = 64 * DV * 2, KNB = 64 * DN * 2, KRB = 64 * 64 * 2, BUF = VB + KNB + KRB;
  constexpr int NVC = VB / 8192, NKC = KNB / 8192;
  const int wid = wave_, lane = lane_id_v(), r32 = lane & 31, hi = lane >> 5;
  char* Vl = lds; char* Knl = lds + VB; char* Krl = lds + VB + KNB;
  float* wsf = (float*)(lds + 3 * BUF) + wid * 64; float* li_l = wsf; float* al_l = wsf + 32;
  float m_reg = -1e30f, l_reg = 0; f32x16 o[NCB] = {}; bf16x8 qr[NQR];
  const bf16_t* Qw = Qb + (MASK ? (long)r32 * ldq + wid * 64 : (long)(wid * 32 + r32) * ldq) + hi * 8;
#pragma unroll
  for (int d0 = 0; d0 < NQR; ++d0) qr[d0] = *reinterpret_cast<const bf16x8*>(Qw + d0 * 16);
  char* qrl = lds + 3 * BUF + 2048 + wid * 4096 + lane * 16;
  if constexpr (DN > 0) {
#pragma unroll
    for (int d0 = 0; d0 < 4; ++d0) *reinterpret_cast<bf16x8*>(qrl + d0 * 1024) = *reinterpret_cast<const bf16x8*>(Qw + DN + d0 * 16);
  }
  int offV[NVC], offK[NKC > 0 ? NKC : 1], offR;
#pragma unroll
  for (int i = 0; i < NVC; ++i) { const int ch = wid * NVC + i, sub = ch * 2 + (lane >> 5), kk = (sub / NCB) * 8 + ((lane & 31) >> 2), col = (sub % NCB) * 32 + (lane & 3) * 8;
    const int k = (kk & ~0xC) | ((kk & 4) << 1) | ((kk & 8) >> 1); offV[i] = k * ldv + col; }
#pragma unroll
  for (int i = 0; i < NKC; ++i) { const int ch = wid * NKC + i, row = ch * 4 + (lane >> 4), cb = ((lane & 15) * 16) ^ ((row & 15) << 4); offK[i] = row * ldkn + (cb >> 1); }
  { const int row = wid * 8 + (lane >> 3), cb = ((lane & 7) * 16) ^ (((row >> 1) & 7) << 4); offR = row * ldkr + (cb >> 1); }
  const int vb0 = (int)(uintptr_t)Vl + v_rd_base(lane);
  const int qd = qpos0 + (MASK ? 0 : wid * 32) + r32 - 4 * hi;
#define TROW(j) ((j) < n1 ? r1 + 64 * (j) : r2 + 64 * ((j) - n1))
#define DMA(j, b) do { const long row0_ = TROW(j); \
    _Pragma("unroll") for (int i_ = 0; i_ < NVC; ++i_) __builtin_amdgcn_global_load_lds((const unsigned*)(Vp + row0_ * ldv + offV[i_]), (ATT_LAS unsigned*)(ldsL + (b) + (wid * NVC + i_) * 1024), 16, 0, 0); \
    _Pragma("unroll") for (int i_ = 0; i_ < NKC; ++i_) __builtin_amdgcn_global_load_lds((const unsigned*)(Kn + row0_ * ldkn + offK[i_]), (ATT_LAS unsigned*)(ldsL + (b) + VB + (wid * NKC + i_) * 1024), 16, 0, 0); \
    __builtin_amdgcn_global_load_lds((const unsigned*)(Kr + row0_ * ldkr + offR), (ATT_LAS unsigned*)(ldsL + (b) + VB + KNB + wid * 1024), 16, 0, 0); } while (0)
#define WAITV() asm volatile("s_waitcnt vmcnt(0)" ::: "memory")
  const int q0w = qpos0 + (MASK ? 0 : wid * 32);
#define KP(j) (kt2 + 64 * ((j) - n1))
#define NEED(j) (!MASK || (j) < n1 || (KP(j) <= q0w + 159 && KP(j) + 63 >= q0w - 128))
#define SCORE(P0, P1, b, j) do { qkt<DN>(P0, P1, Knl + (b), Krl + (b), qr, qrl, r32, hi); \
    if constexpr (MASK) { if ((j) >= n1 && !(KP(j) >= q0w - 97 && KP(j) <= q0w + 65)) band_mask(P0, P1, qd - KP(j)); } } while (0)
#define RESC(a) do { if (__any((a) < 1.f)) { const int l_ = lane_id_v(); if (l_ < 32) al_l[l_] = (a); asm volatile("s_waitcnt lgkmcnt(0)" ::: "memory"); \
    _Pragma("unroll") for (int d = 0; d < NCB; ++d) _Pragma("unroll") for (int r = 0; r < 16; ++r) o[d][r] *= al_l[crow(r, l_ >> 5)]; } } while (0)
#define ROT() do { const int t_ = bp; bp = bc; bc = bn; bn = t_; } while (0)
  f32x16 pA0, pA1, pB0, pB1; float alA, alB; bf16x8 pa0, pa1, pa2, pa3;
  int bp = 0, bc = BUF, bn = 2 * BUF;
  DMA(0, 0); DMA(1, BUF); WAITV(); __syncthreads();
  SCORE(pA0, pA1, 0, 0); partialSM(pA0, pA1, m_reg, alA, C, THRS);
  bool nA = true, nB = true;
  for (int j = 1; j + 1 < NT; j += 2) {
    DMA(j + 1, bn);
    nB = NEED(j);
    SBAR(); if (nB) SCORE(pB0, pB1, bc, j);
    if (nA) finishSM(pA0, pA1, alA, l_reg, pa0, pa1, pa2, pa3); SBAR();
    if (nA) pv_all<NCB>(o, vb0 + bp, pa0, pa1, pa2, pa3);
    if (nB) { partialSM(pB0, pB1, m_reg, alB, C, THRS); RESC(alB); }
    WAITV(); __syncthreads(); ROT();
    DMA(j + 2, bn);
    nA = NEED(j + 1);
    SBAR(); if (nA) SCORE(pA0, pA1, bc, j + 1);
    if (nB) finishSM(pB0, pB1, alB, l_reg, pa0, pa1, pa2, pa3); SBAR();
    if (nB) pv_all<NCB>(o, vb0 + bp, pa0, pa1, pa2, pa3);
    if (nA) { partialSM(pA0, pA1, m_reg, alA, C, THRS); RESC(alA); }
    WAITV(); __syncthreads(); ROT();
  }
  nB = NEED(NT - 1);
  SBAR(); if (nB) SCORE(pB0, pB1, bc, NT - 1);
  if (nA) finishSM(pA0, pA1, alA, l_reg, pa0, pa1, pa2, pa3); SBAR();
  if (nA) pv_all<NCB>(o, vb0 + bp, pa0, pa1, pa2, pa3);
  if (nB) { partialSM(pB0, pB1, m_reg, alB, C, THRS);
    RESC(alB);
    finishSM(pB0, pB1, alB, l_reg, pa0, pa1, pa2, pa3); SBAR();
    pv_all<NCB>(o, vb0 + bc, pa0, pa1, pa2, pa3); }
  l_reg += __builtin_amdgcn_exp2f(sinkl2 - m_reg * C);
  const int lane2 = lane_id_v(), r32e = lane2 & 31, hie = lane2 >> 5;
  if (hie == 0) li_l[r32e] = l_reg; asm volatile("s_waitcnt lgkmcnt(0)" ::: "memory");
  float rli[16];
#pragma unroll
  for (int r = 0; r < 16; ++r) rli[r] = __builtin_amdgcn_rcpf(li_l[crow(r, hie)]);
  bf16_t* Ow = Ob + (MASK ? (long)(wid * 64) : (long)(wid * 32) * ldo);
#pragma unroll
  for (int r = 0; r < 16; ++r) { const int orow = crow(r, hie);
#pragma unroll
    for (int d0 = 0; d0 < NCB; ++d0) Ow[(long)orow * ldo + d0 * 32 + r32e] = (bf16_t)(cvtpk(o[d0][r] * rli[r], 0.f) & 0xffffu); }
  __syncthreads();
#undef TROW
#undef DMA
#undef WAITV
#undef SCORE
#undef RESC
#undef ROT
#undef KP
#undef NEED
}
}

constexpr size_t MiB = 1u << 20;
constexpr size_t WS_MOD = 0;
constexpr size_t WS_SSQ = 512 * 1024;
constexpr size_t WS_ROPE = 1792 * 1024;
constexpr size_t CTL_ZERO_BYTES = 2 * MiB;
constexpr size_t WS_XC = 2 * MiB;
constexpr size_t WS_WIN = 8 * MiB, WS_WQB = 13 * MiB, WS_WKVB = 16 * MiB, WS_WOM = 20 * MiB, WS_WF1 = 28 * MiB, WS_WF2 = 92 * MiB, WS_WQKV = 156 * MiB, WS_WOS = 166 * MiB;
constexpr size_t WS_S1 = 176 * MiB;
constexpr size_t WS_S2 = 306 * MiB;
constexpr size_t WS_G = 436 * MiB;
constexpr size_t WS_Q = WS_G, WS_KV = WS_G + 196 * MiB, WS_KR = WS_G + 456 * MiB;
constexpr size_t WS_PART = WS_G + 520 * MiB;
constexpr size_t WS_END = WS_PART + 64 * MiB;
static_assert((size_t)NROW * 2048 * 2 == 130 * MiB && WS_SSQ + 8 * (size_t)NROW * 4 <= WS_ROPE && (size_t)NROW * NQ * 2 <= 196 * MiB && (size_t)NROW * NKV * 2 <= 260 * MiB, "ws map");

#define LAS __attribute__((address_space(3)))
typedef unsigned short bf16_t;
typedef float f32x4 __attribute__((ext_vector_type(4)));
typedef unsigned u32x4 __attribute__((ext_vector_type(4)));
typedef unsigned u32x2 __attribute__((ext_vector_type(2)));
constexpr int LDS_BYTES = 3 * 40960 + 2048 + 32768;
constexpr int N_PHASES = 17;
#ifndef PROBE_PH
#define PROBE_PH -1
#endif
#ifndef PROBE_PH2
#define PROBE_PH2 -1
#endif
#if PROBE_PH >= 0
#define rep_PROBE0 (rep_ != 0)
#define REP(k) for (int rep_ = 0; rep_ < ((((PROBE_PH) >> (k)) & 1) ? 2 : 1); ++rep_)
#define SSQP(i) (rep_ ? SSQ + 6 * NROW : SSQ + (i) * NROW)
#else
#define rep_PROBE0 false
#define REP(k)
#define SSQP(i) (SSQ + (i) * NROW)
#endif

struct Args { const float* in[18]; float* out; unsigned char* ws; int ph_lo, ph_hi; };

__device__ __forceinline__ float wave_sum(float v) {
#pragma unroll
  for (int o = 1; o < 64; o <<= 1) v += __shfl_xor(v, o);
  return v;
}
__device__ __forceinline__ unsigned pk2(float lo, float hi) { unsigned r; asm volatile("v_cvt_pk_bf16_f32 %0, %1, %2" : "=v"(r) : "v"(lo), "v"(hi)); return r; }

__device__ __forceinline__ int dest_row(int mode, int n) {
  if (mode == 1) { if (n < 1024) return n; const int j = n - 1024; return 1024 + (((j & 31) << 1) | (j >> 5)); }
  if (mode == 2) { const int h = n / 192, d = n - h * 192; if (d < 128) return n; const int j = d - 128; return h * 192 + 128 + (((j & 31) << 1) | (j >> 5)); }
  if (mode == 3) { if (n >= 2304) return n; const int d = n & 63; return (n & ~63) + (((d & 31) << 1) | (d >> 5)); }
  return n;
}
__device__ __forceinline__ void tr_item(const float* __restrict__ W, int K, int N, bf16_t* __restrict__ WT, const float* __restrict__ ks, int mode, LAS float* scr, int item, int lane) {
  const int nblk = N / 32, kb = item / nblk, nb = item - kb * nblk, k0 = 64 * kb, n0 = 32 * nb;
  float wv[32];
#pragma unroll
  for (int i = 0; i < 32; ++i) wv[i] = W[(size_t)(k0 + 2 * i + (lane >> 5)) * N + n0 + (lane & 31)];
  if (ks) {
#pragma unroll
    for (int i = 0; i < 32; ++i) wv[i] *= ks[k0 + 2 * i + (lane >> 5)];
  }
#pragma unroll
  for (int i = 0; i < 32; ++i) scr[(2 * i + (lane >> 5)) * 33 + (lane & 31)] = wv[i];
  asm volatile("s_waitcnt lgkmcnt(0)" ::: "memory");
  const int c = lane & 7;
#pragma unroll
  for (int j = 0; j < 4; ++j) { const int n = (lane >> 3) + 8 * j; const LAS float* s = scr + (8 * c) * 33 + n;
    u32x4 o; o.x = pk2(s[0 * 33], s[1 * 33]); o.y = pk2(s[2 * 33], s[3 * 33]); o.z = pk2(s[4 * 33], s[5 * 33]); o.w = pk2(s[6 * 33], s[7 * 33]);
    *(u32x4*)(WT + (size_t)dest_row(mode, n0 + n) * K + k0 + 8 * c) = o; }
  asm volatile("s_waitcnt lgkmcnt(0)" ::: "memory");
}

__device__ __forceinline__ float silu_f(float x) { return x / (1.f + __expf(-x)); }

constexpr int TI0 = 32 * 34, TI1 = 8 * 96, TI2 = 8 * 128, TI3 = 32 * 64, TI4 = 32 * 256, TI6 = 128 * 64, TI8 = 32 * 80, TI9 = 32 * 64;
constexpr int N_EARLY = TI0 + TI1 + TI2, N_LATE = TI3 + 2 * TI4 + 2 * TI6 + TI8 + TI9;
__device__ __forceinline__ void tr_dispatch(const Args& a, int it  , LAS float* scr, int lane) {
  unsigned char* ws = a.ws;
  int r = it; const float* W; int K, N, mode = 0; const float* ks = nullptr; bf16_t* dst;
  if (r < TI0) { W = a.in[9]; K = 2048; N = 1088; mode = 1; dst = (bf16_t*)(ws + WS_WIN); }
  else if ((r -= TI0) < TI1) { W = a.in[12]; K = 512; N = 3072; mode = 2; ks = a.in[10]; dst = (bf16_t*)(ws + WS_WQB); }
  else if ((r -= TI1) < TI2) { W = a.in[13]; K = 512; N = 4096; ks = a.in[11]; dst = (bf16_t*)(ws + WS_WKVB); }
  else if ((r -= TI2) < TI3) { W = a.in[14]; K = 2048; N = 2048; dst = (bf16_t*)(ws + WS_WOM); }
  else if ((r -= TI3) < 2 * TI4) { const int l = r / TI4; r -= l * TI4; W = a.in[7] + (size_t)l * 2048 * 8192; K = 2048; N = 8192; dst = (bf16_t*)(ws + WS_WF1) + (size_t)l * 2048 * 8192; }
  else if ((r -= 2 * TI4) < 2 * TI6) { const int l = r / TI6; r -= l * TI6; W = a.in[8] + (size_t)l * 2048 * 8192; K = 8192; N = 2048; dst = (bf16_t*)(ws + WS_WF2) + (size_t)l * 2048 * 8192; }
  else if ((r -= 2 * TI6) < TI8) { W = a.in[15]; K = 2048; N = 2560; mode = 3; dst = (bf16_t*)(ws + WS_WQKV); }
  else { r -= TI8; W = a.in[17]; K = 2048; N = 2048; dst = (bf16_t*)(ws + WS_WOS); }
  tr_item(W, K, N, dst, ks, mode, scr, r, lane);
}

__device__ __forceinline__ void p0_prologue(const Args& a, LAS unsigned char* lds, int gw, int NGW, int wave, int lane, bool only_transposes) {
  unsigned char* ws = a.ws;
  LAS float* scr = (LAS float*)(lds + wave * 16384);
  for (int it = gw; it < N_EARLY + N_LATE; it += NGW) tr_dispatch(a, it, scr, lane);
  if (only_transposes) return;
  float* MOD = (float*)(ws + WS_MOD);
  for (int it = gw; it < 2 * 48 * 64; it += NGW) {
    const int kc = it & 63, cb = (it >> 6) % 48, l = it / (64 * 48);
    const int n0 = cb * 256 + lane * 4, k0 = kc * 32;
    const float* Wm = a.in[4] + (size_t)l * 2048 * 12288 + n0;
    f32x4 a0 = {0.f, 0.f, 0.f, 0.f}, a1 = a0, a2 = a0;
#pragma unroll 16
    for (int k = 0; k < 32; ++k) { const int kk = k0 + k;
      const float s0 = silu_f(a.in[1][kk]), s1 = silu_f(a.in[1][2048 + kk]), s2 = silu_f(a.in[3][kk]);
      const f32x4 w = *(const f32x4*)(Wm + (size_t)kk * 12288);
      a0 += w * s0; a1 += w * s1; a2 += w * s2; }
    if (kc == 0) { const f32x4 b = *(const f32x4*)(a.in[5] + l * 12288 + n0); a0 += b; a1 += b; a2 += b; }
    float* mo = MOD + (size_t)(l * 3) * 12288 + n0;
#pragma unroll
    for (int e = 0; e < 4; ++e) { atomicAdd(mo + e, a0[e]); atomicAdd(mo + 12288 + e, a1[e]); atomicAdd(mo + 2 * 12288 + e, a2[e]); }
  }
  float* tab = (float*)(ws + WS_ROPE);
  for (int e = gw * 64 + lane; e < 320 * 16; e += NGW * 64) {
    const int i = e & 15, pos = e >> 4; const float p = (float)(pos < 256 ? pos : pos - 256);
    const float freq = exp2f(-(float)i * 0.8304820237218406f); const float ang = p * freq;
    tab[e * 2] = cosf(ang); tab[e * 2 + 1] = sinf(ang);
  }
}

__device__ __forceinline__ f32x4 ldf4(const float* base, unsigned boff) { return *(const f32x4*)((const char*)base + boff); }
__device__ __forceinline__ void stf4(float* base, unsigned boff, f32x4 v) { *(f32x4*)((char*)base + boff) = v; }
template <bool UPD, bool DOH, int NKC>
__device__ __forceinline__ void norm_rows(const int row0, const int nrows, const float* xin_lat, const float* xin_ctx, float* xout_lat, float* xout_ctx, const bf16_t* Y, const float* ssq,
    const float* gA, const float* gateM, const float* gB, const float* scM, const float* shM, bf16_t* H, int lane, const float* part) {
  const int b = row0 / TB, rb = row0 - b * TB; const bool isctx = rb < CTXL;
  const int v = isctx ? 2 : b;
  const size_t xoff = isctx ? (size_t)(b * CTXL + rb) * DM : (size_t)(b * SEQ + rb - CTXL) * DM;
  const float* xin = (isctx ? xin_ctx : xin_lat) + xoff;
  float* xout = UPD ? ((isctx ? xout_ctx : xout_lat) + xoff) : nullptr;
  const int lane_ = lane_id_v();
  const unsigned lo = (unsigned)lane_ * 16u, lo2 = (unsigned)lane_ * 8u;
  f32x4 GA[8], GB[8], SH[8];
#pragma unroll
  for (int j = 0; j < 8; ++j) { const unsigned o = lo + 1024u * j;
    if (UPD) GA[j] = ldf4(gateM + v * 12288, o) * ldf4(gA, o);
    if (DOH) { GB[j] = ldf4(gB, o) * (ldf4(scM + v * 12288, o) + 1.0f); SH[j] = ldf4(shM + v * 12288, o); } }
  f32x4 xn[8]; u32x2 yn[8];
#pragma unroll
  for (int j = 0; j < 8; ++j) { xn[j] = ldf4(xin, lo + 1024u * j); if (UPD && !(NKC > 0 && isctx)) yn[j] = *(const u32x2*)((const char*)(Y + (size_t)row0 * DM) + lo2 + 512u * j); }
  for (int rr = 0; rr < nrows; ++rr) {
    const int row = row0 + rr;
    f32x4 x[8]; u32x2 yc[8];
#pragma unroll
    for (int j = 0; j < 8; ++j) { x[j] = xn[j]; if (UPD) yc[j] = yn[j]; }
    if (rr + 1 < nrows) { const float* xr = xin + (size_t)(rr + 1) * DM;
#pragma unroll
      for (int j = 0; j < 8; ++j) { xn[j] = ldf4(xr, lo + 1024u * j); if (UPD && !(NKC > 0 && isctx)) yn[j] = *(const u32x2*)((const char*)(Y + (size_t)(row + 1) * DM) + lo2 + 512u * j); } }
    if (UPD && NKC > 0 && isctx) {
      f32x4 y[8]; float ys = 0.f; const float* pr = part + (size_t)(b * CTXL + rb + rr) * DM;
#pragma unroll
      for (int j = 0; j < 8; ++j) y[j] = ldf4(pr, lo + 1024u * j);
#pragma unroll 1
      for (int k = 1; k < NKC; ++k) { pr += (size_t)512 * DM;
#pragma unroll
        for (int j = 0; j < 8; ++j) y[j] += ldf4(pr, lo + 1024u * j); }
#pragma unroll
      for (int j = 0; j < 8; ++j) ys += (y[j][0] * y[j][0] + y[j][1] * y[j][1]) + (y[j][2] * y[j][2] + y[j][3] * y[j][3]);
      const float rinv = __builtin_amdgcn_rsqf(wave_sum(ys) * (1.0f / 2048.0f) + NORM_EPS);
      float* xo = xout + (size_t)rr * DM;
#pragma unroll
      for (int j = 0; j < 8; ++j) { x[j] += GA[j] * (y[j] * rinv); stf4(xo, lo + 1024u * j, x[j]); }
    } else if (UPD) {
      const float rinv = __builtin_amdgcn_rsqf(ssq[row] * (1.0f / 2048.0f) + NORM_EPS);
      float* xo = xout + (size_t)rr * DM;
#pragma unroll
      for (int j = 0; j < 8; ++j) { const u32x2 yb = yc[j];
        f32x4 y; y[0] = __uint_as_float(yb.x << 16); y[1] = __uint_as_float(yb.x & 0xffff0000u); y[2] = __uint_as_float(yb.y << 16); y[3] = __uint_as_float(yb.y & 0xffff0000u);
        x[j] += GA[j] * (y * rinv);
        stf4(xo, lo + 1024u * j, x[j]); }
    }
    if (DOH) {
      float ss = 0.f;
#pragma unroll
      for (int j = 0; j < 8; ++j) ss += (x[j][0] * x[j][0] + x[j][1] * x[j][1]) + (x[j][2] * x[j][2] + x[j][3] * x[j][3]);
      const float r = __builtin_amdgcn_rsqf(wave_sum(ss) * (1.0f / 2048.0f) + NORM_EPS);
      bf16_t* hr = H + (size_t)row * DM;
#pragma unroll
      for (int j = 0; j < 8; ++j) { const f32x4 h = x[j] * r * GB[j] + SH[j]; u32x2 w; w.x = pk2(h[0], h[1]); w.y = pk2(h[2], h[3]);
        *(u32x2*)((char*)hr + lo2 + 512u * j) = w; }
    }
  }
}
template <bool UPD, bool DOH, int NKC = 0>
__device__ __forceinline__ void norm_phase(const float* xin_lat, const float* xin_ctx, float* xout_lat, float* xout_ctx, const bf16_t* Y, const float* ssq,
    const float* gA, const float* gateM, const float* gB, const float* scM, const float* shM, bf16_t* H, bool skipctx, int gw, int NGW, int lane, const float* part = nullptr) {
  for (int ch = gw; ch < 2 * SEQ / 16; ch += NGW) { const int b = ch / (SEQ / 16), row0 = b * TB + CTXL + (ch - b * (SEQ / 16)) * 16;
    norm_rows<UPD, DOH, 0>(row0, 16, xin_lat, xin_ctx, xout_lat, xout_ctx, Y, ssq, gA, gateM, gB, scM, shM, H, lane, part); }
  if (!skipctx)
    for (int r = gw; r < 2 * CTXL; r += NGW) { const int b = r / CTXL, row0 = b * TB + (r - b * CTXL);
      norm_rows<UPD, DOH, NKC>(row0, 1, xin_lat, xin_ctx, xout_lat, xout_ctx, Y, ssq, gA, gateM, gB, scM, shM, H, lane, part); }
}

__global__ void __launch_bounds__(512, 2) mk_fwd(Args a) {
  extern __shared__ __attribute__((aligned(16))) unsigned char lds[];
  cg::grid_group grid = cg::this_grid();
  const int wave = __builtin_amdgcn_readfirstlane(threadIdx.x >> 6);
  const int G = gridDim.x, c = blockIdx.x, gw = c * 8 + wave, NGW = G * 8;
  LAS unsigned char* ldsL = (LAS unsigned char*)lds;
  unsigned char* ws = a.ws;
  const int lo = a.ph_lo, hi = a.ph_hi;
#define IN(k) (lo <= (k) && (k) < hi)
  unsigned* barw = (unsigned*)(ws + CTL_ZERO_BYTES - 256); unsigned bar_epoch = 0;
#define OWN_BAR() do { __builtin_amdgcn_fence(__ATOMIC_RELEASE, "workgroup"); __builtin_amdgcn_s_barrier(); bar_epoch += (unsigned)G; \
    if (wave == 0) { if (lane_id_v() == 0) { __builtin_amdgcn_fence(__ATOMIC_ACQUIRE, "workgroup"); __builtin_amdgcn_fence(__ATOMIC_RELEASE, "agent"); \
      __hip_atomic_fetch_add(barw, 1u, __ATOMIC_RELAXED, __HIP_MEMORY_SCOPE_AGENT); \
      while (__hip_atomic_load(barw, __ATOMIC_RELAXED, __HIP_MEMORY_SCOPE_AGENT) < bar_epoch) __builtin_amdgcn_s_sleep(1); \
      __builtin_amdgcn_fence(__ATOMIC_ACQUIRE, "agent"); __builtin_amdgcn_fence(__ATOMIC_RELEASE, "workgroup"); } } \
    __builtin_amdgcn_s_barrier(); __builtin_amdgcn_fence(__ATOMIC_ACQUIRE, "workgroup"); } while (0)
#define SEAM(k) do { if (IN(k) && IN((k) + 1)) { if ((k) == 0) grid.sync(); else { OWN_BAR(); if ((PROBE_PH >> 20) & 1) OWN_BAR(); } } } while (0)
  float* MOD = (float*)(ws + WS_MOD); float* SSQ = (float*)(ws + WS_SSQ);
  const float* RT = (const float*)(ws + WS_ROPE); const float* CT = RT + 256 * 16 * 2;
  float* XC = (float*)(ws + WS_XC); float* PART = (float*)(ws + WS_PART);
  bf16_t* S1 = (bf16_t*)(ws + WS_S1); bf16_t* S2 = (bf16_t*)(ws + WS_S2);
  bf16_t* Qb = (bf16_t*)(ws + WS_Q); bf16_t* KVb = (bf16_t*)(ws + WS_KV); bf16_t* KRb = (bf16_t*)(ws + WS_KR); bf16_t* Gb = (bf16_t*)(ws + WS_G);
  const float* gn = a.in[6];
#define MODP(l, chunk) (MOD + (size_t)(l) * 3 * 12288 + (chunk) * 2048)
#define RUN_GEMM(MODE, Ap, lda_, Bp, N_, K_, skip, ...) do { pg8::Gemm g{Ap, Bp, NROW, N_, K_, lda_, K_}; pg8::RowSched S; S.init((skip) ? 128 : 130, (N_) / 256, G, c, (skip) ? 1 : 0); \
    pg8::Epi<MODE> E{__VA_ARGS__}; pg8::gemm_phase<pg8::Epi<MODE>, pg8::RowSched, true, true>(ldsL, g, S, E, wave); } while (0)
#define RUN_CTX_SPLIT(Ap, Bp, K_, NKC_) do { pg8::Gemm g{Ap, Bp, NROW, 2048, (K_) / (NKC_), K_, K_}; pg8::CtxSplitSched S; S.init(8, NKC_, G, c); \
    pg8::Epi<6> E{nullptr, 2048, nullptr, nullptr, nullptr, RT, CT, PART}; pg8::gemm_phase<pg8::Epi<6>, pg8::CtxSplitSched, true, true>(ldsL, g, S, E, wave); } while (0)

  if (IN(0)) { REP(0) p0_prologue(a, ldsL, gw, NGW, wave, lane_id_v(), rep_PROBE0); __syncthreads(); } SEAM(0);
  if (IN(1)) REP(1) norm_phase<false, true>(a.in[0], a.in[2], nullptr, nullptr, nullptr, nullptr, nullptr, nullptr, gn + 0 * 2048, MODP(0, 1), MODP(0, 0), S1, false, gw, NGW, lane_id_v());
  SEAM(1);
  if (IN(2)) REP(2) RUN_GEMM(1, S1, 2048, (const bf16_t*)(ws + WS_WIN), NP1, 2048, false, S2, NP1, SSQP(0), nullptr, KRb, RT, CT);
  SEAM(2);
  if (IN(3)) REP(3) {
    RUN_GEMM(2, S2, NP1, (const bf16_t*)(ws + WS_WQB), NQ, 512, false, Qb, NQ, nullptr, SSQ, nullptr, RT, CT);
    RUN_GEMM(3, S2 + 512, NP1, (const bf16_t*)(ws + WS_WKVB), NKV, 512, false, KVb, NKV, nullptr, SSQ + NROW, nullptr, RT, CT);
  }
  SEAM(3);
  if (IN(4)) REP(4) {
    const float SC = 0.07216878364870322f, Cc = SC * 1.4426950408889634f, THRS = 8.f / SC;
    for (int r = 0;; ++r) {
      const int u = c + r * G; if (u >= 2080) break;
      int b, h, rowq, NT;
      if (u < 2048) { int pair, qb; if (G == 256) { pair = (c & 7) * 4 + (r >> 1); qb = (c >> 3) + 32 * (r & 1); } else { pair = u >> 6; qb = u & 63; }
        b = pair >> 4; h = pair & 15; rowq = b * TB + CTXL + qb * 256; NT = TB / 64; }
      else { const int p = u - 2048; b = p >> 4; h = p & 15; rowq = b * TB; NT = CTXL / 64; }
      att::attn_unit<128, 128, false>(Qb + (size_t)rowq * NQ + h * 192, NQ, KVb + h * 256, NKV, KRb, 64, KVb + h * 256 + 128, NKV, S1 + (size_t)rowq * DM + h * 128, DM,
                                      NT, NT, b * TB, 0, 0, 0, Cc, THRS, -INFINITY, (char*)lds, ldsL, wave);
    }
  }
  SEAM(4);
  if (IN(5)) REP(5) { RUN_GEMM(0, S1, 2048, (const bf16_t*)(ws + WS_WOM), 2048, 2048, true, S2, 2048, SSQP(2), nullptr, nullptr, RT, CT);
    RUN_CTX_SPLIT(S1, (const bf16_t*)(ws + WS_WOM), 2048, 8); }
  SEAM(5);
  if (IN(6)) norm_phase<true, true, 8>(a.in[0], a.in[2], a.out, XC, S2, SSQ + 2 * NROW, gn + 1 * 2048, MODP(0, 2), gn + 2 * 2048, MODP(0, 4), MODP(0, 3), S1, false, gw, NGW, lane_id_v(), PART);
  SEAM(6);
  if (IN(7)) REP(7) RUN_GEMM(4, S1, 2048, (const bf16_t*)(ws + WS_WF1), DFF, 2048, false, Gb, DFF, nullptr, nullptr, nullptr, RT, CT);
  SEAM(7);
  if (IN(8)) REP(8) { RUN_GEMM(0, Gb, DFF, (const bf16_t*)(ws + WS_WF2), 2048, DFF, true, S2, 2048, SSQP(3), nullptr, nullptr, RT, CT);
    RUN_CTX_SPLIT(Gb, (const bf16_t*)(ws + WS_WF2), DFF, 16); }
  SEAM(8);
  if (IN(9)) norm_phase<true, true, 16>(a.out, XC, a.out, XC, S2, SSQ + 3 * NROW, gn + 3 * 2048, MODP(0, 5), gn + 4 * 2048, MODP(1, 1), MODP(1, 0), S1, false, gw, NGW, lane_id_v(), PART);
  SEAM(9);
  if (IN(10)) REP(10) RUN_GEMM(5, S1, 2048, (const bf16_t*)(ws + WS_WQKV), NQKV, 2048, false, Gb, NQKV, nullptr, nullptr, nullptr, RT, CT);
  SEAM(10);
  if (IN(11)) REP(11) {
    const float SC = 0.125f, Cc = SC * 1.4426950408889634f, THRS = 8.f / SC;
    for (int u = c; u < 4096; u += G) {
      const int pairkv = u >> 9, qb32 = u & 511, b = pairkv >> 2, kvh = pairkv & 3, t0 = qb32 * 32;
      int f = (t0 - 128) < 0 ? 0 : (t0 - 128) >> 6, l = (t0 + 159) >> 6; if (l > SEQ / 64 - 1) l = SEQ / 64 - 1;
      if ((l - f + 1) & 1) { if (l < SEQ / 64 - 1) ++l; else --f; }
      const int nwin = l - f + 1, tstart = 64 * f;
      const int rowq = b * TB + CTXL + t0;
      att::attn_unit<0, 64, true>(Gb + (size_t)rowq * NQKV + kvh * 512, NQKV, nullptr, 0, Gb + 2048 + kvh * 64, NQKV, Gb + 2304 + kvh * 64, NQKV, S1 + (size_t)rowq * DM + kvh * 512, DM,
                                  4 + nwin, 4, b * TB, b * TB + CTXL + tstart, t0, tstart, Cc, THRS, a.in[16][kvh * 8 + wave] * 1.4426950408889634f, (char*)lds, ldsL, wave);
    }
  }
  SEAM(11);
  if (IN(12)) REP(12) RUN_GEMM(0, S1, 2048, (const bf16_t*)(ws + WS_WOS), 2048, 2048, true, S2, 2048, SSQP(4), nullptr, nullptr, RT, CT);
  SEAM(12);
  if (IN(13)) norm_phase<true, true>(a.out, XC, a.out, XC, S2, SSQ + 4 * NROW, gn + 5 * 2048, MODP(1, 2), gn + 6 * 2048, MODP(1, 4), MODP(1, 3), S1, true, gw, NGW, lane_id_v());
  SEAM(13);
  if (IN(14)) REP(14) RUN_GEMM(4, S1, 2048, (const bf16_t*)(ws + WS_WF1) + (size_t)2048 * 8192, DFF, 2048, true, Gb, DFF, nullptr, nullptr, nullptr, RT, CT);
  SEAM(14);
  if (IN(15)) REP(15) RUN_GEMM(0, Gb, DFF, (const bf16_t*)(ws + WS_WF2) + (size_t)2048 * 8192, 2048, DFF, true, S2, 2048, SSQP(5), nullptr, nullptr, RT, CT);
  SEAM(15);
  if (IN(16)) norm_phase<true, false>(a.out, XC, a.out, XC, S2, SSQ + 5 * NROW, gn + 7 * 2048, MODP(1, 5), nullptr, nullptr, nullptr, nullptr, true, gw, NGW, lane_id_v());
#undef IN
#undef SEAM
}

extern "C" void kernel_launch(void* const* d_in, const int* in_sizes, int n_in, void* d_out, int out_size, void* d_ws, size_t ws_size, hipStream_t stream) {
  static int grid = 0;
  if (grid == 0) {
    if (n_in != 18 || out_size != 2 * SEQ * DM || ws_size < WS_END) { fprintf(stderr, "kernel_launch: unexpected shapes: n_in %d out %d ws %zu (need %zu)\n", n_in, out_size, ws_size, (size_t)WS_END); grid = -1; return; }
    int dev = 0, cus = 0, per_cu = 0;
    hipGetDevice(&dev); hipDeviceGetAttribute(&cus, hipDeviceAttributeMultiprocessorCount, dev);
    if (hipFuncSetAttribute((const void*)mk_fwd, hipFuncAttributeMaxDynamicSharedMemorySize, LDS_BYTES) != hipSuccess) { fprintf(stderr, "kernel_launch: hipFuncSetAttribute failed\n"); grid = -1; return; }
    if (hipOccupancyMaxActiveBlocksPerMultiprocessor(&per_cu, (const void*)mk_fwd, 512, LDS_BYTES) != hipSuccess || per_cu < 1) { fprintf(stderr, "kernel_launch: occupancy query gave %d\n", per_cu); per_cu = 1; }
    (void)hipGetLastError();
    grid = cus * per_cu;
    fprintf(stderr, "kernel_launch: grid %d (cus %d x %d)\n", grid, cus, per_cu);
  }
  if (grid < 0) return;
  hipMemsetAsync((char*)d_ws, 0, CTL_ZERO_BYTES, stream);
  Args a{};
  for (int i = 0; i < 18; ++i) a.in[i] = (const float*)d_in[i];
  a.out = (float*)d_out; a.ws = (unsigned char*)d_ws; a.ph_lo = 0; a.ph_hi = N_PHASES;
  void* args[] = {&a};
  hipError_t e = hipLaunchCooperativeKernel((const void*)mk_fwd, dim3(grid), dim3(512), args, LDS_BYTES, stream);
  if (e != hipSuccess) fprintf(stderr, "kernel_launch: cooperative launch failed: %s (grid %d)\n", hipGetErrorString(e), grid);
}
```

```cpp
#include <hip/hip_runtime.h>
#include <hip/hip_cooperative_groups.h>
#include <cstdio>
#include <cstdint>
namespace cg = cooperative_groups;

constexpr int DM = 2048, SEQ = 16384, CTXL = 256, TB = SEQ + CTXL  , NROW = 2 * TB  , DFF = 8192;
constexpr int NP1 = 1280  , NQ = 3072, NKV = 4096, NQKV = 2560;
constexpr float NORM_EPS = 1e-6f;
__device__ __forceinline__ int lane_id_v() { int l; asm volatile("v_mbcnt_lo_u32_b32 %0, -1, 0\n\tv_mbcnt_hi_u32_b32 %0, -1, %0" : "=v"(l)); return l; }
namespace pg8 {
#define PG8_LAS __attribute__((address_space(3)))
typedef unsigned short bf16_t;
typedef short bf16x8 __attribute__((ext_vector_type(8)));
typedef float f32x4 __attribute__((ext_vector_type(4)));
typedef unsigned u32x4 __attribute__((ext_vector_type(4)));
constexpr int BM = 256, BK = 64, HALF = 128, HTB = HALF * BK * 2  , STAGE_BYTES = 8 * HTB, NXCD = 8, WGM = 8;

__host__ __device__ __forceinline__ int lds_byte(int r, int c) { const int st = (r >> 4) * 2 + (c >> 5), rr = r & 15, cc = c & 31, ob = rr * 64 + cc * 2; return st * 1024 + (ob ^ (((ob >> 9) & 1) << 5)); }
__host__ __device__ __forceinline__ void stage_rc(int b, int& R, int& C) { const int st = b / 1024, sb = b % 1024, swz = sb ^ (((sb >> 9) & 1) << 5); R = (st >> 1) * 16 + swz / 64; C = (st & 1) * 32 + (swz % 64) / 2; }
__host__ __device__ __forceinline__ int perm32(int rho) { const int n = rho >> 4, i = rho & 15; return 8 * (i >> 2) + 4 * n + (i & 3); }

struct Unit { int pm, pn, kc; };
struct Gemm { const bf16_t* A; const bf16_t* Bt; int M, N, K, lda, ldb; };

struct StaticOrder {
    int nM, nN, nwg, G, c;
    __host__ __device__ void init(int M, int N, int G_, int c_) { nM = M / BM; nN = N / BM; nwg = nM * nN; G = G_; c = c_; }
    __host__ __device__ bool next(int i, Unit& u) const {
        const long L = (long)i * G + c; if (L >= nwg) return false;
        int wgid = (int)L; { const int q = nwg / NXCD, r = nwg % NXCD, xcd = wgid % NXCD, off = wgid / NXCD; wgid = (xcd < r ? xcd * (q + 1) : r * (q + 1) + (xcd - r) * q) + off; }
        const int nig = WGM * nN, gid = wgid / nig, fm = gid * WGM, gsz = (nM - fm) < WGM ? (nM - fm) : WGM;
        u.pm = fm + ((wgid % nig) % gsz); u.pn = (wgid % nig) / gsz; return true;
    }
    __device__ __forceinline__ void a_ready(const Unit&) const {}
    __device__ __forceinline__ void done(const Unit&) const {}
};


__device__ __forceinline__ unsigned cvt_pk_bf16(float lo, float hi) { unsigned r; asm volatile("v_cvt_pk_bf16_f32 %0, %1, %2" : "=v"(r) : "v"(lo), "v"(hi)); return r; }

struct RowSched {
    int nM, nN, nwg, G, c, skipctx;
    __device__ void init(int nM_, int nN_, int G_, int c_, int skipctx_) { nM = nM_; nN = nN_; nwg = nM * nN; G = G_; c = c_; skipctx = skipctx_; }
    __device__ bool next(int i, Unit& u) const {
        const long L = (long)i * G + c; if (L >= nwg) return false;
        int wgid = (int)L; { const int q = nwg / NXCD, r = nwg % NXCD, xcd = wgid % NXCD, off = wgid / NXCD; wgid = (xcd < r ? xcd * (q + 1) : r * (q + 1) + (xcd - r) * q) + off; }
        const int nig = WGM * nN, gid = wgid / nig, fm = gid * WGM, gsz = (nM - fm) < WGM ? (nM - fm) : WGM;
        int pm = fm + ((wgid % nig) % gsz); u.pn = (wgid % nig) / gsz;
        if (skipctx) pm += 1 + (pm >= 64 ? 1 : 0);
        u.pm = pm; u.kc = 0; return true;
    }
    __device__ __forceinline__ void a_ready(const Unit&) const {}
    __device__ __forceinline__ void done(const Unit&) const {}
};

struct CtxSplitSched {
    int nN, NKC, nwg, G, c;
    __device__ void init(int nN_, int NKC_, int G_, int c_) { nN = nN_; NKC = NKC_; nwg = 2 * nN * NKC; G = G_; c = c_; }
    __device__ bool next(int i, Unit& u) const {
        const long L = (long)i * G + c; if (L >= nwg) return false;
        const int l = (int)L, t = l / NKC; u.kc = l - t * NKC; u.pn = t % nN; u.pm = (t / nN) ? 65 : 0; return true;
    }
    __device__ __forceinline__ void a_ready(const Unit&) const {}
    __device__ __forceinline__ void done(const Unit&) const {}
};

template <int MODE> struct Epi {
    static constexpr bool PERM = true, AFTER_DRAIN = false;
    bf16_t* O; int ldc;
    float* ssq;
    const float* rssq;
    bf16_t* KR;
    const float* rtab; const float* ctab;
    float* part;
    __device__ __forceinline__ void operator()(const f32x4 (&acc)[2][2][4][2], const Unit& u, int wr, int wc, int fr, int fq) const {
        const int pm = u.pm, pn = u.pn;
        const bool isctx = (pm == 0) || (pm == 65);
        const int tbase = (pm > 65 ? pm - 66 : pm - 1) * 256;
#pragma unroll
        for (int ai = 0; ai < 2; ++ai)
#pragma unroll
            for (int m = 0; m < 4; ++m) {
                const int rt = ai * HALF + wr * 64 + m * 16 + fr;
                const int row = pm * BM + rt;
                const int t = tbase + rt;
                float rs = 1.f;
                if (MODE == 2 || MODE == 3) rs = __builtin_amdgcn_rsqf(rssq[row] * (1.0f / 512.0f) + 1e-6f);
                float sq = 0.f;
#pragma unroll
                for (int bj = 0; bj < 2; ++bj) {
                    const int col = pn * BM + bj * HALF + wc * 32 + 8 * fq;
                    f32x4 v0 = acc[ai][bj][m][0], v1 = acc[ai][bj][m][1];
                    if (MODE == 6) { float* pp = part + ((size_t)u.kc * 512 + (pm == 65 ? 256 : 0) + rt) * ldc + col; *(f32x4*)pp = v0; *(f32x4*)(pp + 4) = v1; continue; }
                    if (MODE == 2 || MODE == 3) { v0 = v0 * rs; v1 = v1 * rs; }
                    if (MODE == 0 || MODE == 1) sq += (v0[0] * v0[0] + v0[1] * v0[1]) + (v0[2] * v0[2] + v0[3] * v0[3]) + (v1[0] * v1[0] + v1[1] * v1[1]) + (v1[2] * v1[2] + v1[3] * v1[3]);
                    bool dorope = false; int i0 = 0;
                    if (MODE == 2) { const int hc = col % 192; dorope = (!isctx) && (hc >= 128); i0 = (hc - 128) >> 1; }
                    if (MODE == 5) { dorope = (!isctx) && (col < 2304); i0 = (col & 63) >> 1; }
                    if (MODE == 1) { dorope = (!isctx) && (pn == 4) && (col < 1088); i0 = (col - 1024) >> 1; }
                    if (MODE == 1 || MODE == 2 || MODE == 5) {
                        if (dorope) {
                            const float* tb = (i0 < 16) ? (rtab + ((t >> 6) * 16 + i0) * 2) : (ctab + ((t & 63) * 16 + (i0 - 16)) * 2);
                            const f32x4 c0 = *(const f32x4*)tb, c1 = *(const f32x4*)(tb + 4);
                            f32x4 w0, w1;
                            w0[0] = v0[0] * c0[0] - v0[1] * c0[1]; w0[1] = v0[0] * c0[1] + v0[1] * c0[0];
                            w0[2] = v0[2] * c0[2] - v0[3] * c0[3]; w0[3] = v0[2] * c0[3] + v0[3] * c0[2];
                            w1[0] = v1[0] * c1[0] - v1[1] * c1[1]; w1[1] = v1[0] * c1[1] + v1[1] * c1[0];
                            w1[2] = v1[2] * c1[2] - v1[3] * c1[3]; w1[3] = v1[2] * c1[3] + v1[3] * c1[2];
                            v0 = w0; v1 = w1;
                        }
                    }
                    if (MODE == 4) {
#pragma unroll
                        for (int e = 0; e < 4; ++e) { const float a = fmaxf(v0[e], 0.f), b = fmaxf(v1[e], 0.f); v0[e] = a * a; v1[e] = b * b; }
                    }
                    u32x4 w; w.x = cvt_pk_bf16(v0[0], v0[1]); w.y = cvt_pk_bf16(v0[2], v0[3]); w.z = cvt_pk_bf16(v1[0], v1[1]); w.w = cvt_pk_bf16(v1[2], v1[3]);
                    if (MODE == 1 && pn == 4) { if (col < 1088) *(u32x4*)(KR + (size_t)row * 64 + (col - 1024)) = w; }
                    else *(u32x4*)(O + (size_t)row * ldc + col) = w;
                }
                if (MODE == 0 || MODE == 1) {
                    if (MODE == 0 || pn < 4) {
                        sq += __shfl_xor(sq, 16); sq += __shfl_xor(sq, 32);
                        if (fq == 0) atomicAdd(ssq + (MODE == 1 ? (size_t)(pn >> 1) * NROW : (size_t)0) + row, sq);
                    }
                }
            }
    }
};

template <class Epi, class Sched, bool ALIGN_EPI = false, bool SP2 = false>
__device__ __forceinline__ void gemm_phase(PG8_LAS unsigned char* lds, const Gemm g, const Sched& S, const Epi& E, const int wave_) {
    const int wid = wave_, lane = lane_id_v(), tid = wid * 64 + lane, wr = wid >> 2, wc = wid & 3, fr = lane & 15, fq = lane >> 4;
    const int K = g.K, nt = K / BK, lda = g.lda, ldb = g.ldb;
    unsigned voffA[2], voffB[2];
#pragma unroll
    for (int i = 0; i < 2; ++i) { int R, C; stage_rc(tid * 16 + i * 8192, R, C); const int Rb = Epi::PERM ? ((R & ~31) + perm32(R & 31)) : R;
        voffA[i] = (unsigned)(R * lda + C) * 2u; voffB[i] = (unsigned)(Rb * ldb + C) * 2u; }
    const size_t kstep = (size_t)(BK * 2);
    const size_t hstepA = (size_t)HALF * lda * 2, hstepB = (size_t)HALF * ldb * 2;
    const size_t tstepA = 2 * hstepA, tstepB = 2 * hstepB;
    const unsigned ldsw = (unsigned)wid * 1024u;
    const int aoff = lds_byte(wr * 64 + fr, fq * 8), boff = lds_byte(wc * 32 + fr, fq * 8);
#define PG8_SA(b, h) (((b) * 2 + (h)) * HTB)
#define PG8_SB(b, h) ((4 + (b) * 2 + (h)) * HTB)
#define PG8_STAGE(bufoff, gbase, voff) do { _Pragma("unroll") for (int _i = 0; _i < 2; ++_i) \
        __builtin_amdgcn_global_load_lds((const unsigned*)((const char*)(gbase) + (voff)[_i]), (PG8_LAS unsigned*)(lds + (bufoff) + ldsw + _i * 8192), 16, 0, 0); } while (0)
#define PG8_LDA(dst, b, h) do { _Pragma("unroll") for (int m = 0; m < 4; ++m) _Pragma("unroll") for (int k = 0; k < 2; ++k) dst[m][k] = *(const PG8_LAS bf16x8*)(lds + PG8_SA(b, h) + aoff + m * 2048 + k * 1024); } while (0)
#define PG8_LDB(dst, b, h) do { _Pragma("unroll") for (int n = 0; n < 2; ++n) _Pragma("unroll") for (int k = 0; k < 2; ++k) dst[n][k] = *(const PG8_LAS bf16x8*)(lds + PG8_SB(b, h) + boff + n * 2048 + k * 1024); } while (0)
#define PG8_MMA(ai, bj, At, Bt) do { __builtin_amdgcn_s_setprio(1); _Pragma("unroll") for (int m = 0; m < 4; ++m) _Pragma("unroll") for (int n = 0; n < 2; ++n) _Pragma("unroll") for (int k = 0; k < 2; ++k) \
        acc[ai][bj][m][n] = __builtin_amdgcn_mfma_f32_16x16x32_bf16(Bt[n][k], At[m][k], acc[ai][bj][m][n], 0, 0, 0); __builtin_amdgcn_s_setprio(0); } while (0)
#define PG8_WAIT_V(n) asm volatile("s_waitcnt vmcnt(" #n ")" ::: "memory")
#define PG8_WAIT_L(n) asm volatile("s_waitcnt lgkmcnt(" #n ")" ::: "memory")
#define PG8_BAR __builtin_amdgcn_s_barrier()
#define PG8_SCHED __builtin_amdgcn_sched_barrier(0)
    Unit cur, nxt; int ui = 0;
    if (!S.next(0, cur)) return;
    f32x4 acc[2][2][4][2];
#pragma unroll
    for (int a = 0; a < 2; ++a)
#pragma unroll
        for (int b = 0; b < 2; ++b)
#pragma unroll
            for (int m = 0; m < 4; ++m)
#pragma unroll
                for (int n = 0; n < 2; ++n) acc[a][b][m][n] = (f32x4){0.f, 0.f, 0.f, 0.f};
    bf16x8 At[4][2], B0[2][2], B1[2][2];
    const char* cA = (const char*)g.A + (size_t)cur.pm * tstepA + (size_t)cur.kc * K * 2; const char* cB = (const char*)g.Bt + (size_t)cur.pn * tstepB + (size_t)cur.kc * K * 2;
    S.a_ready(cur);
    if constexpr (SP2) {
        PG8_STAGE(PG8_SB(0, 0), cB, voffB); PG8_STAGE(PG8_SB(0, 1), cB + hstepB, voffB); PG8_STAGE(PG8_SA(0, 0), cA, voffA); PG8_STAGE(PG8_SA(0, 1), cA + hstepA, voffA);
        if (wr == 1) PG8_BAR;
        PG8_WAIT_V(2); PG8_BAR;
        PG8_STAGE(PG8_SB(1, 0), cB + kstep, voffB); PG8_STAGE(PG8_SA(1, 0), cA + kstep, voffA); PG8_STAGE(PG8_SB(1, 1), cB + hstepB + kstep, voffB);
        PG8_WAIT_V(6); PG8_BAR;
    } else {
        PG8_STAGE(PG8_SB(0, 0), cB, voffB); PG8_STAGE(PG8_SA(0, 0), cA, voffA); PG8_STAGE(PG8_SB(0, 1), cB + hstepB, voffB); PG8_STAGE(PG8_SA(0, 1), cA + hstepA, voffA);
        if (wr == 1) PG8_BAR;
        PG8_WAIT_V(4); PG8_BAR;
        PG8_STAGE(PG8_SB(1, 0), cB + kstep, voffB); PG8_STAGE(PG8_SA(1, 0), cA + kstep, voffA); PG8_STAGE(PG8_SB(1, 1), cB + hstepB + kstep, voffB);
        PG8_WAIT_V(6); PG8_BAR;
    }
    for (;;) {
        const bool has_next = S.next(ui + 1, nxt);
        const char* nA = has_next ? (const char*)g.A + (size_t)nxt.pm * tstepA + (size_t)nxt.kc * K * 2 : cA; const char* nB = has_next ? (const char*)g.Bt + (size_t)nxt.pn * tstepB + (size_t)nxt.kc * K * 2 : cB;
        for (int t = 0; t < nt; t += 2) {
            const bool last = (t == nt - 2);
            const char* a1 = cA + (size_t)(t + 1) * kstep;
            const char* a2 = last ? nA : cA + (size_t)(t + 2) * kstep; const char* b2 = last ? nB : cB + (size_t)(t + 2) * kstep;
            const char* a3 = a2 + kstep; const char* b3 = b2 + kstep;
            if (last && has_next) S.a_ready(nxt);
            if constexpr (SP2) {
            PG8_LDB(B0, 0, 0); PG8_LDB(B1, 0, 1); PG8_SCHED; PG8_LDA(At, 0, 0); PG8_STAGE(PG8_SA(1, 1), a1 + hstepA, voffA);
            PG8_WAIT_V(8); PG8_WAIT_L(0); PG8_BAR; PG8_MMA(0, 0, At, B0); PG8_MMA(0, 1, At, B1); PG8_BAR; PG8_SCHED;
            PG8_LDA(At, 0, 1); PG8_STAGE(PG8_SB(0, 0), b2, voffB); PG8_STAGE(PG8_SB(0, 1), b2 + hstepB, voffB); PG8_STAGE(PG8_SA(0, 0), a2, voffA);
            PG8_WAIT_V(8); PG8_WAIT_L(0); PG8_BAR; PG8_MMA(1, 0, At, B0); PG8_MMA(1, 1, At, B1); PG8_BAR; PG8_SCHED;
            PG8_LDB(B0, 1, 0); PG8_LDB(B1, 1, 1); PG8_SCHED; PG8_LDA(At, 1, 0); PG8_STAGE(PG8_SA(0, 1), a2 + hstepA, voffA);
            PG8_WAIT_V(8); PG8_WAIT_L(0); PG8_BAR; PG8_MMA(0, 0, At, B0); PG8_MMA(0, 1, At, B1); PG8_BAR; PG8_SCHED;
            PG8_LDA(At, 1, 1); PG8_STAGE(PG8_SB(1, 0), b3, voffB); PG8_STAGE(PG8_SB(1, 1), b3 + hstepB, voffB); PG8_STAGE(PG8_SA(1, 0), a3, voffA);
            PG8_WAIT_V(8); PG8_WAIT_L(0); PG8_BAR; PG8_MMA(1, 0, At, B0); PG8_MMA(1, 1, At, B1); PG8_BAR; PG8_SCHED;
            } else {
            PG8_LDB(B0, 0, 0); PG8_SCHED; PG8_LDA(At, 0, 0); PG8_STAGE(PG8_SA(1, 1), a1 + hstepA, voffA);
            PG8_WAIT_L(8); PG8_BAR; PG8_WAIT_L(0); PG8_MMA(0, 0, At, B0); PG8_BAR; PG8_SCHED;
            PG8_LDB(B1, 0, 1); PG8_STAGE(PG8_SB(0, 0), b2, voffB);
            PG8_BAR; PG8_WAIT_L(0); PG8_MMA(0, 1, At, B1); PG8_BAR;
            PG8_LDA(At, 0, 1); PG8_STAGE(PG8_SA(0, 0), a2, voffA);
            PG8_BAR; PG8_WAIT_L(0); PG8_MMA(1, 0, At, B0); PG8_BAR; PG8_SCHED;
            PG8_STAGE(PG8_SB(0, 1), b2 + hstepB, voffB);
            PG8_WAIT_V(6); PG8_BAR; PG8_MMA(1, 1, At, B1); PG8_BAR;
            PG8_LDB(B0, 1, 0); PG8_SCHED; PG8_LDA(At, 1, 0); PG8_STAGE(PG8_SA(0, 1), a2 + hstepA, voffA);
            PG8_WAIT_L(8); PG8_BAR; PG8_WAIT_L(0); PG8_MMA(0, 0, At, B0); PG8_BAR; PG8_SCHED;
            PG8_LDB(B1, 1, 1); PG8_STAGE(PG8_SB(1, 0), b3, voffB);
            PG8_BAR; PG8_WAIT_L(0); PG8_MMA(0, 1, At, B1); PG8_BAR;
            PG8_LDA(At, 1, 1); PG8_STAGE(PG8_SA(1, 0), a3, voffA);
            PG8_BAR; PG8_WAIT_L(0); PG8_MMA(1, 0, At, B0); PG8_BAR; PG8_SCHED;
            PG8_STAGE(PG8_SB(1, 1), b3 + hstepB, voffB);
            PG8_WAIT_V(6); PG8_BAR; PG8_MMA(1, 1, At, B1); PG8_BAR;
            }
        }
        if constexpr (ALIGN_EPI) { if (wr == 0) PG8_BAR; }
        if constexpr (!Epi::AFTER_DRAIN) { E(acc, cur, wr, wc, fr, fq); S.done(cur); }
        if (!has_next) break;
#pragma unroll
        for (int a = 0; a < 2; ++a)
#pragma unroll
            for (int b = 0; b < 2; ++b)
#pragma unroll
                for (int m = 0; m < 4; ++m)
#pragma unroll
                    for (int n = 0; n < 2; ++n) acc[a][b][m][n] = (f32x4){0.f, 0.f, 0.f, 0.f};
        cur = nxt; cA = nA; cB = nB; ++ui;
        if constexpr (ALIGN_EPI) { if (wr == 1) PG8_BAR; }
    }
    PG8_WAIT_V(0);
    if constexpr (!ALIGN_EPI) { if (wr == 0) PG8_BAR; }
    PG8_BAR;
    if constexpr (Epi::AFTER_DRAIN) { E.fused(acc, cur, wr, wc, fr, fq, lds, wid, lane); S.done(cur); }
#undef PG8_SA
#undef PG8_SB
#undef PG8_STAGE
#undef PG8_LDA
#undef PG8_LDB
#undef PG8_MMA
#undef PG8_WAIT_V
#undef PG8_WAIT_L
#undef PG8_BAR
#undef PG8_SCHED
}
}

namespace att {
typedef unsigned short bf16_t;
using bf16x8 = __attribute__((ext_vector_type(8))) short;
using s16x4  = __attribute__((ext_vector_type(4))) short;
using f32x16 = __attribute__((ext_vector_type(16))) float;
using u32x4  = __attribute__((ext_vector_type(4))) unsigned;
#define KSWZ(row, colB) ((row) * 256 + ((colB) ^ (((row) & 15) << 4)))
#define KSWZ64(row, colB) ((row) * 128 + ((colB) ^ ((((row) >> 1) & 7) << 4)))
#define SBAR() __builtin_amdgcn_sched_barrier(0)
__device__ __forceinline__ int crow(int r, int hi) { return (r & 3) + 8 * (r >> 2) + 4 * hi; }
__device__ __forceinline__ unsigned cvtpk(float lo, float hi) { unsigned r; asm volatile("v_cvt_pk_bf16_f32 %0, %1, %2" : "=v"(r) : "v"(lo), "v"(hi)); return r; }

__device__ __forceinline__ void partialSM(f32x16& p0, f32x16& p1, float& m_reg, float& alpha, const float C, const float THRS) {
  float pmax = p0[0];
#pragma unroll
  for (int r = 1; r < 16; ++r) pmax = fmaxf(pmax, p0[r]);
#pragma unroll
  for (int r = 0; r < 16; ++r) pmax = fmaxf(pmax, p1[r]);
  { auto rr = __builtin_amdgcn_permlane32_swap(__float_as_uint(pmax), __float_as_uint(pmax), false, false);
    pmax = fmaxf(__uint_as_float(rr[0]), __uint_as_float(rr[1])); }
  float mn;
  if (__builtin_expect(__all(pmax - m_reg <= THRS), 1)) { mn = m_reg; alpha = 1.f; }
  else { mn = fmaxf(m_reg, pmax); alpha = __builtin_amdgcn_exp2f((m_reg - mn) * C); m_reg = mn; }
  const float mnC = -mn * C;
#pragma unroll
  for (int r = 0; r < 16; ++r) p0[r] = fmaf(p0[r], C, mnC);
#pragma unroll
  for (int r = 0; r < 16; ++r) p1[r] = fmaf(p1[r], C, mnC);
#pragma unroll
  for (int r = 0; r < 16; ++r) p0[r] = __builtin_amdgcn_exp2f(p0[r]);
}
__device__ __forceinline__ void finishSM(f32x16& p0, f32x16& p1, float alpha, float& l_reg, bf16x8& pa0, bf16x8& pa1, bf16x8& pa2, bf16x8& pa3) {
#pragma unroll
  for (int r = 0; r < 16; ++r) p1[r] = __builtin_amdgcn_exp2f(p1[r]);
  float ps = 0;
#pragma unroll
  for (int r = 0; r < 16; ++r) ps += p0[r];
#pragma unroll
  for (int r = 0; r < 16; ++r) ps += p1[r];
  { auto rr = __builtin_amdgcn_permlane32_swap(__float_as_uint(ps), __float_as_uint(ps), false, false);
    ps = __uint_as_float(rr[0]) + __uint_as_float(rr[1]); }
  l_reg = l_reg * alpha + ps;
#define PK4(P, BASE, OUT) do { unsigned a0 = cvtpk(P[BASE + 0], P[BASE + 1]), a1 = cvtpk(P[BASE + 2], P[BASE + 3]);   \
    unsigned b0 = cvtpk(P[BASE + 4], P[BASE + 5]), b1 = cvtpk(P[BASE + 6], P[BASE + 7]);                              \
    auto r0 = __builtin_amdgcn_permlane32_swap(a0, b0, false, false); auto r1 = __builtin_amdgcn_permlane32_swap(a1, b1, false, false); \
    u32x4 w = {r0[0], r1[0], r0[1], r1[1]}; OUT = *reinterpret_cast<bf16x8*>(&w); } while (0)
  PK4(p0, 0, pa0); PK4(p0, 8, pa1); PK4(p1, 0, pa2); PK4(p1, 8, pa3);
#undef PK4
}
template <int DN>
__device__ __forceinline__ void qkt(f32x16& p0, f32x16& p1, const char* Kn, const char* Kr, const bf16x8* qr, const char* qrl, int r32, int hi) {
  p0 = f32x16{}; p1 = f32x16{};
  if constexpr (DN > 0) {
#pragma unroll
    for (int d0 = 0; d0 < DN / 16; ++d0) { const int cb = (d0 * 16 + hi * 8) * 2;
      bf16x8 b0 = *reinterpret_cast<const bf16x8*>(Kn + KSWZ(r32, cb));
      bf16x8 b1 = *reinterpret_cast<const bf16x8*>(Kn + KSWZ(32 + r32, cb));
      p0 = __builtin_amdgcn_mfma_f32_32x32x16_bf16(b0, qr[d0], p0, 0, 0, 0);
      p1 = __builtin_amdgcn_mfma_f32_32x32x16_bf16(b1, qr[d0], p1, 0, 0, 0); }
  }
#pragma unroll
  for (int d0 = 0; d0 < 4; ++d0) { const int cb = (d0 * 16 + hi * 8) * 2;
    bf16x8 b0 = *reinterpret_cast<const bf16x8*>(Kr + KSWZ64(r32, cb));
    bf16x8 b1 = *reinterpret_cast<const bf16x8*>(Kr + KSWZ64(32 + r32, cb));
    bf16x8 q; if constexpr (DN > 0) q = *reinterpret_cast<const bf16x8*>(qrl + d0 * 1024); else q = qr[d0];
    p0 = __builtin_amdgcn_mfma_f32_32x32x16_bf16(b0, q, p0, 0, 0, 0);
    p1 = __builtin_amdgcn_mfma_f32_32x32x16_bf16(b1, q, p1, 0, 0, 0); }
}
__device__ __forceinline__ void band_mask(f32x16& p0, f32x16& p1, int d) {
#pragma unroll
  for (int r = 0; r < 16; ++r) { const int v = d - ((r & 3) + 8 * (r >> 2));
    if (v > 128 || v < -128) p0[r] = -1e30f;
    if (v - 32 > 128 || v - 32 < -128) p1[r] = -1e30f; }
}
__device__ __forceinline__ int v_rd_base(int lane) { return ((lane & 3) << 3) | (((lane >> 2) & 3) << 6) | (((lane >> 4) & 1) << 5) | (((lane >> 5) & 1) << 8); }
template <int NCB> constexpr int v_rd_off(int d0, int ks, int half) { return d0 * 512 + ks * (2 * NCB * 512) + half * (NCB * 512); }
template <int OFF> __device__ __forceinline__ s16x4 tr_read(int vb) {
  s16x4 r; asm volatile("ds_read_b64_tr_b16 %0, %1 offset:%2" : "=&v"(r) : "v"(vb), "i"(OFF) : "memory"); return r;
}
template <int D0, int NCB> __device__ __forceinline__ void pv_one(f32x16& od, int vb, bf16x8 pa0, bf16x8 pa1, bf16x8 pa2, bf16x8 pa3) {
  const s16x4 l0 = tr_read<v_rd_off<NCB>(D0, 0, 0)>(vb), h0 = tr_read<v_rd_off<NCB>(D0, 0, 1)>(vb), l1 = tr_read<v_rd_off<NCB>(D0, 1, 0)>(vb), h1 = tr_read<v_rd_off<NCB>(D0, 1, 1)>(vb);
  const s16x4 l2 = tr_read<v_rd_off<NCB>(D0, 2, 0)>(vb), h2 = tr_read<v_rd_off<NCB>(D0, 2, 1)>(vb), l3 = tr_read<v_rd_off<NCB>(D0, 3, 0)>(vb), h3 = tr_read<v_rd_off<NCB>(D0, 3, 1)>(vb);
  asm volatile("s_waitcnt lgkmcnt(0)" ::: "memory"); SBAR();
#define PK(L, H) (bf16x8){L[0], L[1], L[2], L[3], H[0], H[1], H[2], H[3]}
  od = __builtin_amdgcn_mfma_f32_32x32x16_bf16(pa0, PK(l0, h0), od, 0, 0, 0);
  od = __builtin_amdgcn_mfma_f32_32x32x16_bf16(pa1, PK(l1, h1), od, 0, 0, 0);
  od = __builtin_amdgcn_mfma_f32_32x32x16_bf16(pa2, PK(l2, h2), od, 0, 0, 0);
  od = __builtin_amdgcn_mfma_f32_32x32x16_bf16(pa3, PK(l3, h3), od, 0, 0, 0);
#undef PK
}
template <int NCB> __device__ __forceinline__ void pv_all(f32x16* o, int vb, bf16x8 pa0, bf16x8 pa1, bf16x8 pa2, bf16x8 pa3) {
  pv_one<0, NCB>(o[0], vb, pa0, pa1, pa2, pa3); pv_one<1, NCB>(o[1], vb, pa0, pa1, pa2, pa3);
  if constexpr (NCB == 4) { pv_one<2, NCB>(o[2], vb, pa0, pa1, pa2, pa3); pv_one<3, NCB>(o[3], vb, pa0, pa1, pa2, pa3); }
}

#define ATT_LAS __attribute__((address_space(3)))
template <int DN, int DV, bool MASK>
__device__ __forceinline__ void attn_unit(const bf16_t* __restrict__ Qb, const int ldq, const bf16_t* __restrict__ Kn, const int ldkn,
    const bf16_t* __restrict__ Kr, const int ldkr, const bf16_t* __restrict__ Vp, const int ldv, bf16_t* __restrict__ Ob, const int ldo,
    const int NT, const int n1, const int r1, const int r2, const int qpos0, const int kt2,
    const float C, const float THRS, const float sinkl2, char* lds, ATT_LAS unsigned char* ldsL, const int wave_) {
  constexpr int NQR = DN > 0 ? DN / 16 : 4, NCB = DV / 32, VB = 64 * DV * 2, KNB = 64 * DN * 2, KRB = 64 * 64 * 2, BUF = VB + KNB + KRB;
  constexpr int NVC = VB / 8192, NKC = KNB / 8192;
  const int wid = wave_, lane = lane_id_v(), r32 = lane & 31, hi = lane >> 5;
  char* Vl = lds; char* Knl = lds + VB; char* Krl = lds + VB + KNB;
  float* wsf = (float*)(lds + 3 * BUF) + wid * 64; float* li_l = wsf; float* al_l = wsf + 32;
  float m_reg = -1e30f, l_reg = 0; f32x16 o[NCB] = {}; bf16x8 qr[NQR];
  const bf16_t* Qw = Qb + (MASK ? (long)r32 * ldq + wid * 64 : (long)(wid * 32 + r32) * ldq) + hi * 8;
#pragma unroll
  for (int d0 = 0; d0 < NQR; ++d0) qr[d0] = *reinterpret_cast<const bf16x8*>(Qw + d0 * 16);
  char* qrl = lds + 3 * BUF + 2048 + wid * 4096 + lane * 16;
  if constexpr (DN > 0) {
#pragma unroll
    for (int d0 = 0; d0 < 4; ++d0) *reinterpret_cast<bf16x8*>(qrl + d0 * 1024) = *reinterpret_cast<const bf16x8*>(Qw + DN + d0 * 16);
  }
  int offV[NVC], offK[NKC > 0 ? NKC : 1], offR;
#pragma unroll
  for (int i = 0; i < NVC; ++i) { const int ch = wid * NVC + i, sub = ch * 2 + (lane >> 5), kk = (sub / NCB) * 8 + ((lane & 31) >> 2), col = (sub % NCB) * 32 + (lane & 3) * 8;
    const int k = (kk & ~0xC) | ((kk & 4) << 1) | ((kk & 8) >> 1); offV[i] = k * ldv + col; }
#pragma unroll
  for (int i = 0; i < NKC; ++i) { const int ch = wid * NKC + i, row = ch * 4 + (lane >> 4), cb = ((lane & 15) * 16) ^ ((row & 15) << 4); offK[i] = row * ldkn + (cb >> 1); }
  { const int row = wid * 8 + (lane >> 3), cb = ((lane & 7) * 16) ^ (((row >> 1) & 7) << 4); offR = row * ldkr + (cb >> 1); }
  const int vb0 = (int)(uintptr_t)Vl + v_rd_base(lane);
  const int qd = qpos0 + (MASK ? 0 : wid * 32) + r32 - 4 * hi;
#define TROW(j) ((j) < n1 ? r1 + 64 * (j) : r2 + 64 * ((j) - n1))
#define DMA(j, b) do { const long row0_ = TROW(j); \
    _Pragma("unroll") for (int i_ = 0; i_ < NVC; ++i_) __builtin_amdgcn_global_load_lds((const unsigned*)(Vp + row0_ * ldv + offV[i_]), (ATT_LAS unsigned*)(ldsL + (b) + (wid * NVC + i_) * 1024), 16, 0, 0); \
    _Pragma("unroll") for (int i_ = 0; i_ < NKC; ++i_) __builtin_amdgcn_global_load_lds((const unsigned*)(Kn + row0_ * ldkn + offK[i_]), (ATT_LAS unsigned*)(ldsL + (b) + VB + (wid * NKC + i_) * 1024), 16, 0, 0); \
    __builtin_amdgcn_global_load_lds((const unsigned*)(Kr + row0_ * ldkr + offR), (ATT_LAS unsigned*)(ldsL + (b) + VB + KNB + wid * 1024), 16, 0, 0); } while (0)
#define WAITV() asm volatile("s_waitcnt vmcnt(0)" ::: "memory")
  const int q0w = qpos0 + (MASK ? 0 : wid * 32);
#define KP(j) (kt2 + 64 * ((j) - n1))
#define NEED(j) (!MASK || (j) < n1 || (KP(j) <= q0w + 159 && KP(j) + 63 >= q0w - 128))
#define SCORE(P0, P1, b, j) do { qkt<DN>(P0, P1, Knl + (b), Krl + (b), qr, qrl, r32, hi); \
    if constexpr (MASK) { if ((j) >= n1 && !(KP(j) >= q0w - 97 && KP(j) <= q0w + 65)) band_mask(P0, P1, qd - KP(j)); } } while (0)
#define RESC(a) do { if (__any((a) < 1.f)) { const int l_ = lane_id_v(); if (l_ < 32) al_l[l_] = (a); asm volatile("s_waitcnt lgkmcnt(0)" ::: "memory"); \
    _Pragma("unroll") for (int d = 0; d < NCB; ++d) _Pragma("unroll") for (int r = 0; r < 16; ++r) o[d][r] *= al_l[crow(r, l_ >> 5)]; } } while (0)
#define ROT() do { const int t_ = bp; bp = bc; bc = bn; bn = t_; } while (0)
  f32x16 pA0, pA1, pB0, pB1; float alA, alB; bf16x8 pa0, pa1, pa2, pa3;
  int bp = 0, bc = BUF, bn = 2 * BUF;
  DMA(0, 0); DMA(1, BUF); WAITV(); __syncthreads();
  SCORE(pA0, pA1, 0, 0); partialSM(pA0, pA1, m_reg, alA, C, THRS);
  bool nA = true, nB = true;
  for (int j = 1; j + 1 < NT; j += 2) {
    DMA(j + 1, bn);
    nB = NEED(j);
    SBAR(); if (nB) SCORE(pB0, pB1, bc, j);
    if (nA) finishSM(pA0, pA1, alA, l_reg, pa0, pa1, pa2, pa3); SBAR();
    if (nA) pv_all<NCB>(o, vb0 + bp, pa0, pa1, pa2, pa3);
    if (nB) { partialSM(pB0, pB1, m_reg, alB, C, THRS); RESC(alB); }
    WAITV(); __syncthreads(); ROT();
    DMA(j + 2, bn);
    nA = NEED(j + 1);
    SBAR(); if (nA) SCORE(pA0, pA1, bc, j + 1);
    if (nB) finishSM(pB0, pB1, alB, l_reg, pa0, pa1, pa2, pa3); SBAR();
    if (nB) pv_all<NCB>(o, vb0 + bp, pa0, pa1, pa2, pa3);
    if (nA) { partialSM(pA0, pA1, m_reg, alA, C, THRS); RESC(alA); }
    WAITV(); __syncthreads(); ROT();
  }
  nB = NEED(NT - 1);
  SBAR(); if (nB) SCORE(pB0, pB1, bc, NT - 1);
  if (nA) finishSM(pA0, pA1, alA, l_reg, pa0, pa1, pa2, pa3); SBAR();
  if (nA) pv_all<NCB>(o, vb0 + bp, pa0, pa1, pa2, pa3);
  if (nB) { partialSM(pB0, pB1, m_reg, alB, C, THRS);
    RESC(alB);
    finishSM(pB0, pB1, alB, l_reg, pa0, pa1, pa2, pa3); SBAR();
    pv_all<NCB>(o, vb0 + bc, pa0, pa1, pa2, pa3); }
  l_reg += __builtin_amdgcn_exp2f(sinkl2 - m_reg * C);
  const int lane2 = lane_id_v(), r32e = lane2 & 31, hie = lane2 >> 5;
  if (hie == 0) li_l[r32e] = l_reg; asm volatile("s_waitcnt lgkmcnt(0)" ::: "memory");
  float rli[16];
#pragma unroll
  for (int r = 0; r < 16; ++r) rli[r] = __builtin_amdgcn_rcpf(li_l[crow(r, hie)]);
  bf16_t* Ow = Ob + (MASK ? (long)(wid * 64) : (long)(wid * 32) * ldo);
#pragma unroll
  for (int r = 0; r < 16; ++r) { const int orow = crow(r, hie);
#pragma unroll
    for (int d0 = 0; d0 < NCB; ++d0) Ow[(long)orow * ldo + d0 * 32 + r32e] = (bf16_t)(cvtpk(o[d0][r] * rli[r], 0.f) & 0xffffu); }
  __syncthreads();
#undef TROW
#undef DMA
#undef WAITV
#undef SCORE
#undef RESC
#undef ROT
#undef KP
#undef NEED
}
}

constexpr size_t MiB = 1u << 20;
constexpr size_t WS_MOD = 0;
constexpr size_t WS_SSQ = 512 * 1024;
constexpr size_t WS_ROPE = 1792 * 1024;
constexpr size_t CTL_ZERO_BYTES = 2 * MiB;
constexpr size_t WS_XC = 2 * MiB;
constexpr size_t WS_WIN = 8 * MiB, WS_WQB = 13 * MiB, WS_WKVB = 16 * MiB, WS_WOM = 20 * MiB, WS_WF1 = 28 * MiB, WS_WF2 = 92 * MiB, WS_WQKV = 156 * MiB, WS_WOS = 166 * MiB;
constexpr size_t WS_S1 = 176 * MiB;
constexpr size_t WS_S2 = 306 * MiB;
constexpr size_t WS_G = 436 * MiB;
constexpr size_t WS_Q = WS_G, WS_KV = WS_G + 196 * MiB, WS_KR = WS_G + 456 * MiB;
constexpr size_t WS_PART = WS_G + 520 * MiB;
constexpr size_t WS_END = WS_PART + 64 * MiB;
static_assert((size_t)NROW * 2048 * 2 == 130 * MiB && WS_SSQ + 8 * (size_t)NROW * 4 <= WS_ROPE && (size_t)NROW * NQ * 2 <= 196 * MiB && (size_t)NROW * NKV * 2 <= 260 * MiB, "ws map");

#define LAS __attribute__((address_space(3)))
typedef unsigned short bf16_t;
typedef float f32x4 __attribute__((ext_vector_type(4)));
typedef unsigned u32x4 __attribute__((ext_vector_type(4)));
typedef unsigned u32x2 __attribute__((ext_vector_type(2)));
constexpr int LDS_BYTES = 3 * 40960 + 2048 + 32768;
constexpr int N_PHASES = 17;
#ifndef PROBE_PH
#define PROBE_PH -1
#endif
#ifndef PROBE_PH2
#define PROBE_PH2 -1
#endif
#if PROBE_PH >= 0
#define rep_PROBE0 (rep_ != 0)
#define REP(k) for (int rep_ = 0; rep_ < ((((PROBE_PH) >> (k)) & 1) ? 2 : 1); ++rep_)
#define SSQP(i) (rep_ ? SSQ + 6 * NROW : SSQ + (i) * NROW)
#else
#define rep_PROBE0 false
#define REP(k)
#define SSQP(i) (SSQ + (i) * NROW)
#endif

struct Args { const float* in[18]; float* out; unsigned char* ws; int ph_lo, ph_hi; };

__device__ __forceinline__ float wave_sum(float v) {
#pragma unroll
  for (int o = 1; o < 64; o <<= 1) v += __shfl_xor(v, o);
  return v;
}
__device__ __forceinline__ unsigned pk2(float lo, float hi) { unsigned r; asm volatile("v_cvt_pk_bf16_f32 %0, %1, %2" : "=v"(r) : "v"(lo), "v"(hi)); return r; }

__device__ __forceinline__ int dest_row(int mode, int n) {
  if (mode == 1) { if (n < 1024) return n; const int j = n - 1024; return 1024 + (((j & 31) << 1) | (j >> 5)); }
  if (mode == 2) { const int h = n / 192, d = n - h * 192; if (d < 128) return n; const int j = d - 128; return h * 192 + 128 + (((j & 31) << 1) | (j >> 5)); }
  if (mode == 3) { if (n >= 2304) return n; const int d = n & 63; return (n & ~63) + (((d & 31) << 1) | (d >> 5)); }
  return n;
}
__device__ __forceinline__ void tr_item(const float* __restrict__ W, int K, int N, bf16_t* __restrict__ WT, const float* __restrict__ ks, int mode, LAS float* scr, int item, int lane) {
  const int nblk = N / 32, kb = item / nblk, nb = item - kb * nblk, k0 = 64 * kb, n0 = 32 * nb;
  float wv[32];
#pragma unroll
  for (int i = 0; i < 32; ++i) wv[i] = W[(size_t)(k0 + 2 * i + (lane >> 5)) * N + n0 + (lane & 31)];
  if (ks) {
#pragma unroll
    for (int i = 0; i < 32; ++i) wv[i] *= ks[k0 + 2 * i + (lane >> 5)];
  }
#pragma unroll
  for (int i = 0; i < 32; ++i) scr[(2 * i + (lane >> 5)) * 33 + (lane & 31)] = wv[i];
  asm volatile("s_waitcnt lgkmcnt(0)" ::: "memory");
  const int c = lane & 7;
#pragma unroll
  for (int j = 0; j < 4; ++j) { const int n = (lane >> 3) + 8 * j; const LAS float* s = scr + (8 * c) * 33 + n;
    u32x4 o; o.x = pk2(s[0 * 33], s[1 * 33]); o.y = pk2(s[2 * 33], s[3 * 33]); o.z = pk2(s[4 * 33], s[5 * 33]); o.w = pk2(s[6 * 33], s[7 * 33]);
    *(u32x4*)(WT + (size_t)dest_row(mode, n0 + n) * K + k0 + 8 * c) = o; }
  asm volatile("s_waitcnt lgkmcnt(0)" ::: "memory");
}

__device__ __forceinline__ float silu_f(float x) { return x / (1.f + __expf(-x)); }

constexpr int TI0 = 32 * 34, TI1 = 8 * 96, TI2 = 8 * 128, TI3 = 32 * 64, TI4 = 32 * 256, TI6 = 128 * 64, TI8 = 32 * 80, TI9 = 32 * 64;
constexpr int N_EARLY = TI0 + TI1 + TI2, N_LATE = TI3 + 2 * TI4 + 2 * TI6 + TI8 + TI9;
__device__ __forceinline__ void tr_dispatch(const Args& a, int it  , LAS float* scr, int lane) {
  unsigned char* ws = a.ws;
  int r = it; const float* W; int K, N, mode = 0; const float* ks = nullptr; bf16_t* dst;
  if (r < TI0) { W = a.in[9]; K = 2048; N = 1088; mode = 1; dst = (bf16_t*)(ws + WS_WIN); }
  else if ((r -= TI0) < TI1) { W = a.in[12]; K = 512; N = 3072; mode = 2; ks = a.in[10]; dst = (bf16_t*)(ws + WS_WQB); }
  else if ((r -= TI1) < TI2) { W = a.in[13]; K = 512; N = 4096; ks = a.in[11]; dst = (bf16_t*)(ws + WS_WKVB); }
  else if ((r -= TI2) < TI3) { W = a.in[14]; K = 2048; N = 2048; dst = (bf16_t*)(ws + WS_WOM); }
  else if ((r -= TI3) < 2 * TI4) { const int l = r / TI4; r -= l * TI4; W = a.in[7] + (size_t)l * 2048 * 8192; K = 2048; N = 8192; dst = (bf16_t*)(ws + WS_WF1) + (size_t)l * 2048 * 8192; }
  else if ((r -= 2 * TI4) < 2 * TI6) { const int l = r / TI6; r -= l * TI6; W = a.in[8] + (size_t)l * 2048 * 8192; K = 8192; N = 2048; dst = (bf16_t*)(ws + WS_WF2) + (size_t)l * 2048 * 8192; }
  else if ((r -= 2 * TI6) < TI8) { W = a.in[15]; K = 2048; N = 2560; mode = 3; dst = (bf16_t*)(ws + WS_WQKV); }
  else { r -= TI8; W = a.in[17]; K = 2048; N = 2048; dst = (bf16_t*)(ws + WS_WOS); }
  tr_item(W, K, N, dst, ks, mode, scr, r, lane);
}

__device__ __forceinline__ void p0_prologue(const Args& a, LAS unsigned char* lds, int gw, int NGW, int wave, int lane, bool only_transposes) {
  unsigned char* ws = a.ws;
  LAS float* scr = (LAS float*)(lds + wave * 16384);
  for (int it = gw; it < N_EARLY + N_LATE; it += NGW) tr_dispatch(a, it, scr, lane);
  if (only_transposes) return;
  float* MOD = (float*)(ws + WS_MOD);
  for (int it = gw; it < 2 * 48 * 64; it += NGW) {
    const int kc = it & 63, cb = (it >> 6) % 48, l = it / (64 * 48);
    const int n0 = cb * 256 + lane * 4, k0 = kc * 32;
    const float* Wm = a.in[4] + (size_t)l * 2048 * 12288 + n0;
    f32x4 a0 = {0.f, 0.f, 0.f, 0.f}, a1 = a0, a2 = a0;
#pragma unroll 16
    for (int k = 0; k < 32; ++k) { const int kk = k0 + k;
      const float s0 = silu_f(a.in[1][kk]), s1 = silu_f(a.in[1][2048 + kk]), s2 = silu_f(a.in[3][kk]);
      const f32x4 w = *(const f32x4*)(Wm + (size_t)kk * 12288);
      a0 += w * s0; a1 += w * s1; a2 += w * s2; }
    if (kc == 0) { const f32x4 b = *(const f32x4*)(a.in[5] + l * 12288 + n0); a0 += b; a1 += b; a2 += b; }
    float* mo = MOD + (size_t)(l * 3) * 12288 + n0;
#pragma unroll
    for (int e = 0; e < 4; ++e) { atomicAdd(mo + e, a0[e]); atomicAdd(mo + 12288 + e, a1[e]); atomicAdd(mo + 2 * 12288 + e, a2[e]); }
  }
  float* tab = (float*)(ws + WS_ROPE);
  for (int e = gw * 64 + lane; e < 320 * 16; e += NGW * 64) {
    const int i = e & 15, pos = e >> 4; const float p = (float)(pos < 256 ? pos : pos - 256);
    const float freq = exp2f(-(float)i * 0.8304820237218406f); const float ang = p * freq;
    tab[e * 2] = cosf(ang); tab[e * 2 + 1] = sinf(ang);
  }
}

__device__ __forceinline__ f32x4 ldf4(const float* base, unsigned boff) { return *(const f32x4*)((const char*)base + boff); }
__device__ __forceinline__ void stf4(float* base, unsigned boff, f32x4 v) { *(f32x4*)((char*)base + boff) = v; }
__device__ __forceinline__ f32x4 ldf4s(const float* base, unsigned boff) { return __builtin_nontemporal_load((const f32x4*)((const char*)base + boff)); }
__device__ __forceinline__ void stf4s(float* base, unsigned boff, f32x4 v) { __builtin_nontemporal_store(v, (f32x4*)((char*)base + boff)); }
template <bool UPD, bool DOH, int NKC>
__device__ __forceinline__ void norm_rows(const int row0, const int nrows, const float* xin_lat, const float* xin_ctx, float* xout_lat, float* xout_ctx, const bf16_t* Y, const float* ssq,
    const float* gA, const float* gateM, const float* gB, const float* scM, const float* shM, bf16_t* H, int lane, const float* part) {
  const int b = row0 / TB, rb = row0 - b * TB; const bool isctx = rb < CTXL;
  const int v = isctx ? 2 : b;
  const size_t xoff = isctx ? (size_t)(b * CTXL + rb) * DM : (size_t)(b * SEQ + rb - CTXL) * DM;
  const float* xin = (isctx ? xin_ctx : xin_lat) + xoff;
  float* xout = UPD ? ((isctx ? xout_ctx : xout_lat) + xoff) : nullptr;
  const int lane_ = lane_id_v();
  const unsigned lo = (unsigned)lane_ * 16u, lo2 = (unsigned)lane_ * 8u;
  f32x4 GA[8], GB[8], SH[8];
#pragma unroll
  for (int j = 0; j < 8; ++j) { const unsigned o = lo + 1024u * j;
    if (UPD) GA[j] = ldf4(gateM + v * 12288, o) * ldf4(gA, o);
    if (DOH) { GB[j] = ldf4(gB, o) * (ldf4(scM + v * 12288, o) + 1.0f); SH[j] = ldf4(shM + v * 12288, o); } }
  f32x4 xn[8]; u32x2 yn[8];
#pragma unroll
  for (int j = 0; j < 8; ++j) { xn[j] = ldf4s(xin, lo + 1024u * j); if (UPD && !(NKC > 0 && isctx)) yn[j] = __builtin_nontemporal_load((const u32x2*)((const char*)(Y + (size_t)row0 * DM) + lo2 + 512u * j)); }
  for (int rr = 0; rr < nrows; ++rr) {
    const int row = row0 + rr;
    f32x4 x[8]; u32x2 yc[8];
#pragma unroll
    for (int j = 0; j < 8; ++j) { x[j] = xn[j]; if (UPD) yc[j] = yn[j]; }
    if (rr + 1 < nrows) { const float* xr = xin + (size_t)(rr + 1) * DM;
#pragma unroll
      for (int j = 0; j < 8; ++j) { xn[j] = ldf4s(xr, lo + 1024u * j); if (UPD && !(NKC > 0 && isctx)) yn[j] = __builtin_nontemporal_load((const u32x2*)((const char*)(Y + (size_t)(row + 1) * DM) + lo2 + 512u * j)); } }
    if (UPD && NKC > 0 && isctx) {
      f32x4 y[8]; float ys = 0.f; const float* pr = part + (size_t)(b * CTXL + rb + rr) * DM;
#pragma unroll
      for (int j = 0; j < 8; ++j) y[j] = ldf4(pr, lo + 1024u * j);
#pragma unroll 1
      for (int k = 1; k < NKC; ++k) { pr += (size_t)512 * DM;
#pragma unroll
        for (int j = 0; j < 8; ++j) y[j] += ldf4(pr, lo + 1024u * j); }
#pragma unroll
      for (int j = 0; j < 8; ++j) ys += (y[j][0] * y[j][0] + y[j][1] * y[j][1]) + (y[j][2] * y[j][2] + y[j][3] * y[j][3]);
      const float rinv = __builtin_amdgcn_rsqf(wave_sum(ys) * (1.0f / 2048.0f) + NORM_EPS);
      float* xo = xout + (size_t)rr * DM;
#pragma unroll
      for (int j = 0; j < 8; ++j) { x[j] += GA[j] * (y[j] * rinv); stf4s(xo, lo + 1024u * j, x[j]); }
    } else if (UPD) {
      const float rinv = __builtin_amdgcn_rsqf(ssq[row] * (1.0f / 2048.0f) + NORM_EPS);
      float* xo = xout + (size_t)rr * DM;
#pragma unroll
      for (int j = 0; j < 8; ++j) { const u32x2 yb = yc[j];
        f32x4 y; y[0] = __uint_as_float(yb.x << 16); y[1] = __uint_as_float(yb.x & 0xffff0000u); y[2] = __uint_as_float(yb.y << 16); y[3] = __uint_as_float(yb.y & 0xffff0000u);
        x[j] += GA[j] * (y * rinv);
        stf4s(xo, lo + 1024u * j, x[j]); }
    }
    if (DOH) {
      float ss = 0.f;
#pragma unroll
      for (int j = 0; j < 8; ++j) ss += (x[j][0] * x[j][0] + x[j][1] * x[j][1]) + (x[j][2] * x[j][2] + x[j][3] * x[j][3]);
      const float r = __builtin_amdgcn_rsqf(wave_sum(ss) * (1.0f / 2048.0f) + NORM_EPS);
      bf16_t* hr = H + (size_t)row * DM;
#pragma unroll
      for (int j = 0; j < 8; ++j) { const f32x4 h = x[j] * r * GB[j] + SH[j]; u32x2 w; w.x = pk2(h[0], h[1]); w.y = pk2(h[2], h[3]);
        *(u32x2*)((char*)hr + lo2 + 512u * j) = w; }
    }
  }
}
template <bool UPD, bool DOH, int NKC = 0>
__device__ __forceinline__ void norm_phase(const float* xin_lat, const float* xin_ctx, float* xout_lat, float* xout_ctx, const bf16_t* Y, const float* ssq,
    const float* gA, const float* gateM, const float* gB, const float* scM, const float* shM, bf16_t* H, bool skipctx, int gw, int NGW, int lane, const float* part = nullptr) {
  for (int ch = gw; ch < 2 * SEQ / 16; ch += NGW) { const int b = ch / (SEQ / 16), row0 = b * TB + CTXL + (ch - b * (SEQ / 16)) * 16;
    norm_rows<UPD, DOH, 0>(row0, 16, xin_lat, xin_ctx, xout_lat, xout_ctx, Y, ssq, gA, gateM, gB, scM, shM, H, lane, part); }
  if (!skipctx)
    for (int r = gw; r < 2 * CTXL; r += NGW) { const int b = r / CTXL, row0 = b * TB + (r - b * CTXL);
      norm_rows<UPD, DOH, NKC>(row0, 1, xin_lat, xin_ctx, xout_lat, xout_ctx, Y, ssq, gA, gateM, gB, scM, shM, H, lane, part); }
}

__global__ void __launch_bounds__(512, 2) mk_fwd(Args a) {
  extern __shared__ __attribute__((aligned(16))) unsigned char lds[];
  cg::grid_group grid = cg::this_grid();
  const int wave = __builtin_amdgcn_readfirstlane(threadIdx.x >> 6);
  const int G = gridDim.x, c = blockIdx.x, gw = c * 8 + wave, NGW = G * 8;
  LAS unsigned char* ldsL = (LAS unsigned char*)lds;
  unsigned char* ws = a.ws;
  const int lo = a.ph_lo, hi = a.ph_hi;
#define IN(k) (lo <= (k) && (k) < hi)
  unsigned* barw = (unsigned*)(ws + CTL_ZERO_BYTES - 256); unsigned bar_epoch = 0;
#define OWN_BAR() do { __builtin_amdgcn_fence(__ATOMIC_RELEASE, "workgroup"); __builtin_amdgcn_s_barrier(); bar_epoch += (unsigned)G; \
    if (wave == 0) { if (lane_id_v() == 0) { __builtin_amdgcn_fence(__ATOMIC_ACQUIRE, "workgroup"); __builtin_amdgcn_fence(__ATOMIC_RELEASE, "agent"); \
      __hip_atomic_fetch_add(barw, 1u, __ATOMIC_RELAXED, __HIP_MEMORY_SCOPE_AGENT); \
      while (__hip_atomic_load(barw, __ATOMIC_RELAXED, __HIP_MEMORY_SCOPE_AGENT) < bar_epoch) __builtin_amdgcn_s_sleep(1); \
      __builtin_amdgcn_fence(__ATOMIC_ACQUIRE, "agent"); __builtin_amdgcn_fence(__ATOMIC_RELEASE, "workgroup"); } } \
    __builtin_amdgcn_s_barrier(); __builtin_amdgcn_fence(__ATOMIC_ACQUIRE, "workgroup"); } while (0)
#define SEAM(k) do { if (IN(k) && IN((k) + 1)) { if ((k) == 0) grid.sync(); else { OWN_BAR(); if ((PROBE_PH >> 20) & 1) OWN_BAR(); } } } while (0)
  float* MOD = (float*)(ws + WS_MOD); float* SSQ = (float*)(ws + WS_SSQ);
  const float* RT = (const float*)(ws + WS_ROPE); const float* CT = RT + 256 * 16 * 2;
  float* XC = (float*)(ws + WS_XC); float* PART = (float*)(ws + WS_PART);
  bf16_t* S1 = (bf16_t*)(ws + WS_S1); bf16_t* S2 = (bf16_t*)(ws + WS_S2);
  bf16_t* Qb = (bf16_t*)(ws + WS_Q); bf16_t* KVb = (bf16_t*)(ws + WS_KV); bf16_t* KRb = (bf16_t*)(ws + WS_KR); bf16_t* Gb = (bf16_t*)(ws + WS_G);
  const float* gn = a.in[6];
#define MODP(l, chunk) (MOD + (size_t)(l) * 3 * 12288 + (chunk) * 2048)
#define RUN_GEMM(MODE, Ap, lda_, Bp, N_, K_, skip, ...) do { pg8::Gemm g{Ap, Bp, NROW, N_, K_, lda_, K_}; pg8::RowSched S; S.init((skip) ? 128 : 130, (N_) / 256, G, c, (skip) ? 1 : 0); \
    pg8::Epi<MODE> E{__VA_ARGS__}; pg8::gemm_phase<pg8::Epi<MODE>, pg8::RowSched, true, true>(ldsL, g, S, E, wave); } while (0)
#define RUN_CTX_SPLIT(Ap, Bp, K_, NKC_) do { pg8::Gemm g{Ap, Bp, NROW, 2048, (K_) / (NKC_), K_, K_}; pg8::CtxSplitSched S; S.init(8, NKC_, G, c); \
    pg8::Epi<6> E{nullptr, 2048, nullptr, nullptr, nullptr, RT, CT, PART}; pg8::gemm_phase<pg8::Epi<6>, pg8::CtxSplitSched, true, true>(ldsL, g, S, E, wave); } while (0)

  if (IN(0)) { REP(0) p0_prologue(a, ldsL, gw, NGW, wave, lane_id_v(), rep_PROBE0); __syncthreads(); } SEAM(0);
  if (IN(1)) REP(1) norm_phase<false, true>(a.in[0], a.in[2], nullptr, nullptr, nullptr, nullptr, nullptr, nullptr, gn + 0 * 2048, MODP(0, 1), MODP(0, 0), S1, false, gw, NGW, lane_id_v());
  SEAM(1);
  if (IN(2)) REP(2) RUN_GEMM(1, S1, 2048, (const bf16_t*)(ws + WS_WIN), NP1, 2048, false, S2, NP1, SSQP(0), nullptr, KRb, RT, CT);
  SEAM(2);
  if (IN(3)) REP(3) {
    RUN_GEMM(2, S2, NP1, (const bf16_t*)(ws + WS_WQB), NQ, 512, false, Qb, NQ, nullptr, SSQ, nullptr, RT, CT);
    RUN_GEMM(3, S2 + 512, NP1, (const bf16_t*)(ws + WS_WKVB), NKV, 512, false, KVb, NKV, nullptr, SSQ + NROW, nullptr, RT, CT);
  }
  SEAM(3);
  if (IN(4)) REP(4) {
    const float SC = 0.07216878364870322f, Cc = SC * 1.4426950408889634f, THRS = 8.f / SC;
    for (int r = 0;; ++r) {
      const int u = c + r * G; if (u >= 2080) break;
      int b, h, rowq, NT;
      if (u < 2048) { int pair, qb; if (G == 256) { pair = (c & 7) * 4 + (r >> 1); qb = (c >> 3) + 32 * (r & 1); } else { pair = u >> 6; qb = u & 63; }
        b = pair >> 4; h = pair & 15; rowq = b * TB + CTXL + qb * 256; NT = TB / 64; }
      else { const int p = u - 2048; b = p >> 4; h = p & 15; rowq = b * TB; NT = CTXL / 64; }
      att::attn_unit<128, 128, false>(Qb + (size_t)rowq * NQ + h * 192, NQ, KVb + h * 256, NKV, KRb, 64, KVb + h * 256 + 128, NKV, S1 + (size_t)rowq * DM + h * 128, DM,
                                      NT, NT, b * TB, 0, 0, 0, Cc, THRS, -INFINITY, (char*)lds, ldsL, wave);
    }
  }
  SEAM(4);
  if (IN(5)) REP(5) { RUN_GEMM(0, S1, 2048, (const bf16_t*)(ws + WS_WOM), 2048, 2048, true, S2, 2048, SSQP(2), nullptr, nullptr, RT, CT);
    RUN_CTX_SPLIT(S1, (const bf16_t*)(ws + WS_WOM), 2048, 8); }
  SEAM(5);
  if (IN(6)) norm_phase<true, true, 8>(a.in[0], a.in[2], a.out, XC, S2, SSQ + 2 * NROW, gn + 1 * 2048, MODP(0, 2), gn + 2 * 2048, MODP(0, 4), MODP(0, 3), S1, false, gw, NGW, lane_id_v(), PART);
  SEAM(6);
  if (IN(7)) REP(7) RUN_GEMM(4, S1, 2048, (const bf16_t*)(ws + WS_WF1), DFF, 2048, false, Gb, DFF, nullptr, nullptr, nullptr, RT, CT);
  SEAM(7);
  if (IN(8)) REP(8) { RUN_GEMM(0, Gb, DFF, (const bf16_t*)(ws + WS_WF2), 2048, DFF, true, S2, 2048, SSQP(3), nullptr, nullptr, RT, CT);
    RUN_CTX_SPLIT(Gb, (const bf16_t*)(ws + WS_WF2), DFF, 16); }
  SEAM(8);
  if (IN(9)) norm_phase<true, true, 16>(a.out, XC, a.out, XC, S2, SSQ + 3 * NROW, gn + 3 * 2048, MODP(0, 5), gn + 4 * 2048, MODP(1, 1), MODP(1, 0), S1, false, gw, NGW, lane_id_v(), PART);
  SEAM(9);
  if (IN(10)) REP(10) RUN_GEMM(5, S1, 2048, (const bf16_t*)(ws + WS_WQKV), NQKV, 2048, false, Gb, NQKV, nullptr, nullptr, nullptr, RT, CT);
  SEAM(10);
  if (IN(11)) REP(11) {
    const float SC = 0.125f, Cc = SC * 1.4426950408889634f, THRS = 8.f / SC;
    for (int u = c; u < 4096; u += G) {
      const int pairkv = u >> 9, qb32 = u & 511, b = pairkv >> 2, kvh = pairkv & 3, t0 = qb32 * 32;
      int f = (t0 - 128) < 0 ? 0 : (t0 - 128) >> 6, l = (t0 + 159) >> 6; if (l > SEQ / 64 - 1) l = SEQ / 64 - 1;
      if ((l - f + 1) & 1) { if (l < SEQ / 64 - 1) ++l; else --f; }
      const int nwin = l - f + 1, tstart = 64 * f;
      const int rowq = b * TB + CTXL + t0;
      att::attn_unit<0, 64, true>(Gb + (size_t)rowq * NQKV + kvh * 512, NQKV, nullptr, 0, Gb + 2048 + kvh * 64, NQKV, Gb + 2304 + kvh * 64, NQKV, S1 + (size_t)rowq * DM + kvh * 512, DM,
                                  4 + nwin, 4, b * TB, b * TB + CTXL + tstart, t0, tstart, Cc, THRS, a.in[16][kvh * 8 + wave] * 1.4426950408889634f, (char*)lds, ldsL, wave);
    }
  }
  SEAM(11);
  if (IN(12)) REP(12) RUN_GEMM(0, S1, 2048, (const bf16_t*)(ws + WS_WOS), 2048, 2048, true, S2, 2048, SSQP(4), nullptr, nullptr, RT, CT);
  SEAM(12);
  if (IN(13)) norm_phase<true, true>(a.out, XC, a.out, XC, S2, SSQ + 4 * NROW, gn + 5 * 2048, MODP(1, 2), gn + 6 * 2048, MODP(1, 4), MODP(1, 3), S1, true, gw, NGW, lane_id_v());
  SEAM(13);
  if (IN(14)) REP(14) RUN_GEMM(4, S1, 2048, (const bf16_t*)(ws + WS_WF1) + (size_t)2048 * 8192, DFF, 2048, true, Gb, DFF, nullptr, nullptr, nullptr, RT, CT);
  SEAM(14);
  if (IN(15)) REP(15) RUN_GEMM(0, Gb, DFF, (const bf16_t*)(ws + WS_WF2) + (size_t)2048 * 8192, 2048, DFF, true, S2, 2048, SSQP(5), nullptr, nullptr, RT, CT);
  SEAM(15);
  if (IN(16)) norm_phase<true, false>(a.out, XC, a.out, XC, S2, SSQ + 5 * NROW, gn + 7 * 2048, MODP(1, 5), nullptr, nullptr, nullptr, nullptr, true, gw, NGW, lane_id_v());
#undef IN
#undef SEAM
}

extern "C" void kernel_launch(void* const* d_in, const int* in_sizes, int n_in, void* d_out, int out_size, void* d_ws, size_t ws_size, hipStream_t stream) {
  static int grid = 0;
  if (grid == 0) {
    if (n_in != 18 || out_size != 2 * SEQ * DM || ws_size < WS_END) { fprintf(stderr, "kernel_launch: unexpected shapes: n_in %d out %d ws %zu (need %zu)\n", n_in, out_size, ws_size, (size_t)WS_END); grid = -1; return; }
    int dev = 0, cus = 0, per_cu = 0;
    hipGetDevice(&dev); hipDeviceGetAttribute(&cus, hipDeviceAttributeMultiprocessorCount, dev);
    if (hipFuncSetAttribute((const void*)mk_fwd, hipFuncAttributeMaxDynamicSharedMemorySize, LDS_BYTES) != hipSuccess) { fprintf(stderr, "kernel_launch: hipFuncSetAttribute failed\n"); grid = -1; return; }
    if (hipOccupancyMaxActiveBlocksPerMultiprocessor(&per_cu, (const void*)mk_fwd, 512, LDS_BYTES) != hipSuccess || per_cu < 1) { fprintf(stderr, "kernel_launch: occupancy query gave %d\n", per_cu); per_cu = 1; }
    (void)hipGetLastError();
    grid = cus * per_cu;
    fprintf(stderr, "kernel_launch: grid %d (cus %d x %d)\n", grid, cus, per_cu);
  }
  if (grid < 0) return;
  hipMemsetAsync((char*)d_ws, 0, CTL_ZERO_BYTES, stream);
  Args a{};
  for (int i = 0; i < 18; ++i) a.in[i] = (const float*)d_in[i];
  a.out = (float*)d_out; a.ws = (unsigned char*)d_ws; a.ph_lo = 0; a.ph_hi = N_PHASES;
  void* args[] = {&a};
  hipError_t e = hipLaunchCooperativeKernel((const void*)mk_fwd, dim3(grid), dim3(512), args, LDS_BYTES, stream);
  if (e != hipSuccess) fprintf(stderr, "kernel_launch: cooperative launch failed: %s (grid %d)\n", hipGetErrorString(e), grid);
}
```

```cpp
#include <hip/hip_runtime.h>
#include <hip/hip_cooperative_groups.h>
#include <cstdio>
#include <cstdint>
namespace cg = cooperative_groups;

constexpr int DM = 2048, SEQ = 16384, CTXL = 256, TB = SEQ + CTXL  , NROW = 2 * TB  , DFF = 8192;
constexpr int NP1 = 1280  , NQ = 3072, NKV = 4096, NQKV = 2560;
constexpr float NORM_EPS = 1e-6f;
__device__ __forceinline__ int lane_id_v() { int l; asm volatile("v_mbcnt_lo_u32_b32 %0, -1, 0\n\tv_mbcnt_hi_u32_b32 %0, -1, %0" : "=v"(l)); return l; }
namespace pg8 {
#define PG8_LAS __attribute__((address_space(3)))
typedef unsigned short bf16_t;
typedef short bf16x8 __attribute__((ext_vector_type(8)));
typedef float f32x4 __attribute__((ext_vector_type(4)));
typedef unsigned u32x4 __attribute__((ext_vector_type(4)));
constexpr int BM = 256, BK = 64, HALF = 128, HTB = HALF * BK * 2  , STAGE_BYTES = 8 * HTB, NXCD = 8, WGM = 4;

__host__ __device__ __forceinline__ int lds_byte(int r, int c) { const int st = (r >> 4) * 2 + (c >> 5), rr = r & 15, cc = c & 31, ob = rr * 64 + cc * 2; return st * 1024 + (ob ^ (((ob >> 9) & 1) << 5)); }
__host__ __device__ __forceinline__ void stage_rc(int b, int& R, int& C) { const int st = b / 1024, sb = b % 1024, swz = sb ^ (((sb >> 9) & 1) << 5); R = (st >> 1) * 16 + swz / 64; C = (st & 1) * 32 + (swz % 64) / 2; }
__host__ __device__ __forceinline__ int perm32(int rho) { const int n = rho >> 4, i = rho & 15; return 8 * (i >> 2) + 4 * n + (i & 3); }

struct Unit { int pm, pn, kc; };
struct Gemm { const bf16_t* A; const bf16_t* Bt; int M, N, K, lda, ldb; };

struct StaticOrder {
    int nM, nN, nwg, G, c;
    __host__ __device__ void init(int M, int N, int G_, int c_) { nM = M / BM; nN = N / BM; nwg = nM * nN; G = G_; c = c_; }
    __host__ __device__ bool next(int i, Unit& u) const {
        const long L = (long)i * G + c; if (L >= nwg) return false;
        int wgid = (int)L; { const int q = nwg / NXCD, r = nwg % NXCD, xcd = wgid % NXCD, off = wgid / NXCD; wgid = (xcd < r ? xcd * (q + 1) : r * (q + 1) + (xcd - r) * q) + off; }
        const int nig = WGM * nN, gid = wgid / nig, fm = gid * WGM, gsz = (nM - fm) < WGM ? (nM - fm) : WGM;
        u.pm = fm + ((wgid % nig) % gsz); u.pn = (wgid % nig) / gsz; return true;
    }
    __device__ __forceinline__ void a_ready(const Unit&) const {}
    __device__ __forceinline__ void done(const Unit&) const {}
};


__device__ __forceinline__ unsigned cvt_pk_bf16(float lo, float hi) { unsigned r; asm volatile("v_cvt_pk_bf16_f32 %0, %1, %2" : "=v"(r) : "v"(lo), "v"(hi)); return r; }

struct RowSched {
    int nM, nN, nwg, G, c, skipctx;
    __device__ void init(int nM_, int nN_, int G_, int c_, int skipctx_) { nM = nM_; nN = nN_; nwg = nM * nN; G = G_; c = c_; skipctx = skipctx_; }
    __device__ bool next(int i, Unit& u) const {
        const long L = (long)i * G + c; if (L >= nwg) return false;
        int wgid = (int)L; { const int q = nwg / NXCD, r = nwg % NXCD, xcd = wgid % NXCD, off = wgid / NXCD; wgid = (xcd < r ? xcd * (q + 1) : r * (q + 1) + (xcd - r) * q) + off; }
        const int nig = WGM * nN, gid = wgid / nig, fm = gid * WGM, gsz = (nM - fm) < WGM ? (nM - fm) : WGM;
        int pm = fm + ((wgid % nig) % gsz); u.pn = (wgid % nig) / gsz;
        if (skipctx) pm += 1 + (pm >= 64 ? 1 : 0);
        u.pm = pm; u.kc = 0; return true;
    }
    __device__ __forceinline__ void a_ready(const Unit&) const {}
    __device__ __forceinline__ void done(const Unit&) const {}
};

struct CtxSplitSched {
    int nN, NKC, nwg, G, c;
    __device__ void init(int nN_, int NKC_, int G_, int c_) { nN = nN_; NKC = NKC_; nwg = 2 * nN * NKC; G = G_; c = c_; }
    __device__ bool next(int i, Unit& u) const {
        const long L = (long)i * G + c; if (L >= nwg) return false;
        const int l = (int)L, t = l / NKC; u.kc = l - t * NKC; u.pn = t % nN; u.pm = (t / nN) ? 65 : 0; return true;
    }
    __device__ __forceinline__ void a_ready(const Unit&) const {}
    __device__ __forceinline__ void done(const Unit&) const {}
};

template <int MODE> struct Epi {
    static constexpr bool PERM = true, AFTER_DRAIN = false;
    bf16_t* O; int ldc;
    float* ssq;
    const float* rssq;
    bf16_t* KR;
    const float* rtab; const float* ctab;
    float* part;
    __device__ __forceinline__ void operator()(const f32x4 (&acc)[2][2][4][2], const Unit& u, int wr, int wc, int fr, int fq) const {
        const int pm = u.pm, pn = u.pn;
        const bool isctx = (pm == 0) || (pm == 65);
        const int tbase = (pm > 65 ? pm - 66 : pm - 1) * 256;
#pragma unroll
        for (int ai = 0; ai < 2; ++ai)
#pragma unroll
            for (int m = 0; m < 4; ++m) {
                const int rt = ai * HALF + wr * 64 + m * 16 + fr;
                const int row = pm * BM + rt;
                const int t = tbase + rt;
                float rs = 1.f;
                if (MODE == 2 || MODE == 3) rs = __builtin_amdgcn_rsqf(rssq[row] * (1.0f / 512.0f) + 1e-6f);
                float sq = 0.f;
#pragma unroll
                for (int bj = 0; bj < 2; ++bj) {
                    const int col = pn * BM + bj * HALF + wc * 32 + 8 * fq;
                    f32x4 v0 = acc[ai][bj][m][0], v1 = acc[ai][bj][m][1];
                    if (MODE == 6) { float* pp = part + ((size_t)u.kc * 512 + (pm == 65 ? 256 : 0) + rt) * ldc + col; *(f32x4*)pp = v0; *(f32x4*)(pp + 4) = v1; continue; }
                    if (MODE == 2 || MODE == 3) { v0 = v0 * rs; v1 = v1 * rs; }
                    if (MODE == 0 || MODE == 1) sq += (v0[0] * v0[0] + v0[1] * v0[1]) + (v0[2] * v0[2] + v0[3] * v0[3]) + (v1[0] * v1[0] + v1[1] * v1[1]) + (v1[2] * v1[2] + v1[3] * v1[3]);
                    bool dorope = false; int i0 = 0;
                    if (MODE == 2) { const int hc = col % 192; dorope = (!isctx) && (hc >= 128); i0 = (hc - 128) >> 1; }
                    if (MODE == 5) { dorope = (!isctx) && (col < 2304); i0 = (col & 63) >> 1; }
                    if (MODE == 1) { dorope = (!isctx) && (pn == 4) && (col < 1088); i0 = (col - 1024) >> 1; }
                    if (MODE == 1 || MODE == 2 || MODE == 5) {
                        if (dorope) {
                            const float* tb = (i0 < 16) ? (rtab + ((t >> 6) * 16 + i0) * 2) : (ctab + ((t & 63) * 16 + (i0 - 16)) * 2);
                            const f32x4 c0 = *(const f32x4*)tb, c1 = *(const f32x4*)(tb + 4);
                            f32x4 w0, w1;
                            w0[0] = v0[0] * c0[0] - v0[1] * c0[1]; w0[1] = v0[0] * c0[1] + v0[1] * c0[0];
                            w0[2] = v0[2] * c0[2] - v0[3] * c0[3]; w0[3] = v0[2] * c0[3] + v0[3] * c0[2];
                            w1[0] = v1[0] * c1[0] - v1[1] * c1[1]; w1[1] = v1[0] * c1[1] + v1[1] * c1[0];
                            w1[2] = v1[2] * c1[2] - v1[3] * c1[3]; w1[3] = v1[2] * c1[3] + v1[3] * c1[2];
                            v0 = w0; v1 = w1;
                        }
                    }
                    if (MODE == 4) {
#pragma unroll
                        for (int e = 0; e < 4; ++e) { const float a = fmaxf(v0[e], 0.f), b = fmaxf(v1[e], 0.f); v0[e] = a * a; v1[e] = b * b; }
                    }
                    u32x4 w; w.x = cvt_pk_bf16(v0[0], v0[1]); w.y = cvt_pk_bf16(v0[2], v0[3]); w.z = cvt_pk_bf16(v1[0], v1[1]); w.w = cvt_pk_bf16(v1[2], v1[3]);
                    if (MODE == 1 && pn == 4) { if (col < 1088) *(u32x4*)(KR + (size_t)row * 64 + (col - 1024)) = w; }
                    else *(u32x4*)(O + (size_t)row * ldc + col) = w;
                }
                if (MODE == 0 || MODE == 1) {
                    if (MODE == 0 || pn < 4) {
                        sq += __shfl_xor(sq, 16); sq += __shfl_xor(sq, 32);
                        if (fq == 0) atomicAdd(ssq + (MODE == 1 ? (size_t)(pn >> 1) * NROW : (size_t)0) + row, sq);
                    }
                }
            }
    }
};

template <class Epi, class Sched, bool ALIGN_EPI = false, bool SP2 = false>
__device__ __forceinline__ void gemm_phase(PG8_LAS unsigned char* lds, const Gemm g, const Sched& S, const Epi& E, const int wave_) {
    const int wid = wave_, lane = lane_id_v(), tid = wid * 64 + lane, wr = wid >> 2, wc = wid & 3, fr = lane & 15, fq = lane >> 4;
    const int K = g.K, nt = K / BK, lda = g.lda, ldb = g.ldb;
    unsigned voffA[2], voffB[2];
#pragma unroll
    for (int i = 0; i < 2; ++i) { int R, C; stage_rc(tid * 16 + i * 8192, R, C); const int Rb = Epi::PERM ? ((R & ~31) + perm32(R & 31)) : R;
        voffA[i] = (unsigned)(R * lda + C) * 2u; voffB[i] = (unsigned)(Rb * ldb + C) * 2u; }
    const size_t kstep = (size_t)(BK * 2);
    const size_t hstepA = (size_t)HALF * lda * 2, hstepB = (size_t)HALF * ldb * 2;
    const size_t tstepA = 2 * hstepA, tstepB = 2 * hstepB;
    const unsigned ldsw = (unsigned)wid * 1024u;
    const int aoff = lds_byte(wr * 64 + fr, fq * 8), boff = lds_byte(wc * 32 + fr, fq * 8);
#define PG8_SA(b, h) (((b) * 2 + (h)) * HTB)
#define PG8_SB(b, h) ((4 + (b) * 2 + (h)) * HTB)
#define PG8_STAGE(bufoff, gbase, voff) do { _Pragma("unroll") for (int _i = 0; _i < 2; ++_i) \
        __builtin_amdgcn_global_load_lds((const unsigned*)((const char*)(gbase) + (voff)[_i]), (PG8_LAS unsigned*)(lds + (bufoff) + ldsw + _i * 8192), 16, 0, 0); } while (0)
#define PG8_LDA(dst, b, h) do { _Pragma("unroll") for (int m = 0; m < 4; ++m) _Pragma("unroll") for (int k = 0; k < 2; ++k) dst[m][k] = *(const PG8_LAS bf16x8*)(lds + PG8_SA(b, h) + aoff + m * 2048 + k * 1024); } while (0)
#define PG8_LDB(dst, b, h) do { _Pragma("unroll") for (int n = 0; n < 2; ++n) _Pragma("unroll") for (int k = 0; k < 2; ++k) dst[n][k] = *(const PG8_LAS bf16x8*)(lds + PG8_SB(b, h) + boff + n * 2048 + k * 1024); } while (0)
#define PG8_MMA(ai, bj, At, Bt) do { __builtin_amdgcn_s_setprio(1); _Pragma("unroll") for (int m = 0; m < 4; ++m) _Pragma("unroll") for (int n = 0; n < 2; ++n) _Pragma("unroll") for (int k = 0; k < 2; ++k) \
        acc[ai][bj][m][n] = __builtin_amdgcn_mfma_f32_16x16x32_bf16(Bt[n][k], At[m][k], acc[ai][bj][m][n], 0, 0, 0); __builtin_amdgcn_s_setprio(0); } while (0)
#define PG8_WAIT_V(n) asm volatile("s_waitcnt vmcnt(" #n ")" ::: "memory")
#define PG8_WAIT_L(n) asm volatile("s_waitcnt lgkmcnt(" #n ")" ::: "memory")
#define PG8_BAR __builtin_amdgcn_s_barrier()
#define PG8_SCHED __builtin_amdgcn_sched_barrier(0)
    Unit cur, nxt; int ui = 0;
    if (!S.next(0, cur)) return;
    f32x4 acc[2][2][4][2];
#pragma unroll
    for (int a = 0; a < 2; ++a)
#pragma unroll
        for (int b = 0; b < 2; ++b)
#pragma unroll
            for (int m = 0; m < 4; ++m)
#pragma unroll
                for (int n = 0; n < 2; ++n) acc[a][b][m][n] = (f32x4){0.f, 0.f, 0.f, 0.f};
    bf16x8 At[4][2], B0[2][2], B1[2][2];
    const char* cA = (const char*)g.A + (size_t)cur.pm * tstepA + (size_t)cur.kc * K * 2; const char* cB = (const char*)g.Bt + (size_t)cur.pn * tstepB + (size_t)cur.kc * K * 2;
    S.a_ready(cur);
    if constexpr (SP2) {
        PG8_STAGE(PG8_SB(0, 0), cB, voffB); PG8_STAGE(PG8_SB(0, 1), cB + hstepB, voffB); PG8_STAGE(PG8_SA(0, 0), cA, voffA); PG8_STAGE(PG8_SA(0, 1), cA + hstepA, voffA);
        if (wr == 1) PG8_BAR;
        PG8_WAIT_V(2); PG8_BAR;
        PG8_STAGE(PG8_SB(1, 0), cB + kstep, voffB); PG8_STAGE(PG8_SA(1, 0), cA + kstep, voffA); PG8_STAGE(PG8_SB(1, 1), cB + hstepB + kstep, voffB);
        PG8_WAIT_V(6); PG8_BAR;
    } else {
        PG8_STAGE(PG8_SB(0, 0), cB, voffB); PG8_STAGE(PG8_SA(0, 0), cA, voffA); PG8_STAGE(PG8_SB(0, 1), cB + hstepB, voffB); PG8_STAGE(PG8_SA(0, 1), cA + hstepA, voffA);
        if (wr == 1) PG8_BAR;
        PG8_WAIT_V(4); PG8_BAR;
        PG8_STAGE(PG8_SB(1, 0), cB + kstep, voffB); PG8_STAGE(PG8_SA(1, 0), cA + kstep, voffA); PG8_STAGE(PG8_SB(1, 1), cB + hstepB + kstep, voffB);
        PG8_WAIT_V(6); PG8_BAR;
    }
    for (;;) {
        const bool has_next = S.next(ui + 1, nxt);
        const char* nA = has_next ? (const char*)g.A + (size_t)nxt.pm * tstepA + (size_t)nxt.kc * K * 2 : cA; const char* nB = has_next ? (const char*)g.Bt + (size_t)nxt.pn * tstepB + (size_t)nxt.kc * K * 2 : cB;
        for (int t = 0; t < nt; t += 2) {
            const bool last = (t == nt - 2);
            const char* a1 = cA + (size_t)(t + 1) * kstep;
            const char* a2 = last ? nA : cA + (size_t)(t + 2) * kstep; const char* b2 = last ? nB : cB + (size_t)(t + 2) * kstep;
            const char* a3 = a2 + kstep; const char* b3 = b2 + kstep;
            if (last && has_next) S.a_ready(nxt);
            if constexpr (SP2) {
            PG8_LDB(B0, 0, 0); PG8_LDB(B1, 0, 1); PG8_SCHED; PG8_LDA(At, 0, 0); PG8_STAGE(PG8_SA(1, 1), a1 + hstepA, voffA);
            PG8_WAIT_V(8); PG8_WAIT_L(0); PG8_BAR; PG8_MMA(0, 0, At, B0); PG8_MMA(0, 1, At, B1); PG8_BAR; PG8_SCHED;
            PG8_LDA(At, 0, 1); PG8_STAGE(PG8_SB(0, 0), b2, voffB); PG8_STAGE(PG8_SB(0, 1), b2 + hstepB, voffB); PG8_STAGE(PG8_SA(0, 0), a2, voffA);
            PG8_WAIT_V(8); PG8_WAIT_L(0); PG8_BAR; PG8_MMA(1, 0, At, B0); PG8_MMA(1, 1, At, B1); PG8_BAR; PG8_SCHED;
            PG8_LDB(B0, 1, 0); PG8_LDB(B1, 1, 1); PG8_SCHED; PG8_LDA(At, 1, 0); PG8_STAGE(PG8_SA(0, 1), a2 + hstepA, voffA);
            PG8_WAIT_V(8); PG8_WAIT_L(0); PG8_BAR; PG8_MMA(0, 0, At, B0); PG8_MMA(0, 1, At, B1); PG8_BAR; PG8_SCHED;
            PG8_LDA(At, 1, 1); PG8_STAGE(PG8_SB(1, 0), b3, voffB); PG8_STAGE(PG8_SB(1, 1), b3 + hstepB, voffB); PG8_STAGE(PG8_SA(1, 0), a3, voffA);
            PG8_WAIT_V(8); PG8_WAIT_L(0); PG8_BAR; PG8_MMA(1, 0, At, B0); PG8_MMA(1, 1, At, B1); PG8_BAR; PG8_SCHED;
            } else {
            PG8_LDB(B0, 0, 0); PG8_SCHED; PG8_LDA(At, 0, 0); PG8_STAGE(PG8_SA(1, 1), a1 + hstepA, voffA);
            PG8_WAIT_L(8); PG8_BAR; PG8_WAIT_L(0); PG8_MMA(0, 0, At, B0); PG8_BAR; PG8_SCHED;
            PG8_LDB(B1, 0, 1); PG8_STAGE(PG8_SB(0, 0), b2, voffB);
            PG8_BAR; PG8_WAIT_L(0); PG8_MMA(0, 1, At, B1); PG8_BAR;
            PG8_LDA(At, 0, 1); PG8_STAGE(PG8_SA(0, 0), a2, voffA);
            PG8_BAR; PG8_WAIT_L(0); PG8_MMA(1, 0, At, B0); PG8_BAR; PG8_SCHED;
            PG8_STAGE(PG8_SB(0, 1), b2 + hstepB, voffB);
            PG8_WAIT_V(6); PG8_BAR; PG8_MMA(1, 1, At, B1); PG8_BAR;
            PG8_LDB(B0, 1, 0); PG8_SCHED; PG8_LDA(At, 1, 0); PG8_STAGE(PG8_SA(0, 1), a2 + hstepA, voffA);
            PG8_WAIT_L(8); PG8_BAR; PG8_WAIT_L(0); PG8_MMA(0, 0, At, B0); PG8_BAR; PG8_SCHED;
            PG8_LDB(B1, 1, 1); PG8_STAGE(PG8_SB(1, 0), b3, voffB);
            PG8_BAR; PG8_WAIT_L(0); PG8_MMA(0, 1, At, B1); PG8_BAR;
            PG8_LDA(At, 1, 1); PG8_STAGE(PG8_SA(1, 0), a3, voffA);
            PG8_BAR; PG8_WAIT_L(0); PG8_MMA(1, 0, At, B0); PG8_BAR; PG8_SCHED;
            PG8_STAGE(PG8_SB(1, 1), b3 + hstepB, voffB);
            PG8_WAIT_V(6); PG8_BAR; PG8_MMA(1, 1, At, B1); PG8_BAR;
            }
        }
        if constexpr (ALIGN_EPI) { if (wr == 0) PG8_BAR; }
        if constexpr (!Epi::AFTER_DRAIN) { E(acc, cur, wr, wc, fr, fq); S.done(cur); }
        if (!has_next) break;
#pragma unroll
        for (int a = 0; a < 2; ++a)
#pragma unroll
            for (int b = 0; b < 2; ++b)
#pragma unroll
                for (int m = 0; m < 4; ++m)
#pragma unroll
                    for (int n = 0; n < 2; ++n) acc[a][b][m][n] = (f32x4){0.f, 0.f, 0.f, 0.f};
        cur = nxt; cA = nA; cB = nB; ++ui;
        if constexpr (ALIGN_EPI) { if (wr == 1) PG8_BAR; }
    }
    PG8_WAIT_V(0);
    if constexpr (!ALIGN_EPI) { if (wr == 0) PG8_BAR; }
    PG8_BAR;
    if constexpr (Epi::AFTER_DRAIN) { E.fused(acc, cur, wr, wc, fr, fq, lds, wid, lane); S.done(cur); }
#undef PG8_SA
#undef PG8_SB
#undef PG8_STAGE
#undef PG8_LDA
#undef PG8_LDB
#undef PG8_MMA
#undef PG8_WAIT_V
#undef PG8_WAIT_L
#undef PG8_BAR
#undef PG8_SCHED
}
}

namespace att {
typedef unsigned short bf16_t;
using bf16x8 = __attribute__((ext_vector_type(8))) short;
using s16x4  = __attribute__((ext_vector_type(4))) short;
using f32x16 = __attribute__((ext_vector_type(16))) float;
using u32x4  = __attribute__((ext_vector_type(4))) unsigned;
#define KSWZ(row, colB) ((row) * 256 + ((colB) ^ (((row) & 15) << 4)))
#define KSWZ64(row, colB) ((row) * 128 + ((colB) ^ ((((row) >> 1) & 7) << 4)))
#define SBAR() __builtin_amdgcn_sched_barrier(0)
__device__ __forceinline__ int crow(int r, int hi) { return (r & 3) + 8 * (r >> 2) + 4 * hi; }
__device__ __forceinline__ unsigned cvtpk(float lo, float hi) { unsigned r; asm volatile("v_cvt_pk_bf16_f32 %0, %1, %2" : "=v"(r) : "v"(lo), "v"(hi)); return r; }

__device__ __forceinline__ void partialSM(f32x16& p0, f32x16& p1, float& m_reg, float& alpha, const float C, const float THRS) {
  float pmax = p0[0];
#pragma unroll
  for (int r = 1; r < 16; ++r) pmax = fmaxf(pmax, p0[r]);
#pragma unroll
  for (int r = 0; r < 16; ++r) pmax = fmaxf(pmax, p1[r]);
  { auto rr = __builtin_amdgcn_permlane32_swap(__float_as_uint(pmax), __float_as_uint(pmax), false, false);
    pmax = fmaxf(__uint_as_float(rr[0]), __uint_as_float(rr[1])); }
  float mn;
  if (__builtin_expect(__all(pmax - m_reg <= THRS), 1)) { mn = m_reg; alpha = 1.f; }
  else { mn = fmaxf(m_reg, pmax); alpha = __builtin_amdgcn_exp2f((m_reg - mn) * C); m_reg = mn; }
  const float mnC = -mn * C;
#pragma unroll
  for (int r = 0; r < 16; ++r) p0[r] = fmaf(p0[r], C, mnC);
#pragma unroll
  for (int r = 0; r < 16; ++r) p1[r] = fmaf(p1[r], C, mnC);
#pragma unroll
  for (int r = 0; r < 16; ++r) p0[r] = __builtin_amdgcn_exp2f(p0[r]);
}
__device__ __forceinline__ void finishSM(f32x16& p0, f32x16& p1, float alpha, float& l_reg, bf16x8& pa0, bf16x8& pa1, bf16x8& pa2, bf16x8& pa3) {
#pragma unroll
  for (int r = 0; r < 16; ++r) p1[r] = __builtin_amdgcn_exp2f(p1[r]);
  float ps = 0;
#pragma unroll
  for (int r = 0; r < 16; ++r) ps += p0[r];
#pragma unroll
  for (int r = 0; r < 16; ++r) ps += p1[r];
  { auto rr = __builtin_amdgcn_permlane32_swap(__float_as_uint(ps), __float_as_uint(ps), false, false);
    ps = __uint_as_float(rr[0]) + __uint_as_float(rr[1]); }
  l_reg = l_reg * alpha + ps;
#define PK4(P, BASE, OUT) do { unsigned a0 = cvtpk(P[BASE + 0], P[BASE + 1]), a1 = cvtpk(P[BASE + 2], P[BASE + 3]);   \
    unsigned b0 = cvtpk(P[BASE + 4], P[BASE + 5]), b1 = cvtpk(P[BASE + 6], P[BASE + 7]);                              \
    auto r0 = __builtin_amdgcn_permlane32_swap(a0, b0, false, false); auto r1 = __builtin_amdgcn_permlane32_swap(a1, b1, false, false); \
    u32x4 w = {r0[0], r1[0], r0[1], r1[1]}; OUT = *reinterpret_cast<bf16x8*>(&w); } while (0)
  PK4(p0, 0, pa0); PK4(p0, 8, pa1); PK4(p1, 0, pa2); PK4(p1, 8, pa3);
#undef PK4
}
template <int DN>
__device__ __forceinline__ void qkt(f32x16& p0, f32x16& p1, const char* Kn, const char* Kr, const bf16x8* qr, const char* qrl, int r32, int hi) {
  p0 = f32x16{}; p1 = f32x16{};
  if constexpr (DN > 0) {
#pragma unroll
    for (int d0 = 0; d0 < DN / 16; ++d0) { const int cb = (d0 * 16 + hi * 8) * 2;
      bf16x8 b0 = *reinterpret_cast<const bf16x8*>(Kn + KSWZ(r32, cb));
      bf16x8 b1 = *reinterpret_cast<const bf16x8*>(Kn + KSWZ(32 + r32, cb));
      p0 = __builtin_amdgcn_mfma_f32_32x32x16_bf16(b0, qr[d0], p0, 0, 0, 0);
      p1 = __builtin_amdgcn_mfma_f32_32x32x16_bf16(b1, qr[d0], p1, 0, 0, 0); }
  }
#pragma unroll
  for (int d0 = 0; d0 < 4; ++d0) { const int cb = (d0 * 16 + hi * 8) * 2;
    bf16x8 b0 = *reinterpret_cast<const bf16x8*>(Kr + KSWZ64(r32, cb));
    bf16x8 b1 = *reinterpret_cast<const bf16x8*>(Kr + KSWZ64(32 + r32, cb));
    bf16x8 q; if constexpr (DN > 0) q = *reinterpret_cast<const bf16x8*>(qrl + d0 * 1024); else q = qr[d0];
    p0 = __builtin_amdgcn_mfma_f32_32x32x16_bf16(b0, q, p0, 0, 0, 0);
    p1 = __builtin_amdgcn_mfma_f32_32x32x16_bf16(b1, q, p1, 0, 0, 0); }
}
__device__ __forceinline__ void band_mask(f32x16& p0, f32x16& p1, int d) {
#pragma unroll
  for (int r = 0; r < 16; ++r) { const int v = d - ((r & 3) + 8 * (r >> 2));
    if (v > 128 || v < -128) p0[r] = -1e30f;
    if (v - 32 > 128 || v - 32 < -128) p1[r] = -1e30f; }
}
__device__ __forceinline__ int v_rd_base(int lane) { return ((lane & 3) << 3) | (((lane >> 2) & 3) << 6) | (((lane >> 4) & 1) << 5) | (((lane >> 5) & 1) << 8); }
template <int NCB> constexpr int v_rd_off(int d0, int ks, int half) { return d0 * 512 + ks * (2 * NCB * 512) + half * (NCB * 512); }
template <int OFF> __device__ __forceinline__ s16x4 tr_read(int vb) {
  s16x4 r; asm volatile("ds_read_b64_tr_b16 %0, %1 offset:%2" : "=&v"(r) : "v"(vb), "i"(OFF) : "memory"); return r;
}
template <int D0, int NCB> __device__ __forceinline__ void pv_one(f32x16& od, int vb, bf16x8 pa0, bf16x8 pa1, bf16x8 pa2, bf16x8 pa3) {
  const s16x4 l0 = tr_read<v_rd_off<NCB>(D0, 0, 0)>(vb), h0 = tr_read<v_rd_off<NCB>(D0, 0, 1)>(vb), l1 = tr_read<v_rd_off<NCB>(D0, 1, 0)>(vb), h1 = tr_read<v_rd_off<NCB>(D0, 1, 1)>(vb);
  const s16x4 l2 = tr_read<v_rd_off<NCB>(D0, 2, 0)>(vb), h2 = tr_read<v_rd_off<NCB>(D0, 2, 1)>(vb), l3 = tr_read<v_rd_off<NCB>(D0, 3, 0)>(vb), h3 = tr_read<v_rd_off<NCB>(D0, 3, 1)>(vb);
  asm volatile("s_waitcnt lgkmcnt(0)" ::: "memory"); SBAR();
#define PK(L, H) (bf16x8){L[0], L[1], L[2], L[3], H[0], H[1], H[2], H[3]}
  od = __builtin_amdgcn_mfma_f32_32x32x16_bf16(pa0, PK(l0, h0), od, 0, 0, 0);
  od = __builtin_amdgcn_mfma_f32_32x32x16_bf16(pa1, PK(l1, h1), od, 0, 0, 0);
  od = __builtin_amdgcn_mfma_f32_32x32x16_bf16(pa2, PK(l2, h2), od, 0, 0, 0);
  od = __builtin_amdgcn_mfma_f32_32x32x16_bf16(pa3, PK(l3, h3), od, 0, 0, 0);
#undef PK
}
template <int NCB> __device__ __forceinline__ void pv_all(f32x16* o, int vb, bf16x8 pa0, bf16x8 pa1, bf16x8 pa2, bf16x8 pa3) {
  pv_one<0, NCB>(o[0], vb, pa0, pa1, pa2, pa3); pv_one<1, NCB>(o[1], vb, pa0, pa1, pa2, pa3);
  if constexpr (NCB == 4) { pv_one<2, NCB>(o[2], vb, pa0, pa1, pa2, pa3); pv_one<3, NCB>(o[3], vb, pa0, pa1, pa2, pa3); }
}

#define ATT_LAS __attribute__((address_space(3)))
template <int DN, int DV, bool MASK>
__device__ __forceinline__ void attn_unit(const bf16_t* __restrict__ Qb, const int ldq, const bf16_t* __restrict__ Kn, const int ldkn,
    const bf16_t* __restrict__ Kr, const int ldkr, const bf16_t* __restrict__ Vp, const int ldv, bf16_t* __restrict__ Ob, const int ldo,
    const int NT, const int n1, const int r1, const int r2, const int qpos0, const int kt2,
    const float C, const float THRS, const float sinkl2, char* lds, ATT_LAS unsigned char* ldsL, const int wave_) {
  constexpr int NQR = DN > 0 ? DN / 16 : 4, NCB = DV / 32, VB = 64 * DV * 2, KNB = 64 * DN * 2, KRB = 64 * 64 * 2, BUF = VB + KNB + KRB;
  constexpr int NVC = VB / 8192, NKC = KNB / 8192;
  const int wid = wave_, lane = lane_id_v(), r32 = lane & 31, hi = lane >> 5;
  char* Vl = lds; char* Knl = lds + VB; char* Krl = lds + VB + KNB;
  float* wsf = (float*)(lds + 3 * BUF) + wid * 64; float* li_l = wsf; float* al_l = wsf + 32;
  float m_reg = -1e30f, l_reg = 0; f32x16 o[NCB] = {}; bf16x8 qr[NQR];
  const bf16_t* Qw = Qb + (MASK ? (long)r32 * ldq + wid * 64 : (long)(wid * 32 + r32) * ldq) + hi * 8;
#pragma unroll
  for (int d0 = 0; d0 < NQR; ++d0) qr[d0] = *reinterpret_cast<const bf16x8*>(Qw + d0 * 16);
  char* qrl = lds + 3 * BUF + 2048 + wid * 4096 + lane * 16;
  if constexpr (DN > 0) {
#pragma unroll
    for (int d0 = 0; d0 < 4; ++d0) *reinterpret_cast<bf16x8*>(qrl + d0 * 1024) = *reinterpret_cast<const bf16x8*>(Qw + DN + d0 * 16);
  }
  int offV[NVC], offK[NKC > 0 ? NKC : 1], offR;
#pragma unroll
  for (int i = 0; i < NVC; ++i) { const int ch = wid * NVC + i, sub = ch * 2 + (lane >> 5), kk = (sub / NCB) * 8 + ((lane & 31) >> 2), col = (sub % NCB) * 32 + (lane & 3) * 8;
    const int k = (kk & ~0xC) | ((kk & 4) << 1) | ((kk & 8) >> 1); offV[i] = k * ldv + col; }
#pragma unroll
  for (int i = 0; i < NKC; ++i) { const int ch = wid * NKC + i, row = ch * 4 + (lane >> 4), cb = ((lane & 15) * 16) ^ ((row & 15) << 4); offK[i] = row * ldkn + (cb >> 1); }
  { const int row = wid * 8 + (lane >> 3), cb = ((lane & 7) * 16) ^ (((row >> 1) & 7) << 4); offR = row * ldkr + (cb >> 1); }
  const int vb0 = (int)(uintptr_t)Vl + v_rd_base(lane);
  const int qd = qpos0 + (MASK ? 0 : wid * 32) + r32 - 4 * hi;
#define TROW(j) ((j) < n1 ? r1 + 64 * (j) : r2 + 64 * ((j) - n1))
#define DMA(j, b) do { const long row0_ = TROW(j); \
    _Pragma("unroll") for (int i_ = 0; i_ < NVC; ++i_) __builtin_amdgcn_global_load_lds((const unsigned*)(Vp + row0_ * ldv + offV[i_]), (ATT_LAS unsigned*)(ldsL + (b) + (wid * NVC + i_) * 1024), 16, 0, 0); \
    _Pragma("unroll") for (int i_ = 0; i_ < NKC; ++i_) __builtin_amdgcn_global_load_lds((const unsigned*)(Kn + row0_ * ldkn + offK[i_]), (ATT_LAS unsigned*)(ldsL + (b) + VB + (wid * NKC + i_) * 1024), 16, 0, 0); \
    __builtin_amdgcn_global_load_lds((const unsigned*)(Kr + row0_ * ldkr + offR), (ATT_LAS unsigned*)(ldsL + (b) + VB + KNB + wid * 1024), 16, 0, 0); } while (0)
#define WAITV() asm volatile("s_waitcnt vmcnt(0)" ::: "memory")
  const int q0w = qpos0 + (MASK ? 0 : wid * 32);
#define KP(j) (kt2 + 64 * ((j) - n1))
#define NEED(j) (!MASK || (j) < n1 || (KP(j) <= q0w + 159 && KP(j) + 63 >= q0w - 128))
#define SCORE(P0, P1, b, j) do { qkt<DN>(P0, P1, Knl + (b), Krl + (b), qr, qrl, r32, hi); \
    if constexpr (MASK) { if ((j) >= n1 && !(KP(j) >= q0w - 97 && KP(j) <= q0w + 65)) band_mask(P0, P1, qd - KP(j)); } } while (0)
#define RESC(a) do { if (__any((a) < 1.f)) { const int l_ = lane_id_v(); if (l_ < 32) al_l[l_] = (a); asm volatile("s_waitcnt lgkmcnt(0)" ::: "memory"); \
    _Pragma("unroll") for (int d = 0; d < NCB; ++d) _Pragma("unroll") for (int r = 0; r < 16; ++r) o[d][r] *= al_l[crow(r, l_ >> 5)]; } } while (0)
#define ROT() do { const int t_ = bp; bp = bc; bc = bn; bn = t_; } while (0)
  f32x16 pA0, pA1, pB0, pB1; float alA, alB; bf16x8 pa0, pa1, pa2, pa3;
  int bp = 0, bc = BUF, bn = 2 * BUF;
  DMA(0, 0); DMA(1, BUF); WAITV(); __syncthreads();
  SCORE(pA0, pA1, 0, 0); partialSM(pA0, pA1, m_reg, alA, C, THRS);
  bool nA = true, nB = true;
  for (int j = 1; j + 1 < NT; j += 2) {
    DMA(j + 1, bn);
    nB = NEED(j);
    SBAR(); if (nB) SCORE(pB0, pB1, bc, j);
    if (nA) finishSM(pA0, pA1, alA, l_reg, pa0, pa1, pa2, pa3); SBAR();
    if (nA) pv_all<NCB>(o, vb0 + bp, pa0, pa1, pa2, pa3);
    if (nB) { partialSM(pB0, pB1, m_reg, alB, C, THRS); RESC(alB); }
    WAITV(); __syncthreads(); ROT();
    DMA(j + 2, bn);
    nA = NEED(j + 1);
    SBAR(); if (nA) SCORE(pA0, pA1, bc, j + 1);
    if (nB) finishSM(pB0, pB1, alB, l_reg, pa0, pa1, pa2, pa3); SBAR();
    if (nB) pv_all<NCB>(o, vb0 + bp, pa0, pa1, pa2, pa3);
    if (nA) { partialSM(pA0, pA1, m_reg, alA, C, THRS); RESC(alA); }
    WAITV(); __syncthreads(); ROT();
  }
  nB = NEED(NT - 1);
  SBAR(); if (nB) SCORE(pB0, pB1, bc, NT - 1);
  if (nA) finishSM(pA0, pA1, alA, l_reg, pa0, pa1, pa2, pa3); SBAR();
  if (nA) pv_all<NCB>(o, vb0 + bp, pa0, pa1, pa2, pa3);
  if (nB) { partialSM(pB0, pB1, m_reg, alB, C, THRS);
    RESC(alB);
    finishSM(pB0, pB1, alB, l_reg, pa0, pa1, pa2, pa3); SBAR();
    pv_all<NCB>(o, vb0 + bc, pa0, pa1, pa2, pa3); }
  l_reg += __builtin_amdgcn_exp2f(sinkl2 - m_reg * C);
  const int lane2 = lane_id_v(), r32e = lane2 & 31, hie = lane2 >> 5;
  if (hie == 0) li_l[r32e] = l_reg; asm volatile("s_waitcnt lgkmcnt(0)" ::: "memory");
  float rli[16];
#pragma unroll
  for (int r = 0; r < 16; ++r) rli[r] = __builtin_amdgcn_rcpf(li_l[crow(r, hie)]);
  bf16_t* Ow = Ob + (MASK ? (long)(wid * 64) : (long)(wid * 32) * ldo);
#pragma unroll
  for (int r = 0; r < 16; ++r) { const int orow = crow(r, hie);
#pragma unroll
    for (int d0 = 0; d0 < NCB; ++d0) Ow[(long)orow * ldo + d0 * 32 + r32e] = (bf16_t)(cvtpk(o[d0][r] * rli[r], 0.f) & 0xffffu); }
  __syncthreads();
#undef TROW
#undef DMA
#undef WAITV
#undef SCORE
#undef RESC
#undef ROT
#undef KP
#undef NEED
}
}

constexpr size_t MiB = 1u << 20;
constexpr size_t WS_MOD = 0;
constexpr size_t WS_SSQ = 512 * 1024;
constexpr size_t WS_ROPE = 1792 * 1024;
constexpr size_t CTL_ZERO_BYTES = 2 * MiB;
constexpr size_t WS_XC = 2 * MiB;
constexpr size_t WS_WIN = 8 * MiB, WS_WQB = 13 * MiB, WS_WKVB = 16 * MiB, WS_WOM = 20 * MiB, WS_WF1 = 28 * MiB, WS_WF2 = 92 * MiB, WS_WQKV = 156 * MiB, WS_WOS = 166 * MiB;
constexpr size_t WS_S1 = 176 * MiB;
constexpr size_t WS_S2 = 306 * MiB;
constexpr size_t WS_G = 436 * MiB;
constexpr size_t WS_Q = WS_G, WS_KV = WS_G + 196 * MiB, WS_KR = WS_G + 456 * MiB;
constexpr size_t WS_PART = WS_G + 520 * MiB;
constexpr size_t WS_END = WS_PART + 64 * MiB;
static_assert((size_t)NROW * 2048 * 2 == 130 * MiB && WS_SSQ + 8 * (size_t)NROW * 4 <= WS_ROPE && (size_t)NROW * NQ * 2 <= 196 * MiB && (size_t)NROW * NKV * 2 <= 260 * MiB, "ws map");

#define LAS __attribute__((address_space(3)))
typedef unsigned short bf16_t;
typedef float f32x4 __attribute__((ext_vector_type(4)));
typedef unsigned u32x4 __attribute__((ext_vector_type(4)));
typedef unsigned u32x2 __attribute__((ext_vector_type(2)));
constexpr int LDS_BYTES = 3 * 40960 + 2048 + 32768;
constexpr int N_PHASES = 17;
#ifndef PROBE_PH
#define PROBE_PH -1
#endif
#ifndef PROBE_PH2
#define PROBE_PH2 -1
#endif
#if PROBE_PH >= 0
#define rep_PROBE0 (rep_ != 0)
#define REP(k) for (int rep_ = 0; rep_ < ((((PROBE_PH) >> (k)) & 1) ? 2 : 1); ++rep_)
#define SSQP(i) (rep_ ? SSQ + 6 * NROW : SSQ + (i) * NROW)
#else
#define rep_PROBE0 false
#define REP(k)
#define SSQP(i) (SSQ + (i) * NROW)
#endif

struct Args { const float* in[18]; float* out; unsigned char* ws; int ph_lo, ph_hi; };

__device__ __forceinline__ float wave_sum(float v) {
#pragma unroll
  for (int o = 1; o < 64; o <<= 1) v += __shfl_xor(v, o);
  return v;
}
__device__ __forceinline__ unsigned pk2(float lo, float hi) { unsigned r; asm volatile("v_cvt_pk_bf16_f32 %0, %1, %2" : "=v"(r) : "v"(lo), "v"(hi)); return r; }

__device__ __forceinline__ int dest_row(int mode, int n) {
  if (mode == 1) { if (n < 1024) return n; const int j = n - 1024; return 1024 + (((j & 31) << 1) | (j >> 5)); }
  if (mode == 2) { const int h = n / 192, d = n - h * 192; if (d < 128) return n; const int j = d - 128; return h * 192 + 128 + (((j & 31) << 1) | (j >> 5)); }
  if (mode == 3) { if (n >= 2304) return n; const int d = n & 63; return (n & ~63) + (((d & 31) << 1) | (d >> 5)); }
  return n;
}
__device__ __forceinline__ void tr_item(const float* __restrict__ W, int K, int N, bf16_t* __restrict__ WT, const float* __restrict__ ks, int mode, LAS float* scr, int item, int lane) {
  const int nblk = N / 32, kb = item / nblk, nb = item - kb * nblk, k0 = 64 * kb, n0 = 32 * nb;
  float wv[32];
#pragma unroll
  for (int i = 0; i < 32; ++i) wv[i] = W[(size_t)(k0 + 2 * i + (lane >> 5)) * N + n0 + (lane & 31)];
  if (ks) {
#pragma unroll
    for (int i = 0; i < 32; ++i) wv[i] *= ks[k0 + 2 * i + (lane >> 5)];
  }
#pragma unroll
  for (int i = 0; i < 32; ++i) scr[(2 * i + (lane >> 5)) * 33 + (lane & 31)] = wv[i];
  asm volatile("s_waitcnt lgkmcnt(0)" ::: "memory");
  const int c = lane & 7;
#pragma unroll
  for (int j = 0; j < 4; ++j) { const int n = (lane >> 3) + 8 * j; const LAS float* s = scr + (8 * c) * 33 + n;
    u32x4 o; o.x = pk2(s[0 * 33], s[1 * 33]); o.y = pk2(s[2 * 33], s[3 * 33]); o.z = pk2(s[4 * 33], s[5 * 33]); o.w = pk2(s[6 * 33], s[7 * 33]);
    *(u32x4*)(WT + (size_t)dest_row(mode, n0 + n) * K + k0 + 8 * c) = o; }
  asm volatile("s_waitcnt lgkmcnt(0)" ::: "memory");
}

__device__ __forceinline__ float silu_f(float x) { return x / (1.f + __expf(-x)); }

constexpr int TI0 = 32 * 34, TI1 = 8 * 96, TI2 = 8 * 128, TI3 = 32 * 64, TI4 = 32 * 256, TI6 = 128 * 64, TI8 = 32 * 80, TI9 = 32 * 64;
constexpr int N_EARLY = TI0 + TI1 + TI2, N_LATE = TI3 + 2 * TI4 + 2 * TI6 + TI8 + TI9;
__device__ __forceinline__ void tr_dispatch(const Args& a, int it  , LAS float* scr, int lane) {
  unsigned char* ws = a.ws;
  int r = it; const float* W; int K, N, mode = 0; const float* ks = nullptr; bf16_t* dst;
  if (r < TI0) { W = a.in[9]; K = 2048; N = 1088; mode = 1; dst = (bf16_t*)(ws + WS_WIN); }
  else if ((r -= TI0) < TI1) { W = a.in[12]; K = 512; N = 3072; mode = 2; ks = a.in[10]; dst = (bf16_t*)(ws + WS_WQB); }
  else if ((r -= TI1) < TI2) { W = a.in[13]; K = 512; N = 4096; ks = a.in[11]; dst = (bf16_t*)(ws + WS_WKVB); }
  else if ((r -= TI2) < TI3) { W = a.in[14]; K = 2048; N = 2048; dst = (bf16_t*)(ws + WS_WOM); }
  else if ((r -= TI3) < 2 * TI4) { const int l = r / TI4; r -= l * TI4; W = a.in[7] + (size_t)l * 2048 * 8192; K = 2048; N = 8192; dst = (bf16_t*)(ws + WS_WF1) + (size_t)l * 2048 * 8192; }
  else if ((r -= 2 * TI4) < 2 * TI6) { const int l = r / TI6; r -= l * TI6; W = a.in[8] + (size_t)l * 2048 * 8192; K = 8192; N = 2048; dst = (bf16_t*)(ws + WS_WF2) + (size_t)l * 2048 * 8192; }
  else if ((r -= 2 * TI6) < TI8) { W = a.in[15]; K = 2048; N = 2560; mode = 3; dst = (bf16_t*)(ws + WS_WQKV); }
  else { r -= TI8; W = a.in[17]; K = 2048; N = 2048; dst = (bf16_t*)(ws + WS_WOS); }
  tr_item(W, K, N, dst, ks, mode, scr, r, lane);
}

__device__ __forceinline__ void p0_prologue(const Args& a, LAS unsigned char* lds, int gw, int NGW, int wave, int lane, bool only_transposes) {
  unsigned char* ws = a.ws;
  LAS float* scr = (LAS float*)(lds + wave * 16384);
  for (int it = gw; it < N_EARLY + N_LATE; it += NGW) tr_dispatch(a, it, scr, lane);
  if (only_transposes) return;
  float* MOD = (float*)(ws + WS_MOD);
  for (int it = gw; it < 2 * 48 * 64; it += NGW) {
    const int kc = it & 63, cb = (it >> 6) % 48, l = it / (64 * 48);
    const int n0 = cb * 256 + lane * 4, k0 = kc * 32;
    const float* Wm = a.in[4] + (size_t)l * 2048 * 12288 + n0;
    f32x4 a0 = {0.f, 0.f, 0.f, 0.f}, a1 = a0, a2 = a0;
#pragma unroll 16
    for (int k = 0; k < 32; ++k) { const int kk = k0 + k;
      const float s0 = silu_f(a.in[1][kk]), s1 = silu_f(a.in[1][2048 + kk]), s2 = silu_f(a.in[3][kk]);
      const f32x4 w = *(const f32x4*)(Wm + (size_t)kk * 12288);
      a0 += w * s0; a1 += w * s1; a2 += w * s2; }
    if (kc == 0) { const f32x4 b = *(const f32x4*)(a.in[5] + l * 12288 + n0); a0 += b; a1 += b; a2 += b; }
    float* mo = MOD + (size_t)(l * 3) * 12288 + n0;
#pragma unroll
    for (int e = 0; e < 4; ++e) { atomicAdd(mo + e, a0[e]); atomicAdd(mo + 12288 + e, a1[e]); atomicAdd(mo + 2 * 12288 + e, a2[e]); }
  }
  float* tab = (float*)(ws + WS_ROPE);
  for (int e = gw * 64 + lane; e < 320 * 16; e += NGW * 64) {
    const int i = e & 15, pos = e >> 4; const float p = (float)(pos < 256 ? pos : pos - 256);
    const float freq = exp2f(-(float)i * 0.8304820237218406f); const float ang = p * freq;
    tab[e * 2] = cosf(ang); tab[e * 2 + 1] = sinf(ang);
  }
}

__device__ __forceinline__ f32x4 ldf4(const float* base, unsigned boff) { return *(const f32x4*)((const char*)base + boff); }
__device__ __forceinline__ void stf4(float* base, unsigned boff, f32x4 v) { *(f32x4*)((char*)base + boff) = v; }
__device__ __forceinline__ f32x4 ldf4s(const float* base, unsigned boff) { return __builtin_nontemporal_load((const f32x4*)((const char*)base + boff)); }
__device__ __forceinline__ void stf4s(float* base, unsigned boff, f32x4 v) { __builtin_nontemporal_store(v, (f32x4*)((char*)base + boff)); }
template <bool UPD, bool DOH, int NKC>
__device__ __forceinline__ void norm_rows(const int row0, const int nrows, const float* xin_lat, const float* xin_ctx, float* xout_lat, float* xout_ctx, const bf16_t* Y, const float* ssq,
    const float* gA, const float* gateM, const float* gB, const float* scM, const float* shM, bf16_t* H, int lane, const float* part) {
  const int b = row0 / TB, rb = row0 - b * TB; const bool isctx = rb < CTXL;
  const int v = isctx ? 2 : b;
  const size_t xoff = isctx ? (size_t)(b * CTXL + rb) * DM : (size_t)(b * SEQ + rb - CTXL) * DM;
  const float* xin = (isctx ? xin_ctx : xin_lat) + xoff;
  float* xout = UPD ? ((isctx ? xout_ctx : xout_lat) + xoff) : nullptr;
  const int lane_ = lane_id_v();
  const unsigned lo = (unsigned)lane_ * 16u, lo2 = (unsigned)lane_ * 8u;
  f32x4 GA[8], GB[8], SH[8];
#pragma unroll
  for (int j = 0; j < 8; ++j) { const unsigned o = lo + 1024u * j;
    if (UPD) GA[j] = ldf4(gateM + v * 12288, o) * ldf4(gA, o);
    if (DOH) { GB[j] = ldf4(gB, o) * (ldf4(scM + v * 12288, o) + 1.0f); SH[j] = ldf4(shM + v * 12288, o); } }
  f32x4 xn[8]; u32x2 yn[8];
#pragma unroll
  for (int j = 0; j < 8; ++j) { xn[j] = ldf4s(xin, lo + 1024u * j); if (UPD && !(NKC > 0 && isctx)) yn[j] = __builtin_nontemporal_load((const u32x2*)((const char*)(Y + (size_t)row0 * DM) + lo2 + 512u * j)); }
  for (int rr = 0; rr < nrows; ++rr) {
    const int row = row0 + rr;
    f32x4 x[8]; u32x2 yc[8];
#pragma unroll
    for (int j = 0; j < 8; ++j) { x[j] = xn[j]; if (UPD) yc[j] = yn[j]; }
    if (rr + 1 < nrows) { const float* xr = xin + (size_t)(rr + 1) * DM;
#pragma unroll
      for (int j = 0; j < 8; ++j) { xn[j] = ldf4s(xr, lo + 1024u * j); if (UPD && !(NKC > 0 && isctx)) yn[j] = __builtin_nontemporal_load((const u32x2*)((const char*)(Y + (size_t)(row + 1) * DM) + lo2 + 512u * j)); } }
    if (UPD && NKC > 0 && isctx) {
      f32x4 y[8]; float ys = 0.f; const float* pr = part + (size_t)(b * CTXL + rb + rr) * DM;
#pragma unroll
      for (int j = 0; j < 8; ++j) y[j] = ldf4(pr, lo + 1024u * j);
#pragma unroll 1
      for (int k = 1; k < NKC; ++k) { pr += (size_t)512 * DM;
#pragma unroll
        for (int j = 0; j < 8; ++j) y[j] += ldf4(pr, lo + 1024u * j); }
#pragma unroll
      for (int j = 0; j < 8; ++j) ys += (y[j][0] * y[j][0] + y[j][1] * y[j][1]) + (y[j][2] * y[j][2] + y[j][3] * y[j][3]);
      const float rinv = __builtin_amdgcn_rsqf(wave_sum(ys) * (1.0f / 2048.0f) + NORM_EPS);
      float* xo = xout + (size_t)rr * DM;
#pragma unroll
      for (int j = 0; j < 8; ++j) { x[j] += GA[j] * (y[j] * rinv); stf4s(xo, lo + 1024u * j, x[j]); }
    } else if (UPD) {
      const float rinv = __builtin_amdgcn_rsqf(ssq[row] * (1.0f / 2048.0f) + NORM_EPS);
      float* xo = xout + (size_t)rr * DM;
#pragma unroll
      for (int j = 0; j < 8; ++j) { const u32x2 yb = yc[j];
        f32x4 y; y[0] = __uint_as_float(yb.x << 16); y[1] = __uint_as_float(yb.x & 0xffff0000u); y[2] = __uint_as_float(yb.y << 16); y[3] = __uint_as_float(yb.y & 0xffff0000u);
        x[j] += GA[j] * (y * rinv);
        stf4s(xo, lo + 1024u * j, x[j]); }
    }
    if (DOH) {
      float ss = 0.f;
#pragma unroll
      for (int j = 0; j < 8; ++j) ss += (x[j][0] * x[j][0] + x[j][1] * x[j][1]) + (x[j][2] * x[j][2] + x[j][3] * x[j][3]);
      const float r = __builtin_amdgcn_rsqf(wave_sum(ss) * (1.0f / 2048.0f) + NORM_EPS);
      bf16_t* hr = H + (size_t)row * DM;
#pragma unroll
      for (int j = 0; j < 8; ++j) { const f32x4 h = x[j] * r * GB[j] + SH[j]; u32x2 w; w.x = pk2(h[0], h[1]); w.y = pk2(h[2], h[3]);
        *(u32x2*)((char*)hr + lo2 + 512u * j) = w; }
    }
  }
}
template <bool UPD, bool DOH, int NKC = 0>
__device__ __forceinline__ void norm_phase(const float* xin_lat, const float* xin_ctx, float* xout_lat, float* xout_ctx, const bf16_t* Y, const float* ssq,
    const float* gA, const float* gateM, const float* gB, const float* scM, const float* shM, bf16_t* H, bool skipctx, int gw, int NGW, int lane, const float* part = nullptr) {
  for (int ch = gw; ch < 2 * SEQ / 16; ch += NGW) { const int b = ch / (SEQ / 16), row0 = b * TB + CTXL + (ch - b * (SEQ / 16)) * 16;
    norm_rows<UPD, DOH, 0>(row0, 16, xin_lat, xin_ctx, xout_lat, xout_ctx, Y, ssq, gA, gateM, gB, scM, shM, H, lane, part); }
  if (!skipctx)
    for (int r = gw; r < 2 * CTXL; r += NGW) { const int b = r / CTXL, row0 = b * TB + (r - b * CTXL);
      norm_rows<UPD, DOH, NKC>(row0, 1, xin_lat, xin_ctx, xout_lat, xout_ctx, Y, ssq, gA, gateM, gB, scM, shM, H, lane, part); }
}

__global__ void __launch_bounds__(512, 2) mk_fwd(Args a) {
  extern __shared__ __attribute__((aligned(16))) unsigned char lds[];
  cg::grid_group grid = cg::this_grid();
  const int wave = __builtin_amdgcn_readfirstlane(threadIdx.x >> 6);
  const int G = gridDim.x, c = blockIdx.x, gw = c * 8 + wave, NGW = G * 8;
  LAS unsigned char* ldsL = (LAS unsigned char*)lds;
  unsigned char* ws = a.ws;
  const int lo = a.ph_lo, hi = a.ph_hi;
#define IN(k) (lo <= (k) && (k) < hi)
  unsigned* barw = (unsigned*)(ws + CTL_ZERO_BYTES - 256); unsigned bar_epoch = 0;
#define OWN_BAR() do { __builtin_amdgcn_fence(__ATOMIC_RELEASE, "workgroup"); __builtin_amdgcn_s_barrier(); bar_epoch += (unsigned)G; \
    if (wave == 0) { if (lane_id_v() == 0) { __builtin_amdgcn_fence(__ATOMIC_ACQUIRE, "workgroup"); __builtin_amdgcn_fence(__ATOMIC_RELEASE, "agent"); \
      __hip_atomic_fetch_add(barw, 1u, __ATOMIC_RELAXED, __HIP_MEMORY_SCOPE_AGENT); \
      while (__hip_atomic_load(barw, __ATOMIC_RELAXED, __HIP_MEMORY_SCOPE_AGENT) < bar_epoch) __builtin_amdgcn_s_sleep(1); \
      __builtin_amdgcn_fence(__ATOMIC_ACQUIRE, "agent"); __builtin_amdgcn_fence(__ATOMIC_RELEASE, "workgroup"); } } \
    __builtin_amdgcn_s_barrier(); __builtin_amdgcn_fence(__ATOMIC_ACQUIRE, "workgroup"); } while (0)
#define SEAM(k) do { if (IN(k) && IN((k) + 1)) { if ((k) == 0) grid.sync(); else { OWN_BAR(); if ((PROBE_PH >> 20) & 1) OWN_BAR(); } } } while (0)
  float* MOD = (float*)(ws + WS_MOD); float* SSQ = (float*)(ws + WS_SSQ);
  const float* RT = (const float*)(ws + WS_ROPE); const float* CT = RT + 256 * 16 * 2;
  float* XC = (float*)(ws + WS_XC); float* PART = (float*)(ws + WS_PART);
  bf16_t* S1 = (bf16_t*)(ws + WS_S1); bf16_t* S2 = (bf16_t*)(ws + WS_S2);
  bf16_t* Qb = (bf16_t*)(ws + WS_Q); bf16_t* KVb = (bf16_t*)(ws + WS_KV); bf16_t* KRb = (bf16_t*)(ws + WS_KR); bf16_t* Gb = (bf16_t*)(ws + WS_G);
  const float* gn = a.in[6];
#define MODP(l, chunk) (MOD + (size_t)(l) * 3 * 12288 + (chunk) * 2048)
#define RUN_GEMM(MODE, Ap, lda_, Bp, N_, K_, skip, ...) do { pg8::Gemm g{Ap, Bp, NROW, N_, K_, lda_, K_}; pg8::RowSched S; S.init((skip) ? 128 : 130, (N_) / 256, G, c, (skip) ? 1 : 0); \
    pg8::Epi<MODE> E{__VA_ARGS__}; pg8::gemm_phase<pg8::Epi<MODE>, pg8::RowSched, true, true>(ldsL, g, S, E, wave); } while (0)
#define RUN_CTX_SPLIT(Ap, Bp, K_, NKC_) do { pg8::Gemm g{Ap, Bp, NROW, 2048, (K_) / (NKC_), K_, K_}; pg8::CtxSplitSched S; S.init(8, NKC_, G, c); \
    pg8::Epi<6> E{nullptr, 2048, nullptr, nullptr, nullptr, RT, CT, PART}; pg8::gemm_phase<pg8::Epi<6>, pg8::CtxSplitSched, true, true>(ldsL, g, S, E, wave); } while (0)

  if (IN(0)) { REP(0) p0_prologue(a, ldsL, gw, NGW, wave, lane_id_v(), rep_PROBE0); __syncthreads(); } SEAM(0);
  if (IN(1)) REP(1) norm_phase<false, true>(a.in[0], a.in[2], nullptr, nullptr, nullptr, nullptr, nullptr, nullptr, gn + 0 * 2048, MODP(0, 1), MODP(0, 0), S1, false, gw, NGW, lane_id_v());
  SEAM(1);
  if (IN(2)) REP(2) RUN_GEMM(1, S1, 2048, (const bf16_t*)(ws + WS_WIN), NP1, 2048, false, S2, NP1, SSQP(0), nullptr, KRb, RT, CT);
  SEAM(2);
  if (IN(3)) REP(3) {
    RUN_GEMM(2, S2, NP1, (const bf16_t*)(ws + WS_WQB), NQ, 512, false, Qb, NQ, nullptr, SSQ, nullptr, RT, CT);
    RUN_GEMM(3, S2 + 512, NP1, (const bf16_t*)(ws + WS_WKVB), NKV, 512, false, KVb, NKV, nullptr, SSQ + NROW, nullptr, RT, CT);
  }
  SEAM(3);
  if (IN(4)) REP(4) {
    const float SC = 0.07216878364870322f, Cc = SC * 1.4426950408889634f, THRS = 8.f / SC;
    for (int r = 0;; ++r) {
      const int u = c + r * G; if (u >= 2080) break;
      int b, h, rowq, NT;
      if (u < 2048) { int pair, qb; if (G == 256) { pair = (c & 7) * 4 + (r >> 1); qb = (c >> 3) + 32 * (r & 1); } else { pair = u >> 6; qb = u & 63; }
        b = pair >> 4; h = pair & 15; rowq = b * TB + CTXL + qb * 256; NT = TB / 64; }
      else { const int p = u - 2048; b = p >> 4; h = p & 15; rowq = b * TB; NT = CTXL / 64; }
      att::attn_unit<128, 128, false>(Qb + (size_t)rowq * NQ + h * 192, NQ, KVb + h * 256, NKV, KRb, 64, KVb + h * 256 + 128, NKV, S1 + (size_t)rowq * DM + h * 128, DM,
                                      NT, NT, b * TB, 0, 0, 0, Cc, THRS, -INFINITY, (char*)lds, ldsL, wave);
    }
  }
  SEAM(4);
  if (IN(5)) REP(5) { RUN_GEMM(0, S1, 2048, (const bf16_t*)(ws + WS_WOM), 2048, 2048, true, S2, 2048, SSQP(2), nullptr, nullptr, RT, CT);
    RUN_CTX_SPLIT(S1, (const bf16_t*)(ws + WS_WOM), 2048, 8); }
  SEAM(5);
  if (IN(6)) norm_phase<true, true, 8>(a.in[0], a.in[2], a.out, XC, S2, SSQ + 2 * NROW, gn + 1 * 2048, MODP(0, 2), gn + 2 * 2048, MODP(0, 4), MODP(0, 3), S1, false, gw, NGW, lane_id_v(), PART);
  SEAM(6);
  if (IN(7)) REP(7) RUN_GEMM(4, S1, 2048, (const bf16_t*)(ws + WS_WF1), DFF, 2048, false, Gb, DFF, nullptr, nullptr, nullptr, RT, CT);
  SEAM(7);
  if (IN(8)) REP(8) { RUN_GEMM(0, Gb, DFF, (const bf16_t*)(ws + WS_WF2), 2048, DFF, true, S2, 2048, SSQP(3), nullptr, nullptr, RT, CT);
    RUN_CTX_SPLIT(Gb, (const bf16_t*)(ws + WS_WF2), DFF, 16); }
  SEAM(8);
  if (IN(9)) norm_phase<true, true, 16>(a.out, XC, a.out, XC, S2, SSQ + 3 * NROW, gn + 3 * 2048, MODP(0, 5), gn + 4 * 2048, MODP(1, 1), MODP(1, 0), S1, false, gw, NGW, lane_id_v(), PART);
  SEAM(9);
  if (IN(10)) REP(10) RUN_GEMM(5, S1, 2048, (const bf16_t*)(ws + WS_WQKV), NQKV, 2048, false, Gb, NQKV, nullptr, nullptr, nullptr, RT, CT);
  SEAM(10);
  if (IN(11)) REP(11) {
    const float SC = 0.125f, Cc = SC * 1.4426950408889634f, THRS = 8.f / SC;
    for (int u = c; u < 4096; u += G) {
      const int pairkv = u >> 9, qb32 = u & 511, b = pairkv >> 2, kvh = pairkv & 3, t0 = qb32 * 32;
      int f = (t0 - 128) < 0 ? 0 : (t0 - 128) >> 6, l = (t0 + 159) >> 6; if (l > SEQ / 64 - 1) l = SEQ / 64 - 1;
      if ((l - f + 1) & 1) { if (l < SEQ / 64 - 1) ++l; else --f; }
      const int nwin = l - f + 1, tstart = 64 * f;
      const int rowq = b * TB + CTXL + t0;
      att::attn_unit<0, 64, true>(Gb + (size_t)rowq * NQKV + kvh * 512, NQKV, nullptr, 0, Gb + 2048 + kvh * 64, NQKV, Gb + 2304 + kvh * 64, NQKV, S1 + (size_t)rowq * DM + kvh * 512, DM,
                                  4 + nwin, 4, b * TB, b * TB + CTXL + tstart, t0, tstart, Cc, THRS, a.in[16][kvh * 8 + wave] * 1.4426950408889634f, (char*)lds, ldsL, wave);
    }
  }
  SEAM(11);
  if (IN(12)) REP(12) RUN_GEMM(0, S1, 2048, (const bf16_t*)(ws + WS_WOS), 2048, 2048, true, S2, 2048, SSQP(4), nullptr, nullptr, RT, CT);
  SEAM(12);
  if (IN(13)) norm_phase<true, true>(a.out, XC, a.out, XC, S2, SSQ + 4 * NROW, gn + 5 * 2048, MODP(1, 2), gn + 6 * 2048, MODP(1, 4), MODP(1, 3), S1, true, gw, NGW, lane_id_v());
  SEAM(13);
  if (IN(14)) REP(14) RUN_GEMM(4, S1, 2048, (const bf16_t*)(ws + WS_WF1) + (size_t)2048 * 8192, DFF, 2048, true, Gb, DFF, nullptr, nullptr, nullptr, RT, CT);
  SEAM(14);
  if (IN(15)) REP(15) RUN_GEMM(0, Gb, DFF, (const bf16_t*)(ws + WS_WF2) + (size_t)2048 * 8192, 2048, DFF, true, S2, 2048, SSQP(5), nullptr, nullptr, RT, CT);
  SEAM(15);
  if (IN(16)) norm_phase<true, false>(a.out, XC, a.out, XC, S2, SSQ + 5 * NROW, gn + 7 * 2048, MODP(1, 5), nullptr, nullptr, nullptr, nullptr, true, gw, NGW, lane_id_v());
#undef IN
#undef SEAM
}

extern "C" void kernel_launch(void* const* d_in, const int* in_sizes, int n_in, void* d_out, int out_size, void* d_ws, size_t ws_size, hipStream_t stream) {
  static int grid = 0;
  if (grid == 0) {
    if (n_in != 18 || out_size != 2 * SEQ * DM || ws_size < WS_END) { fprintf(stderr, "kernel_launch: unexpected shapes: n_in %d out %d ws %zu (need %zu)\n", n_in, out_size, ws_size, (size_t)WS_END); grid = -1; return; }
    int dev = 0, cus = 0, per_cu = 0;
    hipGetDevice(&dev); hipDeviceGetAttribute(&cus, hipDeviceAttributeMultiprocessorCount, dev);
    if (hipFuncSetAttribute((const void*)mk_fwd, hipFuncAttributeMaxDynamicSharedMemorySize, LDS_BYTES) != hipSuccess) { fprintf(stderr, "kernel_launch: hipFuncSetAttribute failed\n"); grid = -1; return; }
    if (hipOccupancyMaxActiveBlocksPerMultiprocessor(&per_cu, (const void*)mk_fwd, 512, LDS_BYTES) != hipSuccess || per_cu < 1) { fprintf(stderr, "kernel_launch: occupancy query gave %d\n", per_cu); per_cu = 1; }
    (void)hipGetLastError();
    grid = cus * per_cu;
    fprintf(stderr, "kernel_launch: grid %d (cus %d x %d)\n", grid, cus, per_cu);
  }
  if (grid < 0) return;
  hipMemsetAsync((char*)d_ws, 0, CTL_ZERO_BYTES, stream);
  Args a{};
  for (int i = 0; i < 18; ++i) a.in[i] = (const float*)d_in[i];
  a.out = (float*)d_out; a.ws = (unsigned char*)d_ws; a.ph_lo = 0; a.ph_hi = N_PHASES;
  void* args[] = {&a};
  hipError_t e = hipLaunchCooperativeKernel((const void*)mk_fwd, dim3(grid), dim3(512), args, LDS_BYTES, stream);
  if (e != hipSuccess) fprintf(stderr, "kernel_launch: cooperative launch failed: %s (grid %d)\n", hipGetErrorString(e), grid);
}
```

```cpp
#include <hip/hip_runtime.h>
#include <hip/hip_cooperative_groups.h>
#include <cstdio>
#include <cstdint>
namespace cg = cooperative_groups;

constexpr int DM = 2048, SEQ = 16384, CTXL = 256, TB = SEQ + CTXL  , NROW = 2 * TB  , DFF = 8192;
constexpr int NP1 = 1280  , NQ = 3072, NKV = 4096, NQKV = 2560;
constexpr float NORM_EPS = 1e-6f;
__device__ __forceinline__ int lane_id_v() { int l; asm volatile("v_mbcnt_lo_u32_b32 %0, -1, 0\n\tv_mbcnt_hi_u32_b32 %0, -1, %0" : "=v"(l)); return l; }
namespace pg8 {
#define PG8_LAS __attribute__((address_space(3)))
typedef unsigned short bf16_t;
typedef short bf16x8 __attribute__((ext_vector_type(8)));
typedef float f32x4 __attribute__((ext_vector_type(4)));
typedef unsigned u32x4 __attribute__((ext_vector_type(4)));
constexpr int BM = 256, BK = 64, HALF = 128, HTB = HALF * BK * 2  , STAGE_BYTES = 8 * HTB, NXCD = 8, WGM = 4;

__host__ __device__ __forceinline__ int lds_byte(int r, int c) { const int st = (r >> 4) * 2 + (c >> 5), rr = r & 15, cc = c & 31, ob = rr * 64 + cc * 2; return st * 1024 + (ob ^ (((ob >> 9) & 1) << 5)); }
__host__ __device__ __forceinline__ void stage_rc(int b, int& R, int& C) { const int st = b / 1024, sb = b % 1024, swz = sb ^ (((sb >> 9) & 1) << 5); R = (st >> 1) * 16 + swz / 64; C = (st & 1) * 32 + (swz % 64) / 2; }
__host__ __device__ __forceinline__ int perm32(int rho) { const int n = rho >> 4, i = rho & 15; return 8 * (i >> 2) + 4 * n + (i & 3); }

struct Unit { int pm, pn, kc; };
struct Gemm { const bf16_t* A; const bf16_t* Bt; int M, N, K, lda, ldb; };

struct StaticOrder {
    int nM, nN, nwg, G, c;
    __host__ __device__ void init(int M, int N, int G_, int c_) { nM = M / BM; nN = N / BM; nwg = nM * nN; G = G_; c = c_; }
    __host__ __device__ bool next(int i, Unit& u) const {
        const long L = (long)i * G + c; if (L >= nwg) return false;
        int wgid = (int)L; { const int q = nwg / NXCD, r = nwg % NXCD, xcd = wgid % NXCD, off = wgid / NXCD; wgid = (xcd < r ? xcd * (q + 1) : r * (q + 1) + (xcd - r) * q) + off; }
        const int nig = WGM * nN, gid = wgid / nig, fm = gid * WGM, gsz = (nM - fm) < WGM ? (nM - fm) : WGM;
        u.pm = fm + ((wgid % nig) % gsz); u.pn = (wgid % nig) / gsz; return true;
    }
    __device__ __forceinline__ void a_ready(const Unit&) const {}
    __device__ __forceinline__ void done(const Unit&) const {}
};


__device__ __forceinline__ unsigned cvt_pk_bf16(float lo, float hi) { unsigned r; asm volatile("v_cvt_pk_bf16_f32 %0, %1, %2" : "=v"(r) : "v"(lo), "v"(hi)); return r; }

struct RowSched {
    int nM, nN, nwg, G, c, skipctx, rev;
    __device__ void init(int nM_, int nN_, int G_, int c_, int skipctx_, int rev_ = 0) { nM = nM_; nN = nN_; nwg = nM * nN; G = G_; c = c_; skipctx = skipctx_; rev = rev_; }
    __device__ bool next(int i, Unit& u) const {
        const long L = (long)i * G + c; if (L >= nwg) return false;
        int wgid = (int)L; { const int q = nwg / NXCD, r = nwg % NXCD, xcd = wgid % NXCD, off = wgid / NXCD; wgid = (xcd < r ? xcd * (q + 1) : r * (q + 1) + (xcd - r) * q) + off; }
        const int nig = WGM * nN, gid = wgid / nig, fm = gid * WGM, gsz = (nM - fm) < WGM ? (nM - fm) : WGM;
        int pm = fm + ((wgid % nig) % gsz); u.pn = (wgid % nig) / gsz;
        if (rev) pm = nM - 1 - pm;
        if (skipctx) pm += 1 + (pm >= 64 ? 1 : 0);
        u.pm = pm; u.kc = 0; return true;
    }
    __device__ __forceinline__ void a_ready(const Unit&) const {}
    __device__ __forceinline__ void done(const Unit&) const {}
};

struct CtxSplitSched {
    int nN, NKC, nwg, G, c;
    __device__ void init(int nN_, int NKC_, int G_, int c_) { nN = nN_; NKC = NKC_; nwg = 2 * nN * NKC; G = G_; c = c_; }
    __device__ bool next(int i, Unit& u) const {
        const long L = (long)i * G + c; if (L >= nwg) return false;
        const int l = (int)L, t = l / NKC; u.kc = l - t * NKC; u.pn = t % nN; u.pm = (t / nN) ? 65 : 0; return true;
    }
    __device__ __forceinline__ void a_ready(const Unit&) const {}
    __device__ __forceinline__ void done(const Unit&) const {}
};

template <int MODE> struct Epi {
    static constexpr bool PERM = true, AFTER_DRAIN = false;
    bf16_t* O; int ldc;
    float* ssq;
    const float* rssq;
    bf16_t* KR;
    const float* rtab; const float* ctab;
    float* part;
    __device__ __forceinline__ void operator()(const f32x4 (&acc)[2][2][4][2], const Unit& u, int wr, int wc, int fr, int fq) const {
        const int pm = u.pm, pn = u.pn;
        const bool isctx = (pm == 0) || (pm == 65);
        const int tbase = (pm > 65 ? pm - 66 : pm - 1) * 256;
#pragma unroll
        for (int ai = 0; ai < 2; ++ai)
#pragma unroll
            for (int m = 0; m < 4; ++m) {
                const int rt = ai * HALF + wr * 64 + m * 16 + fr;
                const int row = pm * BM + rt;
                const int t = tbase + rt;
                float rs = 1.f;
                if (MODE == 2 || MODE == 3) rs = __builtin_amdgcn_rsqf(rssq[row] * (1.0f / 512.0f) + 1e-6f);
                float sq = 0.f;
#pragma unroll
                for (int bj = 0; bj < 2; ++bj) {
                    const int col = pn * BM + bj * HALF + wc * 32 + 8 * fq;
                    f32x4 v0 = acc[ai][bj][m][0], v1 = acc[ai][bj][m][1];
                    if (MODE == 6) { float* pp = part + ((size_t)u.kc * 512 + (pm == 65 ? 256 : 0) + rt) * ldc + col; *(f32x4*)pp = v0; *(f32x4*)(pp + 4) = v1; continue; }
                    if (MODE == 2 || MODE == 3) { v0 = v0 * rs; v1 = v1 * rs; }
                    if (MODE == 0 || MODE == 1) sq += (v0[0] * v0[0] + v0[1] * v0[1]) + (v0[2] * v0[2] + v0[3] * v0[3]) + (v1[0] * v1[0] + v1[1] * v1[1]) + (v1[2] * v1[2] + v1[3] * v1[3]);
                    bool dorope = false; int i0 = 0;
                    if (MODE == 2) { const int hc = col % 192; dorope = (!isctx) && (hc >= 128); i0 = (hc - 128) >> 1; }
                    if (MODE == 5) { dorope = (!isctx) && (col < 2304); i0 = (col & 63) >> 1; }
                    if (MODE == 1) { dorope = (!isctx) && (pn == 4) && (col < 1088); i0 = (col - 1024) >> 1; }
                    if (MODE == 1 || MODE == 2 || MODE == 5) {
                        if (dorope) {
                            const float* tb = (i0 < 16) ? (rtab + ((t >> 6) * 16 + i0) * 2) : (ctab + ((t & 63) * 16 + (i0 - 16)) * 2);
                            const f32x4 c0 = *(const f32x4*)tb, c1 = *(const f32x4*)(tb + 4);
                            f32x4 w0, w1;
                            w0[0] = v0[0] * c0[0] - v0[1] * c0[1]; w0[1] = v0[0] * c0[1] + v0[1] * c0[0];
                            w0[2] = v0[2] * c0[2] - v0[3] * c0[3]; w0[3] = v0[2] * c0[3] + v0[3] * c0[2];
                            w1[0] = v1[0] * c1[0] - v1[1] * c1[1]; w1[1] = v1[0] * c1[1] + v1[1] * c1[0];
                            w1[2] = v1[2] * c1[2] - v1[3] * c1[3]; w1[3] = v1[2] * c1[3] + v1[3] * c1[2];
                            v0 = w0; v1 = w1;
                        }
                    }
                    if (MODE == 4) {
#pragma unroll
                        for (int e = 0; e < 4; ++e) { const float a = fmaxf(v0[e], 0.f), b = fmaxf(v1[e], 0.f); v0[e] = a * a; v1[e] = b * b; }
                    }
                    u32x4 w; w.x = cvt_pk_bf16(v0[0], v0[1]); w.y = cvt_pk_bf16(v0[2], v0[3]); w.z = cvt_pk_bf16(v1[0], v1[1]); w.w = cvt_pk_bf16(v1[2], v1[3]);
                    if (MODE == 1 && pn == 4) { if (col < 1088) *(u32x4*)(KR + (size_t)row * 64 + (col - 1024)) = w; }
                    else *(u32x4*)(O + (size_t)row * ldc + col) = w;
                }
                if (MODE == 0 || MODE == 1) {
                    if (MODE == 0 || pn < 4) {
                        sq += __shfl_xor(sq, 16); sq += __shfl_xor(sq, 32);
                        if (fq == 0) atomicAdd(ssq + (MODE == 1 ? (size_t)(pn >> 1) * NROW : (size_t)0) + row, sq);
                    }
                }
            }
    }
};

template <class Epi, class Sched, bool ALIGN_EPI = false, bool SP2 = false>
__device__ __forceinline__ void gemm_phase(PG8_LAS unsigned char* lds, const Gemm g, const Sched& S, const Epi& E, const int wave_) {
    const int wid = wave_, lane = lane_id_v(), tid = wid * 64 + lane, wr = wid >> 2, wc = wid & 3, fr = lane & 15, fq = lane >> 4;
    const int K = g.K, nt = K / BK, lda = g.lda, ldb = g.ldb;
    unsigned voffA[2], voffB[2];
#pragma unroll
    for (int i = 0; i < 2; ++i) { int R, C; stage_rc(tid * 16 + i * 8192, R, C); const int Rb = Epi::PERM ? ((R & ~31) + perm32(R & 31)) : R;
        voffA[i] = (unsigned)(R * lda + C) * 2u; voffB[i] = (unsigned)(Rb * ldb + C) * 2u; }
    const size_t kstep = (size_t)(BK * 2);
    const size_t hstepA = (size_t)HALF * lda * 2, hstepB = (size_t)HALF * ldb * 2;
    const size_t tstepA = 2 * hstepA, tstepB = 2 * hstepB;
    const unsigned ldsw = (unsigned)wid * 1024u;
    const int aoff = lds_byte(wr * 64 + fr, fq * 8), boff = lds_byte(wc * 32 + fr, fq * 8);
#define PG8_SA(b, h) (((b) * 2 + (h)) * HTB)
#define PG8_SB(b, h) ((4 + (b) * 2 + (h)) * HTB)
#define PG8_STAGE(bufoff, gbase, voff) do { _Pragma("unroll") for (int _i = 0; _i < 2; ++_i) \
        __builtin_amdgcn_global_load_lds((const unsigned*)((const char*)(gbase) + (voff)[_i]), (PG8_LAS unsigned*)(lds + (bufoff) + ldsw + _i * 8192), 16, 0, 0); } while (0)
#define PG8_LDA(dst, b, h) do { _Pragma("unroll") for (int m = 0; m < 4; ++m) _Pragma("unroll") for (int k = 0; k < 2; ++k) dst[m][k] = *(const PG8_LAS bf16x8*)(lds + PG8_SA(b, h) + aoff + m * 2048 + k * 1024); } while (0)
#define PG8_LDB(dst, b, h) do { _Pragma("unroll") for (int n = 0; n < 2; ++n) _Pragma("unroll") for (int k = 0; k < 2; ++k) dst[n][k] = *(const PG8_LAS bf16x8*)(lds + PG8_SB(b, h) + boff + n * 2048 + k * 1024); } while (0)
#define PG8_MMA(ai, bj, At, Bt) do { __builtin_amdgcn_s_setprio(1); _Pragma("unroll") for (int m = 0; m < 4; ++m) _Pragma("unroll") for (int n = 0; n < 2; ++n) _Pragma("unroll") for (int k = 0; k < 2; ++k) \
        acc[ai][bj][m][n] = __builtin_amdgcn_mfma_f32_16x16x32_bf16(Bt[n][k], At[m][k], acc[ai][bj][m][n], 0, 0, 0); __builtin_amdgcn_s_setprio(0); } while (0)
#define PG8_WAIT_V(n) asm volatile("s_waitcnt vmcnt(" #n ")" ::: "memory")
#define PG8_WAIT_L(n) asm volatile("s_waitcnt lgkmcnt(" #n ")" ::: "memory")
#define PG8_BAR __builtin_amdgcn_s_barrier()
#define PG8_SCHED __builtin_amdgcn_sched_barrier(0)
    Unit cur, nxt; int ui = 0;
    if (!S.next(0, cur)) return;
    f32x4 acc[2][2][4][2];
#pragma unroll
    for (int a = 0; a < 2; ++a)
#pragma unroll
        for (int b = 0; b < 2; ++b)
#pragma unroll
            for (int m = 0; m < 4; ++m)
#pragma unroll
                for (int n = 0; n < 2; ++n) acc[a][b][m][n] = (f32x4){0.f, 0.f, 0.f, 0.f};
    bf16x8 At[4][2], B0[2][2], B1[2][2];
    const char* cA = (const char*)g.A + (size_t)cur.pm * tstepA + (size_t)cur.kc * K * 2; const char* cB = (const char*)g.Bt + (size_t)cur.pn * tstepB + (size_t)cur.kc * K * 2;
    S.a_ready(cur);
    if constexpr (SP2) {
        PG8_STAGE(PG8_SB(0, 0), cB, voffB); PG8_STAGE(PG8_SB(0, 1), cB + hstepB, voffB); PG8_STAGE(PG8_SA(0, 0), cA, voffA); PG8_STAGE(PG8_SA(0, 1), cA + hstepA, voffA);
        if (wr == 1) PG8_BAR;
        PG8_WAIT_V(2); PG8_BAR;
        PG8_STAGE(PG8_SB(1, 0), cB + kstep, voffB); PG8_STAGE(PG8_SA(1, 0), cA + kstep, voffA); PG8_STAGE(PG8_SB(1, 1), cB + hstepB + kstep, voffB);
        PG8_WAIT_V(6); PG8_BAR;
    } else {
        PG8_STAGE(PG8_SB(0, 0), cB, voffB); PG8_STAGE(PG8_SA(0, 0), cA, voffA); PG8_STAGE(PG8_SB(0, 1), cB + hstepB, voffB); PG8_STAGE(PG8_SA(0, 1), cA + hstepA, voffA);
        if (wr == 1) PG8_BAR;
        PG8_WAIT_V(4); PG8_BAR;
        PG8_STAGE(PG8_SB(1, 0), cB + kstep, voffB); PG8_STAGE(PG8_SA(1, 0), cA + kstep, voffA); PG8_STAGE(PG8_SB(1, 1), cB + hstepB + kstep, voffB);
        PG8_WAIT_V(6); PG8_BAR;
    }
    for (;;) {
        const bool has_next = S.next(ui + 1, nxt);
        const char* nA = has_next ? (const char*)g.A + (size_t)nxt.pm * tstepA + (size_t)nxt.kc * K * 2 : cA; const char* nB = has_next ? (const char*)g.Bt + (size_t)nxt.pn * tstepB + (size_t)nxt.kc * K * 2 : cB;
        for (int t = 0; t < nt; t += 2) {
            const bool last = (t == nt - 2);
            const char* a1 = cA + (size_t)(t + 1) * kstep;
            const char* a2 = last ? nA : cA + (size_t)(t + 2) * kstep; const char* b2 = last ? nB : cB + (size_t)(t + 2) * kstep;
            const char* a3 = a2 + kstep; const char* b3 = b2 + kstep;
            if (last && has_next) S.a_ready(nxt);
            if constexpr (SP2) {
            PG8_LDB(B0, 0, 0); PG8_LDB(B1, 0, 1); PG8_SCHED; PG8_LDA(At, 0, 0); PG8_STAGE(PG8_SA(1, 1), a1 + hstepA, voffA);
            PG8_WAIT_V(8); PG8_WAIT_L(0); PG8_BAR; PG8_MMA(0, 0, At, B0); PG8_MMA(0, 1, At, B1); PG8_BAR; PG8_SCHED;
            PG8_LDA(At, 0, 1); PG8_STAGE(PG8_SB(0, 0), b2, voffB); PG8_STAGE(PG8_SB(0, 1), b2 + hstepB, voffB); PG8_STAGE(PG8_SA(0, 0), a2, voffA);
            PG8_WAIT_V(8); PG8_WAIT_L(0); PG8_BAR; PG8_MMA(1, 0, At, B0); PG8_MMA(1, 1, At, B1); PG8_BAR; PG8_SCHED;
            PG8_LDB(B0, 1, 0); PG8_LDB(B1, 1, 1); PG8_SCHED; PG8_LDA(At, 1, 0); PG8_STAGE(PG8_SA(0, 1), a2 + hstepA, voffA);
            PG8_WAIT_V(8); PG8_WAIT_L(0); PG8_BAR; PG8_MMA(0, 0, At, B0); PG8_MMA(0, 1, At, B1); PG8_BAR; PG8_SCHED;
            PG8_LDA(At, 1, 1); PG8_STAGE(PG8_SB(1, 0), b3, voffB); PG8_STAGE(PG8_SB(1, 1), b3 + hstepB, voffB); PG8_STAGE(PG8_SA(1, 0), a3, voffA);
            PG8_WAIT_V(8); PG8_WAIT_L(0); PG8_BAR; PG8_MMA(1, 0, At, B0); PG8_MMA(1, 1, At, B1); PG8_BAR; PG8_SCHED;
            } else {
            PG8_LDB(B0, 0, 0); PG8_SCHED; PG8_LDA(At, 0, 0); PG8_STAGE(PG8_SA(1, 1), a1 + hstepA, voffA);
            PG8_WAIT_L(8); PG8_BAR; PG8_WAIT_L(0); PG8_MMA(0, 0, At, B0); PG8_BAR; PG8_SCHED;
            PG8_LDB(B1, 0, 1); PG8_STAGE(PG8_SB(0, 0), b2, voffB);
            PG8_BAR; PG8_WAIT_L(0); PG8_MMA(0, 1, At, B1); PG8_BAR;
            PG8_LDA(At, 0, 1); PG8_STAGE(PG8_SA(0, 0), a2, voffA);
            PG8_BAR; PG8_WAIT_L(0); PG8_MMA(1, 0, At, B0); PG8_BAR; PG8_SCHED;
            PG8_STAGE(PG8_SB(0, 1), b2 + hstepB, voffB);
            PG8_WAIT_V(6); PG8_BAR; PG8_MMA(1, 1, At, B1); PG8_BAR;
            PG8_LDB(B0, 1, 0); PG8_SCHED; PG8_LDA(At, 1, 0); PG8_STAGE(PG8_SA(0, 1), a2 + hstepA, voffA);
            PG8_WAIT_L(8); PG8_BAR; PG8_WAIT_L(0); PG8_MMA(0, 0, At, B0); PG8_BAR; PG8_SCHED;
            PG8_LDB(B1, 1, 1); PG8_STAGE(PG8_SB(1, 0), b3, voffB);
            PG8_BAR; PG8_WAIT_L(0); PG8_MMA(0, 1, At, B1); PG8_BAR;
            PG8_LDA(At, 1, 1); PG8_STAGE(PG8_SA(1, 0), a3, voffA);
            PG8_BAR; PG8_WAIT_L(0); PG8_MMA(1, 0, At, B0); PG8_BAR; PG8_SCHED;
            PG8_STAGE(PG8_SB(1, 1), b3 + hstepB, voffB);
            PG8_WAIT_V(6); PG8_BAR; PG8_MMA(1, 1, At, B1); PG8_BAR;
            }
        }
        if constexpr (ALIGN_EPI) { if (wr == 0) PG8_BAR; }
        if constexpr (!Epi::AFTER_DRAIN) { E(acc, cur, wr, wc, fr, fq); S.done(cur); }
        if (!has_next) break;
#pragma unroll
        for (int a = 0; a < 2; ++a)
#pragma unroll
            for (int b = 0; b < 2; ++b)
#pragma unroll
                for (int m = 0; m < 4; ++m)
#pragma unroll
                    for (int n = 0; n < 2; ++n) acc[a][b][m][n] = (f32x4){0.f, 0.f, 0.f, 0.f};
        cur = nxt; cA = nA; cB = nB; ++ui;
        if constexpr (ALIGN_EPI) { if (wr == 1) PG8_BAR; }
    }
    PG8_WAIT_V(0);
    if constexpr (!ALIGN_EPI) { if (wr == 0) PG8_BAR; }
    PG8_BAR;
    if constexpr (Epi::AFTER_DRAIN) { E.fused(acc, cur, wr, wc, fr, fq, lds, wid, lane); S.done(cur); }
#undef PG8_SA
#undef PG8_SB
#undef PG8_STAGE
#undef PG8_LDA
#undef PG8_LDB
#undef PG8_MMA
#undef PG8_WAIT_V
#undef PG8_WAIT_L
#undef PG8_BAR
#undef PG8_SCHED
}
}

namespace att {
typedef unsigned short bf16_t;
using bf16x8 = __attribute__((ext_vector_type(8))) short;
using s16x4  = __attribute__((ext_vector_type(4))) short;
using f32x16 = __attribute__((ext_vector_type(16))) float;
using u32x4  = __attribute__((ext_vector_type(4))) unsigned;
#define KSWZ(row, colB) ((row) * 256 + ((colB) ^ (((row) & 15) << 4)))
#define KSWZ64(row, colB) ((row) * 128 + ((colB) ^ ((((row) >> 1) & 7) << 4)))
#define SBAR() __builtin_amdgcn_sched_barrier(0)
__device__ __forceinline__ int crow(int r, int hi) { return (r & 3) + 8 * (r >> 2) + 4 * hi; }
__device__ __forceinline__ unsigned cvtpk(float lo, float hi) { unsigned r; asm volatile("v_cvt_pk_bf16_f32 %0, %1, %2" : "=v"(r) : "v"(lo), "v"(hi)); return r; }

__device__ __forceinline__ void partialSM(f32x16& p0, f32x16& p1, float& m_reg, float& alpha, const float C, const float THRS) {
  float pmax = p0[0];
#pragma unroll
  for (int r = 1; r < 16; ++r) pmax = fmaxf(pmax, p0[r]);
#pragma unroll
  for (int r = 0; r < 16; ++r) pmax = fmaxf(pmax, p1[r]);
  { auto rr = __builtin_amdgcn_permlane32_swap(__float_as_uint(pmax), __float_as_uint(pmax), false, false);
    pmax = fmaxf(__uint_as_float(rr[0]), __uint_as_float(rr[1])); }
  float mn;
  if (__builtin_expect(__all(pmax - m_reg <= THRS), 1)) { mn = m_reg; alpha = 1.f; }
  else { mn = fmaxf(m_reg, pmax); alpha = __builtin_amdgcn_exp2f((m_reg - mn) * C); m_reg = mn; }
  const float mnC = -mn * C;
#pragma unroll
  for (int r = 0; r < 16; ++r) p0[r] = fmaf(p0[r], C, mnC);
#pragma unroll
  for (int r = 0; r < 16; ++r) p1[r] = fmaf(p1[r], C, mnC);
#pragma unroll
  for (int r = 0; r < 16; ++r) p0[r] = __builtin_amdgcn_exp2f(p0[r]);
}
__device__ __forceinline__ void finishSM(f32x16& p0, f32x16& p1, float alpha, float& l_reg, bf16x8& pa0, bf16x8& pa1, bf16x8& pa2, bf16x8& pa3) {
#pragma unroll
  for (int r = 0; r < 16; ++r) p1[r] = __builtin_amdgcn_exp2f(p1[r]);
  float ps = 0;
#pragma unroll
  for (int r = 0; r < 16; ++r) ps += p0[r];
#pragma unroll
  for (int r = 0; r < 16; ++r) ps += p1[r];
  { auto rr = __builtin_amdgcn_permlane32_swap(__float_as_uint(ps), __float_as_uint(ps), false, false);
    ps = __uint_as_float(rr[0]) + __uint_as_float(rr[1]); }
  l_reg = l_reg * alpha + ps;
#define PK4(P, BASE, OUT) do { unsigned a0 = cvtpk(P[BASE + 0], P[BASE + 1]), a1 = cvtpk(P[BASE + 2], P[BASE + 3]);   \
    unsigned b0 = cvtpk(P[BASE + 4], P[BASE + 5]), b1 = cvtpk(P[BASE + 6], P[BASE + 7]);                              \
    auto r0 = __builtin_amdgcn_permlane32_swap(a0, b0, false, false); auto r1 = __builtin_amdgcn_permlane32_swap(a1, b1, false, false); \
    u32x4 w = {r0[0], r1[0], r0[1], r1[1]}; OUT = *reinterpret_cast<bf16x8*>(&w); } while (0)
  PK4(p0, 0, pa0); PK4(p0, 8, pa1); PK4(p1, 0, pa2); PK4(p1, 8, pa3);
#undef PK4
}
template <int DN>
__device__ __forceinline__ void qkt(f32x16& p0, f32x16& p1, const char* Kn, const char* Kr, const bf16x8* qr, const char* qrl, int r32, int hi) {
  p0 = f32x16{}; p1 = f32x16{};
  if constexpr (DN > 0) {
#pragma unroll
    for (int d0 = 0; d0 < DN / 16; ++d0) { const int cb = (d0 * 16 + hi * 8) * 2;
      bf16x8 b0 = *reinterpret_cast<const bf16x8*>(Kn + KSWZ(r32, cb));
      bf16x8 b1 = *reinterpret_cast<const bf16x8*>(Kn + KSWZ(32 + r32, cb));
      p0 = __builtin_amdgcn_mfma_f32_32x32x16_bf16(b0, qr[d0], p0, 0, 0, 0);
      p1 = __builtin_amdgcn_mfma_f32_32x32x16_bf16(b1, qr[d0], p1, 0, 0, 0); }
  }
#pragma unroll
  for (int d0 = 0; d0 < 4; ++d0) { const int cb = (d0 * 16 + hi * 8) * 2;
    bf16x8 b0 = *reinterpret_cast<const bf16x8*>(Kr + KSWZ64(r32, cb));
    bf16x8 b1 = *reinterpret_cast<const bf16x8*>(Kr + KSWZ64(32 + r32, cb));
    bf16x8 q; if constexpr (DN > 0) q = *reinterpret_cast<const bf16x8*>(qrl + d0 * 1024); else q = qr[d0];
    p0 = __builtin_amdgcn_mfma_f32_32x32x16_bf16(b0, q, p0, 0, 0, 0);
    p1 = __builtin_amdgcn_mfma_f32_32x32x16_bf16(b1, q, p1, 0, 0, 0); }
}
__device__ __forceinline__ void band_mask(f32x16& p0, f32x16& p1, int d) {
#pragma unroll
  for (int r = 0; r < 16; ++r) { const int v = d - ((r & 3) + 8 * (r >> 2));
    if (v > 128 || v < -128) p0[r] = -1e30f;
    if (v - 32 > 128 || v - 32 < -128) p1[r] = -1e30f; }
}
__device__ __forceinline__ int v_rd_base(int lane) { return ((lane & 3) << 3) | (((lane >> 2) & 3) << 6) | (((lane >> 4) & 1) << 5) | (((lane >> 5) & 1) << 8); }
template <int NCB> constexpr int v_rd_off(int d0, int ks, int half) { return d0 * 512 + ks * (2 * NCB * 512) + half * (NCB * 512); }
template <int OFF> __device__ __forceinline__ s16x4 tr_read(int vb) {
  s16x4 r; asm volatile("ds_read_b64_tr_b16 %0, %1 offset:%2" : "=&v"(r) : "v"(vb), "i"(OFF) : "memory"); return r;
}
template <int D0, int NCB> __device__ __forceinline__ void pv_one(f32x16& od, int vb, bf16x8 pa0, bf16x8 pa1, bf16x8 pa2, bf16x8 pa3) {
  const s16x4 l0 = tr_read<v_rd_off<NCB>(D0, 0, 0)>(vb), h0 = tr_read<v_rd_off<NCB>(D0, 0, 1)>(vb), l1 = tr_read<v_rd_off<NCB>(D0, 1, 0)>(vb), h1 = tr_read<v_rd_off<NCB>(D0, 1, 1)>(vb);
  const s16x4 l2 = tr_read<v_rd_off<NCB>(D0, 2, 0)>(vb), h2 = tr_read<v_rd_off<NCB>(D0, 2, 1)>(vb), l3 = tr_read<v_rd_off<NCB>(D0, 3, 0)>(vb), h3 = tr_read<v_rd_off<NCB>(D0, 3, 1)>(vb);
  asm volatile("s_waitcnt lgkmcnt(0)" ::: "memory"); SBAR();
#define PK(L, H) (bf16x8){L[0], L[1], L[2], L[3], H[0], H[1], H[2], H[3]}
  od = __builtin_amdgcn_mfma_f32_32x32x16_bf16(pa0, PK(l0, h0), od, 0, 0, 0);
  od = __builtin_amdgcn_mfma_f32_32x32x16_bf16(pa1, PK(l1, h1), od, 0, 0, 0);
  od = __builtin_amdgcn_mfma_f32_32x32x16_bf16(pa2, PK(l2, h2), od, 0, 0, 0);
  od = __builtin_amdgcn_mfma_f32_32x32x16_bf16(pa3, PK(l3, h3), od, 0, 0, 0);
#undef PK
}
template <int NCB> __device__ __forceinline__ void pv_all(f32x16* o, int vb, bf16x8 pa0, bf16x8 pa1, bf16x8 pa2, bf16x8 pa3) {
  pv_one<0, NCB>(o[0], vb, pa0, pa1, pa2, pa3); pv_one<1, NCB>(o[1], vb, pa0, pa1, pa2, pa3);
  if constexpr (NCB == 4) { pv_one<2, NCB>(o[2], vb, pa0, pa1, pa2, pa3); pv_one<3, NCB>(o[3], vb, pa0, pa1, pa2, pa3); }
}

#define ATT_LAS __attribute__((address_space(3)))
template <int DN, int DV, bool MASK>
__device__ __forceinline__ void attn_unit(const bf16_t* __restrict__ Qb, const int ldq, const bf16_t* __restrict__ Kn, const int ldkn,
    const bf16_t* __restrict__ Kr, const int ldkr, const bf16_t* __restrict__ Vp, const int ldv, bf16_t* __restrict__ Ob, const int ldo,
    const int NT, const int n1, const int r1, const int r2, const int qpos0, const int kt2,
    const float C, const float THRS, const float sinkl2, char* lds, ATT_LAS unsigned char* ldsL, const int wave_) {
  constexpr int NQR = DN > 0 ? DN / 16 : 4, NCB = DV / 32, VB = 64 * DV * 2, KNB = 64 * DN * 2, KRB = 64 * 64 * 2, BUF = VB + KNB + KRB;
  constexpr int NVC = VB / 8192, NKC = KNB / 8192;
  const int wid = wave_, lane = lane_id_v(), r32 = lane & 31, hi = lane >> 5;
  char* Vl = lds; char* Knl = lds + VB; char* Krl = lds + VB + KNB;
  float* wsf = (float*)(lds + 3 * BUF) + wid * 64; float* li_l = wsf; float* al_l = wsf + 32;
  float m_reg = -1e30f, l_reg = 0; f32x16 o[NCB] = {}; bf16x8 qr[NQR];
  const bf16_t* Qw = Qb + (MASK ? (long)r32 * ldq + wid * 64 : (long)(wid * 32 + r32) * ldq) + hi * 8;
#pragma unroll
  for (int d0 = 0; d0 < NQR; ++d0) qr[d0] = *reinterpret_cast<const bf16x8*>(Qw + d0 * 16);
  char* qrl = lds + 3 * BUF + 2048 + wid * 4096 + lane * 16;
  if constexpr (DN > 0) {
#pragma unroll
    for (int d0 = 0; d0 < 4; ++d0) *reinterpret_cast<bf16x8*>(qrl + d0 * 1024) = *reinterpret_cast<const bf16x8*>(Qw + DN + d0 * 16);
  }
  int offV[NVC], offK[NKC > 0 ? NKC : 1], offR;
#pragma unroll
  for (int i = 0; i < NVC; ++i) { const int ch = wid * NVC + i, sub = ch * 2 + (lane >> 5), kk = (sub / NCB) * 8 + ((lane & 31) >> 2), col = (sub % NCB) * 32 + (lane & 3) * 8;
    const int k = (kk & ~0xC) | ((kk & 4) << 1) | ((kk & 8) >> 1); offV[i] = k * ldv + col; }
#pragma unroll
  for (int i = 0; i < NKC; ++i) { const int ch = wid * NKC + i, row = ch * 4 + (lane >> 4), cb = ((lane & 15) * 16) ^ ((row & 15) << 4); offK[i] = row * ldkn + (cb >> 1); }
  { const int row = wid * 8 + (lane >> 3), cb = ((lane & 7) * 16) ^ (((row >> 1) & 7) << 4); offR = row * ldkr + (cb >> 1); }
  const int vb0 = (int)(uintptr_t)Vl + v_rd_base(lane);
  const int qd = qpos0 + (MASK ? 0 : wid * 32) + r32 - 4 * hi;
#define TROW(j) ((j) < n1 ? r1 + 64 * (j) : r2 + 64 * ((j) - n1))
#define DMA(j, b) do { const long row0_ = TROW(j); \
    _Pragma("unroll") for (int i_ = 0; i_ < NVC; ++i_) __builtin_amdgcn_global_load_lds((const unsigned*)(Vp + row0_ * ldv + offV[i_]), (ATT_LAS unsigned*)(ldsL + (b) + (wid * NVC + i_) * 1024), 16, 0, 0); \
    _Pragma("unroll") for (int i_ = 0; i_ < NKC; ++i_) __builtin_amdgcn_global_load_lds((const unsigned*)(Kn + row0_ * ldkn + offK[i_]), (ATT_LAS unsigned*)(ldsL + (b) + VB + (wid * NKC + i_) * 1024), 16, 0, 0); \
    __builtin_amdgcn_global_load_lds((const unsigned*)(Kr + row0_ * ldkr + offR), (ATT_LAS unsigned*)(ldsL + (b) + VB + KNB + wid * 1024), 16, 0, 0); } while (0)
#define WAITV() asm volatile("s_waitcnt vmcnt(0)" ::: "memory")
  const int q0w = qpos0 + (MASK ? 0 : wid * 32);
#define KP(j) (kt2 + 64 * ((j) - n1))
#define NEED(j) (!MASK || (j) < n1 || (KP(j) <= q0w + 159 && KP(j) + 63 >= q0w - 128))
#define SCORE(P0, P1, b, j) do { qkt<DN>(P0, P1, Knl + (b), Krl + (b), qr, qrl, r32, hi); \
    if constexpr (MASK) { if ((j) >= n1 && !(KP(j) >= q0w - 97 && KP(j) <= q0w + 65)) band_mask(P0, P1, qd - KP(j)); } } while (0)
#define RESC(a) do { if (__any((a) < 1.f)) { const int l_ = lane_id_v(); if (l_ < 32) al_l[l_] = (a); asm volatile("s_waitcnt lgkmcnt(0)" ::: "memory"); \
    _Pragma("unroll") for (int d = 0; d < NCB; ++d) _Pragma("unroll") for (int r = 0; r < 16; ++r) o[d][r] *= al_l[crow(r, l_ >> 5)]; } } while (0)
#define ROT() do { const int t_ = bp; bp = bc; bc = bn; bn = t_; } while (0)
  f32x16 pA0, pA1, pB0, pB1; float alA, alB; bf16x8 pa0, pa1, pa2, pa3;
  int bp = 0, bc = BUF, bn = 2 * BUF;
  DMA(0, 0); DMA(1, BUF); WAITV(); __syncthreads();
  SCORE(pA0, pA1, 0, 0); partialSM(pA0, pA1, m_reg, alA, C, THRS);
  bool nA = true, nB = true;
  for (int j = 1; j + 1 < NT; j += 2) {
    DMA(j + 1, bn);
    nB = NEED(j);
    SBAR(); if (nB) SCORE(pB0, pB1, bc, j);
    if (nA) finishSM(pA0, pA1, alA, l_reg, pa0, pa1, pa2, pa3); SBAR();
    if (nA) pv_all<NCB>(o, vb0 + bp, pa0, pa1, pa2, pa3);
    if (nB) { partialSM(pB0, pB1, m_reg, alB, C, THRS); RESC(alB); }
    WAITV(); __syncthreads(); ROT();
    DMA(j + 2, bn);
    nA = NEED(j + 1);
    SBAR(); if (nA) SCORE(pA0, pA1, bc, j + 1);
    if (nB) finishSM(pB0, pB1, alB, l_reg, pa0, pa1, pa2, pa3); SBAR();
    if (nB) pv_all<NCB>(o, vb0 + bp, pa0, pa1, pa2, pa3);
    if (nA) { partialSM(pA0, pA1, m_reg, alA, C, THRS); RESC(alA); }
    WAITV(); __syncthreads(); ROT();
  }
  nB = NEED(NT - 1);
  SBAR(); if (nB) SCORE(pB0, pB1, bc, NT - 1);
  if (nA) finishSM(pA0, pA1, alA, l_reg, pa0, pa1, pa2, pa3); SBAR();
  if (nA) pv_all<NCB>(o, vb0 + bp, pa0, pa1, pa2, pa3);
  if (nB) { partialSM(pB0, pB1, m_reg, alB, C, THRS);
    RESC(alB);
    finishSM(pB0, pB1, alB, l_reg, pa0, pa1, pa2, pa3); SBAR();
    pv_all<NCB>(o, vb0 + bc, pa0, pa1, pa2, pa3); }
  l_reg += __builtin_amdgcn_exp2f(sinkl2 - m_reg * C);
  const int lane2 = lane_id_v(), r32e = lane2 & 31, hie = lane2 >> 5;
  if (hie == 0) li_l[r32e] = l_reg; asm volatile("s_waitcnt lgkmcnt(0)" ::: "memory");
  float rli[16];
#pragma unroll
  for (int r = 0; r < 16; ++r) rli[r] = __builtin_amdgcn_rcpf(li_l[crow(r, hie)]);
  bf16_t* Ow = Ob + (MASK ? (long)(wid * 64) : (long)(wid * 32) * ldo);
#pragma unroll
  for (int r = 0; r < 16; ++r) { const int orow = crow(r, hie);
#pragma unroll
    for (int d0 = 0; d0 < NCB; ++d0) Ow[(long)orow * ldo + d0 * 32 + r32e] = (bf16_t)(cvtpk(o[d0][r] * rli[r], 0.f) & 0xffffu); }
  __syncthreads();
#undef TROW
#undef DMA
#undef WAITV
#undef SCORE
#undef RESC
#undef ROT
#undef KP
#undef NEED
}
}

constexpr size_t MiB = 1u << 20;
constexpr size_t WS_MOD = 0;
constexpr size_t WS_SSQ = 512 * 1024;
constexpr size_t WS_ROPE = 1792 * 1024;
constexpr size_t CTL_ZERO_BYTES = 2 * MiB;
constexpr size_t WS_XC = 2 * MiB;
constexpr size_t WS_WIN = 8 * MiB, WS_WQB = 13 * MiB, WS_WKVB = 16 * MiB, WS_WOM = 20 * MiB, WS_WF1 = 28 * MiB, WS_WF2 = 92 * MiB, WS_WQKV = 156 * MiB, WS_WOS = 166 * MiB;
constexpr size_t WS_S1 = 176 * MiB;
constexpr size_t WS_S2 = 306 * MiB;
constexpr size_t WS_G = 436 * MiB;
constexpr size_t WS_Q = WS_G, WS_KV = WS_G + 196 * MiB, WS_KR = WS_G + 456 * MiB;
constexpr size_t WS_PART = WS_G + 520 * MiB;
constexpr size_t WS_END = WS_PART + 64 * MiB;
static_assert((size_t)NROW * 2048 * 2 == 130 * MiB && WS_SSQ + 8 * (size_t)NROW * 4 <= WS_ROPE && (size_t)NROW * NQ * 2 <= 196 * MiB && (size_t)NROW * NKV * 2 <= 260 * MiB, "ws map");

#define LAS __attribute__((address_space(3)))
typedef unsigned short bf16_t;
typedef float f32x4 __attribute__((ext_vector_type(4)));
typedef unsigned u32x4 __attribute__((ext_vector_type(4)));
typedef unsigned u32x2 __attribute__((ext_vector_type(2)));
constexpr int LDS_BYTES = 3 * 40960 + 2048 + 32768;
constexpr int N_PHASES = 17;
#ifndef PROBE_PH
#define PROBE_PH -1
#endif
#ifndef PROBE_PH2
#define PROBE_PH2 -1
#endif
#if PROBE_PH >= 0
#define rep_PROBE0 (rep_ != 0)
#define REP(k) for (int rep_ = 0; rep_ < ((((PROBE_PH) >> (k)) & 1) ? 2 : 1); ++rep_)
#define SSQP(i) (rep_ ? SSQ + 6 * NROW : SSQ + (i) * NROW)
#else
#define rep_PROBE0 false
#define REP(k)
#define SSQP(i) (SSQ + (i) * NROW)
#endif

struct Args { const float* in[18]; float* out; unsigned char* ws; int ph_lo, ph_hi; };

__device__ __forceinline__ float wave_sum(float v) {
#pragma unroll
  for (int o = 1; o < 64; o <<= 1) v += __shfl_xor(v, o);
  return v;
}
__device__ __forceinline__ unsigned pk2(float lo, float hi) { unsigned r; asm volatile("v_cvt_pk_bf16_f32 %0, %1, %2" : "=v"(r) : "v"(lo), "v"(hi)); return r; }

__device__ __forceinline__ int dest_row(int mode, int n) {
  if (mode == 1) { if (n < 1024) return n; const int j = n - 1024; return 1024 + (((j & 31) << 1) | (j >> 5)); }
  if (mode == 2) { const int h = n / 192, d = n - h * 192; if (d < 128) return n; const int j = d - 128; return h * 192 + 128 + (((j & 31) << 1) | (j >> 5)); }
  if (mode == 3) { if (n >= 2304) return n; const int d = n & 63; return (n & ~63) + (((d & 31) << 1) | (d >> 5)); }
  return n;
}
__device__ __forceinline__ void tr_item(const float* __restrict__ W, int K, int N, bf16_t* __restrict__ WT, const float* __restrict__ ks, int mode, LAS float* scr, int item, int lane) {
  const int nblk = N / 32, kb = item / nblk, nb = item - kb * nblk, k0 = 64 * kb, n0 = 32 * nb;
  float wv[32];
#pragma unroll
  for (int i = 0; i < 32; ++i) wv[i] = W[(size_t)(k0 + 2 * i + (lane >> 5)) * N + n0 + (lane & 31)];
  if (ks) {
#pragma unroll
    for (int i = 0; i < 32; ++i) wv[i] *= ks[k0 + 2 * i + (lane >> 5)];
  }
#pragma unroll
  for (int i = 0; i < 32; ++i) scr[(2 * i + (lane >> 5)) * 33 + (lane & 31)] = wv[i];
  asm volatile("s_waitcnt lgkmcnt(0)" ::: "memory");
  const int c = lane & 7;
#pragma unroll
  for (int j = 0; j < 4; ++j) { const int n = (lane >> 3) + 8 * j; const LAS float* s = scr + (8 * c) * 33 + n;
    u32x4 o; o.x = pk2(s[0 * 33], s[1 * 33]); o.y = pk2(s[2 * 33], s[3 * 33]); o.z = pk2(s[4 * 33], s[5 * 33]); o.w = pk2(s[6 * 33], s[7 * 33]);
    *(u32x4*)(WT + (size_t)dest_row(mode, n0 + n) * K + k0 + 8 * c) = o; }
  asm volatile("s_waitcnt lgkmcnt(0)" ::: "memory");
}

__device__ __forceinline__ float silu_f(float x) { return x / (1.f + __expf(-x)); }

constexpr int TI0 = 32 * 34, TI1 = 8 * 96, TI2 = 8 * 128, TI3 = 32 * 64, TI4 = 32 * 256, TI6 = 128 * 64, TI8 = 32 * 80, TI9 = 32 * 64;
constexpr int N_EARLY = TI0 + TI1 + TI2, N_LATE = TI3 + 2 * TI4 + 2 * TI6 + TI8 + TI9;
__device__ __forceinline__ void tr_dispatch(const Args& a, int it  , LAS float* scr, int lane) {
  unsigned char* ws = a.ws;
  int r = it; const float* W; int K, N, mode = 0; const float* ks = nullptr; bf16_t* dst;
  if (r < TI0) { W = a.in[9]; K = 2048; N = 1088; mode = 1; dst = (bf16_t*)(ws + WS_WIN); }
  else if ((r -= TI0) < TI1) { W = a.in[12]; K = 512; N = 3072; mode = 2; ks = a.in[10]; dst = (bf16_t*)(ws + WS_WQB); }
  else if ((r -= TI1) < TI2) { W = a.in[13]; K = 512; N = 4096; ks = a.in[11]; dst = (bf16_t*)(ws + WS_WKVB); }
  else if ((r -= TI2) < TI3) { W = a.in[14]; K = 2048; N = 2048; dst = (bf16_t*)(ws + WS_WOM); }
  else if ((r -= TI3) < 2 * TI4) { const int l = r / TI4; r -= l * TI4; W = a.in[7] + (size_t)l * 2048 * 8192; K = 2048; N = 8192; dst = (bf16_t*)(ws + WS_WF1) + (size_t)l * 2048 * 8192; }
  else if ((r -= 2 * TI4) < 2 * TI6) { const int l = r / TI6; r -= l * TI6; W = a.in[8] + (size_t)l * 2048 * 8192; K = 8192; N = 2048; dst = (bf16_t*)(ws + WS_WF2) + (size_t)l * 2048 * 8192; }
  else if ((r -= 2 * TI6) < TI8) { W = a.in[15]; K = 2048; N = 2560; mode = 3; dst = (bf16_t*)(ws + WS_WQKV); }
  else { r -= TI8; W = a.in[17]; K = 2048; N = 2048; dst = (bf16_t*)(ws + WS_WOS); }
  tr_item(W, K, N, dst, ks, mode, scr, r, lane);
}

__device__ __forceinline__ void p0_prologue(const Args& a, LAS unsigned char* lds, int gw, int NGW, int wave, int lane, bool only_transposes) {
  unsigned char* ws = a.ws;
  LAS float* scr = (LAS float*)(lds + wave * 16384);
  for (int it = gw; it < N_EARLY + N_LATE; it += NGW) tr_dispatch(a, it, scr, lane);
  if (only_transposes) return;
  float* MOD = (float*)(ws + WS_MOD);
  for (int it = gw; it < 2 * 48 * 64; it += NGW) {
    const int kc = it & 63, cb = (it >> 6) % 48, l = it / (64 * 48);
    const int n0 = cb * 256 + lane * 4, k0 = kc * 32;
    const float* Wm = a.in[4] + (size_t)l * 2048 * 12288 + n0;
    f32x4 a0 = {0.f, 0.f, 0.f, 0.f}, a1 = a0, a2 = a0;
#pragma unroll 16
    for (int k = 0; k < 32; ++k) { const int kk = k0 + k;
      const float s0 = silu_f(a.in[1][kk]), s1 = silu_f(a.in[1][2048 + kk]), s2 = silu_f(a.in[3][kk]);
      const f32x4 w = *(const f32x4*)(Wm + (size_t)kk * 12288);
      a0 += w * s0; a1 += w * s1; a2 += w * s2; }
    if (kc == 0) { const f32x4 b = *(const f32x4*)(a.in[5] + l * 12288 + n0); a0 += b; a1 += b; a2 += b; }
    float* mo = MOD + (size_t)(l * 3) * 12288 + n0;
#pragma unroll
    for (int e = 0; e < 4; ++e) { atomicAdd(mo + e, a0[e]); atomicAdd(mo + 12288 + e, a1[e]); atomicAdd(mo + 2 * 12288 + e, a2[e]); }
  }
  float* tab = (float*)(ws + WS_ROPE);
  for (int e = gw * 64 + lane; e < 320 * 16; e += NGW * 64) {
    const int i = e & 15, pos = e >> 4; const float p = (float)(pos < 256 ? pos : pos - 256);
    const float freq = exp2f(-(float)i * 0.8304820237218406f); const float ang = p * freq;
    tab[e * 2] = cosf(ang); tab[e * 2 + 1] = sinf(ang);
  }
}

__device__ __forceinline__ f32x4 ldf4(const float* base, unsigned boff) { return *(const f32x4*)((const char*)base + boff); }
__device__ __forceinline__ void stf4(float* base, unsigned boff, f32x4 v) { *(f32x4*)((char*)base + boff) = v; }
__device__ __forceinline__ f32x4 ldf4s(const float* base, unsigned boff) { return __builtin_nontemporal_load((const f32x4*)((const char*)base + boff)); }
__device__ __forceinline__ void stf4s(float* base, unsigned boff, f32x4 v) { __builtin_nontemporal_store(v, (f32x4*)((char*)base + boff)); }
template <bool UPD, bool DOH, int NKC>
__device__ __forceinline__ void norm_rows(const int row0, const int nrows, const float* xin_lat, const float* xin_ctx, float* xout_lat, float* xout_ctx, const bf16_t* Y, const float* ssq,
    const float* gA, const float* gateM, const float* gB, const float* scM, const float* shM, bf16_t* H, int lane, const float* part) {
  const int b = row0 / TB, rb = row0 - b * TB; const bool isctx = rb < CTXL;
  const int v = isctx ? 2 : b;
  const size_t xoff = isctx ? (size_t)(b * CTXL + rb) * DM : (size_t)(b * SEQ + rb - CTXL) * DM;
  const float* xin = (isctx ? xin_ctx : xin_lat) + xoff;
  float* xout = UPD ? ((isctx ? xout_ctx : xout_lat) + xoff) : nullptr;
  const int lane_ = lane_id_v();
  const unsigned lo = (unsigned)lane_ * 16u, lo2 = (unsigned)lane_ * 8u;
  f32x4 GA[8], GB[8], SH[8];
#pragma unroll
  for (int j = 0; j < 8; ++j) { const unsigned o = lo + 1024u * j;
    if (UPD) GA[j] = ldf4(gateM + v * 12288, o) * ldf4(gA, o);
    if (DOH) { GB[j] = ldf4(gB, o) * (ldf4(scM + v * 12288, o) + 1.0f); SH[j] = ldf4(shM + v * 12288, o); } }
  f32x4 xn[8]; u32x2 yn[8];
#pragma unroll
  for (int j = 0; j < 8; ++j) { xn[j] = ldf4s(xin, lo + 1024u * j); if (UPD && !(NKC > 0 && isctx)) yn[j] = __builtin_nontemporal_load((const u32x2*)((const char*)(Y + (size_t)row0 * DM) + lo2 + 512u * j)); }
  for (int rr = 0; rr < nrows; ++rr) {
    const int row = row0 + rr;
    f32x4 x[8]; u32x2 yc[8];
#pragma unroll
    for (int j = 0; j < 8; ++j) { x[j] = xn[j]; if (UPD) yc[j] = yn[j]; }
    if (rr + 1 < nrows) { const float* xr = xin + (size_t)(rr + 1) * DM;
#pragma unroll
      for (int j = 0; j < 8; ++j) { xn[j] = ldf4s(xr, lo + 1024u * j); if (UPD && !(NKC > 0 && isctx)) yn[j] = __builtin_nontemporal_load((const u32x2*)((const char*)(Y + (size_t)(row + 1) * DM) + lo2 + 512u * j)); } }
    if (UPD && NKC > 0 && isctx) {
      f32x4 y[8]; float ys = 0.f; const float* pr = part + (size_t)(b * CTXL + rb + rr) * DM;
#pragma unroll
      for (int j = 0; j < 8; ++j) y[j] = ldf4(pr, lo + 1024u * j);
#pragma unroll 1
      for (int k = 1; k < NKC; ++k) { pr += (size_t)512 * DM;
#pragma unroll
        for (int j = 0; j < 8; ++j) y[j] += ldf4(pr, lo + 1024u * j); }
#pragma unroll
      for (int j = 0; j < 8; ++j) ys += (y[j][0] * y[j][0] + y[j][1] * y[j][1]) + (y[j][2] * y[j][2] + y[j][3] * y[j][3]);
      const float rinv = __builtin_amdgcn_rsqf(wave_sum(ys) * (1.0f / 2048.0f) + NORM_EPS);
      float* xo = xout + (size_t)rr * DM;
#pragma unroll
      for (int j = 0; j < 8; ++j) { x[j] += GA[j] * (y[j] * rinv); stf4s(xo, lo + 1024u * j, x[j]); }
    } else if (UPD) {
      const float rinv = __builtin_amdgcn_rsqf(ssq[row] * (1.0f / 2048.0f) + NORM_EPS);
      float* xo = xout + (size_t)rr * DM;
#pragma unroll
      for (int j = 0; j < 8; ++j) { const u32x2 yb = yc[j];
        f32x4 y; y[0] = __uint_as_float(yb.x << 16); y[1] = __uint_as_float(yb.x & 0xffff0000u); y[2] = __uint_as_float(yb.y << 16); y[3] = __uint_as_float(yb.y & 0xffff0000u);
        x[j] += GA[j] * (y * rinv);
        stf4s(xo, lo + 1024u * j, x[j]); }
    }
    if (DOH) {
      float ss = 0.f;
#pragma unroll
      for (int j = 0; j < 8; ++j) ss += (x[j][0] * x[j][0] + x[j][1] * x[j][1]) + (x[j][2] * x[j][2] + x[j][3] * x[j][3]);
      const float r = __builtin_amdgcn_rsqf(wave_sum(ss) * (1.0f / 2048.0f) + NORM_EPS);
      bf16_t* hr = H + (size_t)row * DM;
#pragma unroll
      for (int j = 0; j < 8; ++j) { const f32x4 h = x[j] * r * GB[j] + SH[j]; u32x2 w; w.x = pk2(h[0], h[1]); w.y = pk2(h[2], h[3]);
        *(u32x2*)((char*)hr + lo2 + 512u * j) = w; }
    }
  }
}
template <bool UPD, bool DOH, int NKC = 0>
__device__ __forceinline__ void norm_phase(const float* xin_lat, const float* xin_ctx, float* xout_lat, float* xout_ctx, const bf16_t* Y, const float* ssq,
    const float* gA, const float* gateM, const float* gB, const float* scM, const float* shM, bf16_t* H, bool skipctx, int gw, int NGW, int lane, const float* part = nullptr) {
  for (int ch = gw; ch < 2 * SEQ / 16; ch += NGW) { const int b = ch / (SEQ / 16), row0 = b * TB + CTXL + (ch - b * (SEQ / 16)) * 16;
    norm_rows<UPD, DOH, 0>(row0, 16, xin_lat, xin_ctx, xout_lat, xout_ctx, Y, ssq, gA, gateM, gB, scM, shM, H, lane, part); }
  if (!skipctx)
    for (int r = gw; r < 2 * CTXL; r += NGW) { const int b = r / CTXL, row0 = b * TB + (r - b * CTXL);
      norm_rows<UPD, DOH, NKC>(row0, 1, xin_lat, xin_ctx, xout_lat, xout_ctx, Y, ssq, gA, gateM, gB, scM, shM, H, lane, part); }
}

__global__ void __launch_bounds__(512, 2) mk_fwd(Args a) {
  extern __shared__ __attribute__((aligned(16))) unsigned char lds[];
  cg::grid_group grid = cg::this_grid();
  const int wave = __builtin_amdgcn_readfirstlane(threadIdx.x >> 6);
  const int G = gridDim.x, c = blockIdx.x, gw = c * 8 + wave, NGW = G * 8;
  LAS unsigned char* ldsL = (LAS unsigned char*)lds;
  unsigned char* ws = a.ws;
  const int lo = a.ph_lo, hi = a.ph_hi;
#define IN(k) (lo <= (k) && (k) < hi)
  unsigned* barw = (unsigned*)(ws + CTL_ZERO_BYTES - 256); unsigned bar_epoch = 0;
#define OWN_BAR() do { __builtin_amdgcn_fence(__ATOMIC_RELEASE, "workgroup"); __builtin_amdgcn_s_barrier(); bar_epoch += (unsigned)G; \
    if (wave == 0) { if (lane_id_v() == 0) { __builtin_amdgcn_fence(__ATOMIC_ACQUIRE, "workgroup"); __builtin_amdgcn_fence(__ATOMIC_RELEASE, "agent"); \
      __hip_atomic_fetch_add(barw, 1u, __ATOMIC_RELAXED, __HIP_MEMORY_SCOPE_AGENT); \
      while (__hip_atomic_load(barw, __ATOMIC_RELAXED, __HIP_MEMORY_SCOPE_AGENT) < bar_epoch) __builtin_amdgcn_s_sleep(1); \
      __builtin_amdgcn_fence(__ATOMIC_ACQUIRE, "agent"); __builtin_amdgcn_fence(__ATOMIC_RELEASE, "workgroup"); } } \
    __builtin_amdgcn_s_barrier(); __builtin_amdgcn_fence(__ATOMIC_ACQUIRE, "workgroup"); } while (0)
#define SEAM(k) do { if (IN(k) && IN((k) + 1)) { if ((k) == 0) grid.sync(); else { OWN_BAR(); if ((PROBE_PH >> 20) & 1) OWN_BAR(); } } } while (0)
  float* MOD = (float*)(ws + WS_MOD); float* SSQ = (float*)(ws + WS_SSQ);
  const float* RT = (const float*)(ws + WS_ROPE); const float* CT = RT + 256 * 16 * 2;
  float* XC = (float*)(ws + WS_XC); float* PART = (float*)(ws + WS_PART);
  bf16_t* S1 = (bf16_t*)(ws + WS_S1); bf16_t* S2 = (bf16_t*)(ws + WS_S2);
  bf16_t* Qb = (bf16_t*)(ws + WS_Q); bf16_t* KVb = (bf16_t*)(ws + WS_KV); bf16_t* KRb = (bf16_t*)(ws + WS_KR); bf16_t* Gb = (bf16_t*)(ws + WS_G);
  const float* gn = a.in[6];
#define MODP(l, chunk) (MOD + (size_t)(l) * 3 * 12288 + (chunk) * 2048)
#define RUN_GEMM(MODE, Ap, lda_, Bp, N_, K_, skip, ...) do { pg8::Gemm g{Ap, Bp, NROW, N_, K_, lda_, K_}; pg8::RowSched S; S.init((skip) ? 128 : 130, (N_) / 256, G, c, (skip) ? 1 : 0, (K_) == DFF ? 1 : 0); \
    pg8::Epi<MODE> E{__VA_ARGS__}; pg8::gemm_phase<pg8::Epi<MODE>, pg8::RowSched, true, true>(ldsL, g, S, E, wave); } while (0)
#define RUN_CTX_SPLIT(Ap, Bp, K_, NKC_) do { pg8::Gemm g{Ap, Bp, NROW, 2048, (K_) / (NKC_), K_, K_}; pg8::CtxSplitSched S; S.init(8, NKC_, G, c); \
    pg8::Epi<6> E{nullptr, 2048, nullptr, nullptr, nullptr, RT, CT, PART}; pg8::gemm_phase<pg8::Epi<6>, pg8::CtxSplitSched, true, true>(ldsL, g, S, E, wave); } while (0)

  if (IN(0)) { REP(0) p0_prologue(a, ldsL, gw, NGW, wave, lane_id_v(), rep_PROBE0); __syncthreads(); } SEAM(0);
  if (IN(1)) REP(1) norm_phase<false, true>(a.in[0], a.in[2], nullptr, nullptr, nullptr, nullptr, nullptr, nullptr, gn + 0 * 2048, MODP(0, 1), MODP(0, 0), S1, false, gw, NGW, lane_id_v());
  SEAM(1);
  if (IN(2)) REP(2) RUN_GEMM(1, S1, 2048, (const bf16_t*)(ws + WS_WIN), NP1, 2048, false, S2, NP1, SSQP(0), nullptr, KRb, RT, CT);
  SEAM(2);
  if (IN(3)) REP(3) {
    RUN_GEMM(2, S2, NP1, (const bf16_t*)(ws + WS_WQB), NQ, 512, false, Qb, NQ, nullptr, SSQ, nullptr, RT, CT);
    RUN_GEMM(3, S2 + 512, NP1, (const bf16_t*)(ws + WS_WKVB), NKV, 512, false, KVb, NKV, nullptr, SSQ + NROW, nullptr, RT, CT);
  }
  SEAM(3);
  if (IN(4)) REP(4) {
    const float SC = 0.07216878364870322f, Cc = SC * 1.4426950408889634f, THRS = 8.f / SC;
    for (int r = 0;; ++r) {
      const int u = c + r * G; if (u >= 2080) break;
      int b, h, rowq, NT;
      if (u < 2048) { int pair, qb; if (G == 256) { pair = (c & 7) * 4 + (r >> 1); qb = (c >> 3) + 32 * (r & 1); } else { pair = u >> 6; qb = u & 63; }
        b = pair >> 4; h = pair & 15; rowq = b * TB + CTXL + qb * 256; NT = TB / 64; }
      else { const int p = u - 2048; b = p >> 4; h = p & 15; rowq = b * TB; NT = CTXL / 64; }
      att::attn_unit<128, 128, false>(Qb + (size_t)rowq * NQ + h * 192, NQ, KVb + h * 256, NKV, KRb, 64, KVb + h * 256 + 128, NKV, S1 + (size_t)rowq * DM + h * 128, DM,
                                      NT, NT, b * TB, 0, 0, 0, Cc, THRS, -INFINITY, (char*)lds, ldsL, wave);
    }
  }
  SEAM(4);
  if (IN(5)) REP(5) { RUN_GEMM(0, S1, 2048, (const bf16_t*)(ws + WS_WOM), 2048, 2048, true, S2, 2048, SSQP(2), nullptr, nullptr, RT, CT);
    RUN_CTX_SPLIT(S1, (const bf16_t*)(ws + WS_WOM), 2048, 8); }
  SEAM(5);
  if (IN(6)) norm_phase<true, true, 8>(a.in[0], a.in[2], a.out, XC, S2, SSQ + 2 * NROW, gn + 1 * 2048, MODP(0, 2), gn + 2 * 2048, MODP(0, 4), MODP(0, 3), S1, false, gw, NGW, lane_id_v(), PART);
  SEAM(6);
  if (IN(7)) REP(7) RUN_GEMM(4, S1, 2048, (const bf16_t*)(ws + WS_WF1), DFF, 2048, false, Gb, DFF, nullptr, nullptr, nullptr, RT, CT);
  SEAM(7);
  if (IN(8)) REP(8) { RUN_GEMM(0, Gb, DFF, (const bf16_t*)(ws + WS_WF2), 2048, DFF, true, S2, 2048, SSQP(3), nullptr, nullptr, RT, CT);
    RUN_CTX_SPLIT(Gb, (const bf16_t*)(ws + WS_WF2), DFF, 16); }
  SEAM(8);
  if (IN(9)) norm_phase<true, true, 16>(a.out, XC, a.out, XC, S2, SSQ + 3 * NROW, gn + 3 * 2048, MODP(0, 5), gn + 4 * 2048, MODP(1, 1), MODP(1, 0), S1, false, gw, NGW, lane_id_v(), PART);
  SEAM(9);
  if (IN(10)) REP(10) RUN_GEMM(5, S1, 2048, (const bf16_t*)(ws + WS_WQKV), NQKV, 2048, false, Gb, NQKV, nullptr, nullptr, nullptr, RT, CT);
  SEAM(10);
  if (IN(11)) REP(11) {
    const float SC = 0.125f, Cc = SC * 1.4426950408889634f, THRS = 8.f / SC;
    for (int u = c; u < 4096; u += G) {
      const int pairkv = u >> 9, qb32 = u & 511, b = pairkv >> 2, kvh = pairkv & 3, t0 = qb32 * 32;
      int f = (t0 - 128) < 0 ? 0 : (t0 - 128) >> 6, l = (t0 + 159) >> 6; if (l > SEQ / 64 - 1) l = SEQ / 64 - 1;
      if ((l - f + 1) & 1) { if (l < SEQ / 64 - 1) ++l; else --f; }
      const int nwin = l - f + 1, tstart = 64 * f;
      const int rowq = b * TB + CTXL + t0;
      att::attn_unit<0, 64, true>(Gb + (size_t)rowq * NQKV + kvh * 512, NQKV, nullptr, 0, Gb + 2048 + kvh * 64, NQKV, Gb + 2304 + kvh * 64, NQKV, S1 + (size_t)rowq * DM + kvh * 512, DM,
                                  4 + nwin, 4, b * TB, b * TB + CTXL + tstart, t0, tstart, Cc, THRS, a.in[16][kvh * 8 + wave] * 1.4426950408889634f, (char*)lds, ldsL, wave);
    }
  }
  SEAM(11);
  if (IN(12)) REP(12) RUN_GEMM(0, S1, 2048, (const bf16_t*)(ws + WS_WOS), 2048, 2048, true, S2, 2048, SSQP(4), nullptr, nullptr, RT, CT);
  SEAM(12);
  if (IN(13)) norm_phase<true, true>(a.out, XC, a.out, XC, S2, SSQ + 4 * NROW, gn + 5 * 2048, MODP(1, 2), gn + 6 * 2048, MODP(1, 4), MODP(1, 3), S1, true, gw, NGW, lane_id_v());
  SEAM(13);
  if (IN(14)) REP(14) RUN_GEMM(4, S1, 2048, (const bf16_t*)(ws + WS_WF1) + (size_t)2048 * 8192, DFF, 2048, true, Gb, DFF, nullptr, nullptr, nullptr, RT, CT);
  SEAM(14);
  if (IN(15)) REP(15) RUN_GEMM(0, Gb, DFF, (const bf16_t*)(ws + WS_WF2) + (size_t)2048 * 8192, 2048, DFF, true, S2, 2048, SSQP(5), nullptr, nullptr, RT, CT);
  SEAM(15);
  if (IN(16)) norm_phase<true, false>(a.out, XC, a.out, XC, S2, SSQ + 5 * NROW, gn + 7 * 2048, MODP(1, 5), nullptr, nullptr, nullptr, nullptr, true, gw, NGW, lane_id_v());
#undef IN
#undef SEAM
}

extern "C" void kernel_launch(void* const* d_in, const int* in_sizes, int n_in, void* d_out, int out_size, void* d_ws, size_t ws_size, hipStream_t stream) {
  static int grid = 0;
  if (grid == 0) {
    if (n_in != 18 || out_size != 2 * SEQ * DM || ws_size < WS_END) { fprintf(stderr, "kernel_launch: unexpected shapes: n_in %d out %d ws %zu (need %zu)\n", n_in, out_size, ws_size, (size_t)WS_END); grid = -1; return; }
    int dev = 0, cus = 0, per_cu = 0;
    hipGetDevice(&dev); hipDeviceGetAttribute(&cus, hipDeviceAttributeMultiprocessorCount, dev);
    if (hipFuncSetAttribute((const void*)mk_fwd, hipFuncAttributeMaxDynamicSharedMemorySize, LDS_BYTES) != hipSuccess) { fprintf(stderr, "kernel_launch: hipFuncSetAttribute failed\n"); grid = -1; return; }
    if (hipOccupancyMaxActiveBlocksPerMultiprocessor(&per_cu, (const void*)mk_fwd, 512, LDS_BYTES) != hipSuccess || per_cu < 1) { fprintf(stderr, "kernel_launch: occupancy query gave %d\n", per_cu); per_cu = 1; }
    (void)hipGetLastError();
    grid = cus * per_cu;
    fprintf(stderr, "kernel_launch: grid %d (cus %d x %d)\n", grid, cus, per_cu);
  }
  if (grid < 0) return;
  hipMemsetAsync((char*)d_ws, 0, CTL_ZERO_BYTES, stream);
  Args a{};
  for (int i = 0; i < 18; ++i) a.in[i] = (const float*)d_in[i];
  a.out = (float*)d_out; a.ws = (unsigned char*)d_ws; a.ph_lo = 0; a.ph_hi = N_PHASES;
  void* args[] = {&a};
  hipError_t e = hipLaunchCooperativeKernel((const void*)mk_fwd, dim3(grid), dim3(512), args, LDS_BYTES, stream);
  if (e != hipSuccess) fprintf(stderr, "kernel_launch: cooperative launch failed: %s (grid %d)\n", hipGetErrorString(e), grid);
}
```

```cpp
#include <hip/hip_runtime.h>
#include <hip/hip_cooperative_groups.h>
#include <cstdio>
#include <cstdint>
namespace cg = cooperative_groups;

constexpr int DM = 2048, SEQ = 16384, CTXL = 256, TB = SEQ + CTXL  , NROW = 2 * TB  , DFF = 8192;
constexpr int NP1 = 1280  , NQ = 3072, NKV = 4096, NQKV = 2560;
constexpr float NORM_EPS = 1e-6f;
__device__ __forceinline__ int lane_id_v() { int l; asm volatile("v_mbcnt_lo_u32_b32 %0, -1, 0\n\tv_mbcnt_hi_u32_b32 %0, -1, %0" : "=v"(l)); return l; }
namespace pg8 {
#define PG8_LAS __attribute__((address_space(3)))
typedef unsigned short bf16_t;
typedef short bf16x8 __attribute__((ext_vector_type(8)));
typedef float f32x4 __attribute__((ext_vector_type(4)));
typedef unsigned u32x4 __attribute__((ext_vector_type(4)));
constexpr int BM = 256, BK = 64, HALF = 128, HTB = HALF * BK * 2  , STAGE_BYTES = 8 * HTB, NXCD = 8, WGM = 4;

__host__ __device__ __forceinline__ int lds_byte(int r, int c) { const int st = (r >> 4) * 2 + (c >> 5), rr = r & 15, cc = c & 31, ob = rr * 64 + cc * 2; return st * 1024 + (ob ^ (((ob >> 9) & 1) << 5)); }
__host__ __device__ __forceinline__ void stage_rc(int b, int& R, int& C) { const int st = b / 1024, sb = b % 1024, swz = sb ^ (((sb >> 9) & 1) << 5); R = (st >> 1) * 16 + swz / 64; C = (st & 1) * 32 + (swz % 64) / 2; }
__host__ __device__ __forceinline__ int perm32(int rho) { const int n = rho >> 4, i = rho & 15; return 8 * (i >> 2) + 4 * n + (i & 3); }

struct Unit { int pm, pn, kc; };
struct Gemm { const bf16_t* A; const bf16_t* Bt; int M, N, K, lda, ldb; };

struct StaticOrder {
    int nM, nN, nwg, G, c;
    __host__ __device__ void init(int M, int N, int G_, int c_) { nM = M / BM; nN = N / BM; nwg = nM * nN; G = G_; c = c_; }
    __host__ __device__ bool next(int i, Unit& u) const {
        const long L = (long)i * G + c; if (L >= nwg) return false;
        int wgid = (int)L; { const int q = nwg / NXCD, r = nwg % NXCD, xcd = wgid % NXCD, off = wgid / NXCD; wgid = (xcd < r ? xcd * (q + 1) : r * (q + 1) + (xcd - r) * q) + off; }
        const int nig = WGM * nN, gid = wgid / nig, fm = gid * WGM, gsz = (nM - fm) < WGM ? (nM - fm) : WGM;
        u.pm = fm + ((wgid % nig) % gsz); u.pn = (wgid % nig) / gsz; return true;
    }
    __device__ __forceinline__ void a_ready(const Unit&) const {}
    __device__ __forceinline__ void done(const Unit&) const {}
};


__device__ __forceinline__ unsigned cvt_pk_bf16(float lo, float hi) { unsigned r; asm volatile("v_cvt_pk_bf16_f32 %0, %1, %2" : "=v"(r) : "v"(lo), "v"(hi)); return r; }

struct RowSched {
    int nM, nN, nwg, G, c, skipctx, rev;
    __device__ void init(int nM_, int nN_, int G_, int c_, int skipctx_, int rev_ = 0) { nM = nM_; nN = nN_; nwg = nM * nN; G = G_; c = c_; skipctx = skipctx_; rev = rev_; }
    __device__ bool next(int i, Unit& u) const {
        const long L = (long)i * G + c; if (L >= nwg) return false;
        int wgid = (int)L; { const int q = nwg / NXCD, r = nwg % NXCD, xcd = wgid % NXCD, off = wgid / NXCD; wgid = (xcd < r ? xcd * (q + 1) : r * (q + 1) + (xcd - r) * q) + off; }
        const int nig = WGM * nN, gid = wgid / nig, fm = gid * WGM, gsz = (nM - fm) < WGM ? (nM - fm) : WGM;
        int pm = fm + ((wgid % nig) % gsz); u.pn = (wgid % nig) / gsz;
        if (rev) pm = nM - 1 - pm;
        if (skipctx) pm += 1 + (pm >= 64 ? 1 : 0);
        u.pm = pm; u.kc = 0; return true;
    }
    __device__ __forceinline__ void a_ready(const Unit&) const {}
    __device__ __forceinline__ void done(const Unit&) const {}
};

struct CtxSplitSched {
    int nN, NKC, nwg, G, c;
    __device__ void init(int nN_, int NKC_, int G_, int c_) { nN = nN_; NKC = NKC_; nwg = 2 * nN * NKC; G = G_; c = c_; }
    __device__ bool next(int i, Unit& u) const {
        const long L = (long)i * G + c; if (L >= nwg) return false;
        const int l = (int)L, t = l / NKC; u.kc = l - t * NKC; u.pn = t % nN; u.pm = (t / nN) ? 65 : 0; return true;
    }
    __device__ __forceinline__ void a_ready(const Unit&) const {}
    __device__ __forceinline__ void done(const Unit&) const {}
};

template <int MODE> struct Epi {
    static constexpr bool PERM = true, AFTER_DRAIN = false;
    bf16_t* O; int ldc;
    float* ssq;
    const float* rssq;
    bf16_t* KR;
    const float* rtab; const float* ctab;
    float* part;
    __device__ __forceinline__ void operator()(const f32x4 (&acc)[2][2][4][2], const Unit& u, int wr, int wc, int fr, int fq) const {
        const int pm = u.pm, pn = u.pn;
        const bool isctx = (pm == 0) || (pm == 65);
        const int tbase = (pm > 65 ? pm - 66 : pm - 1) * 256;
#pragma unroll
        for (int ai = 0; ai < 2; ++ai)
#pragma unroll
            for (int m = 0; m < 4; ++m) {
                const int rt = ai * HALF + wr * 64 + m * 16 + fr;
                const int row = pm * BM + rt;
                const int t = tbase + rt;
                float rs = 1.f;
                if (MODE == 2 || MODE == 3) rs = __builtin_amdgcn_rsqf(rssq[row] * (1.0f / 512.0f) + 1e-6f);
                float sq = 0.f;
#pragma unroll
                for (int bj = 0; bj < 2; ++bj) {
                    const int col = pn * BM + bj * HALF + wc * 32 + 8 * fq;
                    f32x4 v0 = acc[ai][bj][m][0], v1 = acc[ai][bj][m][1];
                    if (MODE == 6) { float* pp = part + ((size_t)u.kc * 512 + (pm == 65 ? 256 : 0) + rt) * ldc + col; *(f32x4*)pp = v0; *(f32x4*)(pp + 4) = v1; continue; }
                    if (MODE == 2 || MODE == 3) { v0 = v0 * rs; v1 = v1 * rs; }
                    if (MODE == 0 || MODE == 1) sq += (v0[0] * v0[0] + v0[1] * v0[1]) + (v0[2] * v0[2] + v0[3] * v0[3]) + (v1[0] * v1[0] + v1[1] * v1[1]) + (v1[2] * v1[2] + v1[3] * v1[3]);
                    bool dorope = false; int i0 = 0;
                    if (MODE == 2) { const int hc = col % 192; dorope = (!isctx) && (hc >= 128); i0 = (hc - 128) >> 1; }
                    if (MODE == 5) { dorope = (!isctx) && (col < 2304); i0 = (col & 63) >> 1; }
                    if (MODE == 1) { dorope = (!isctx) && (pn == 4) && (col < 1088); i0 = (col - 1024) >> 1; }
                    if (MODE == 1 || MODE == 2 || MODE == 5) {
                        if (dorope) {
                            const float* tb = (i0 < 16) ? (rtab + ((t >> 6) * 16 + i0) * 2) : (ctab + ((t & 63) * 16 + (i0 - 16)) * 2);
                            const f32x4 c0 = *(const f32x4*)tb, c1 = *(const f32x4*)(tb + 4);
                            f32x4 w0, w1;
                            w0[0] = v0[0] * c0[0] - v0[1] * c0[1]; w0[1] = v0[0] * c0[1] + v0[1] * c0[0];
                            w0[2] = v0[2] * c0[2] - v0[3] * c0[3]; w0[3] = v0[2] * c0[3] + v0[3] * c0[2];
                            w1[0] = v1[0] * c1[0] - v1[1] * c1[1]; w1[1] = v1[0] * c1[1] + v1[1] * c1[0];
                            w1[2] = v1[2] * c1[2] - v1[3] * c1[3]; w1[3] = v1[2] * c1[3] + v1[3] * c1[2];
                            v0 = w0; v1 = w1;
                        }
                    }
                    if (MODE == 4) {
#pragma unroll
                        for (int e = 0; e < 4; ++e) { const float a = fmaxf(v0[e], 0.f), b = fmaxf(v1[e], 0.f); v0[e] = a * a; v1[e] = b * b; }
                    }
                    u32x4 w; w.x = cvt_pk_bf16(v0[0], v0[1]); w.y = cvt_pk_bf16(v0[2], v0[3]); w.z = cvt_pk_bf16(v1[0], v1[1]); w.w = cvt_pk_bf16(v1[2], v1[3]);
                    if (MODE == 1 && pn == 4) { if (col < 1088) *(u32x4*)(KR + (size_t)row * 64 + (col - 1024)) = w; }
                    else *(u32x4*)(O + (size_t)row * ldc + col) = w;
                }
                if (MODE == 0 || MODE == 1) {
                    if (MODE == 0 || pn < 4) {
                        sq += __shfl_xor(sq, 16); sq += __shfl_xor(sq, 32);
                        if (fq == 0) atomicAdd(ssq + (MODE == 1 ? (size_t)(pn >> 1) * NROW : (size_t)0) + row, sq);
                    }
                }
            }
    }
};

template <class Epi, class Sched, bool ALIGN_EPI = false, bool SP2 = false>
__device__ __forceinline__ void gemm_phase(PG8_LAS unsigned char* lds, const Gemm g, const Sched& S, const Epi& E, const int wave_) {
    const int wid = wave_, lane = lane_id_v(), tid = wid * 64 + lane, wr = wid >> 2, wc = wid & 3, fr = lane & 15, fq = lane >> 4;
    const int K = g.K, nt = K / BK, lda = g.lda, ldb = g.ldb;
    unsigned voffA[2], voffB[2];
#pragma unroll
    for (int i = 0; i < 2; ++i) { int R, C; stage_rc(tid * 16 + i * 8192, R, C); const int Rb = Epi::PERM ? ((R & ~31) + perm32(R & 31)) : R;
        voffA[i] = (unsigned)(R * lda + C) * 2u; voffB[i] = (unsigned)(Rb * ldb + C) * 2u; }
    const size_t kstep = (size_t)(BK * 2);
    const size_t hstepA = (size_t)HALF * lda * 2, hstepB = (size_t)HALF * ldb * 2;
    const size_t tstepA = 2 * hstepA, tstepB = 2 * hstepB;
    const unsigned ldsw = (unsigned)wid * 1024u;
    const int aoff = lds_byte(wr * 64 + fr, fq * 8), boff = lds_byte(wc * 32 + fr, fq * 8);
#define PG8_SA(b, h) (((b) * 2 + (h)) * HTB)
#define PG8_SB(b, h) ((4 + (b) * 2 + (h)) * HTB)
#define PG8_STAGE(bufoff, gbase, voff) do { _Pragma("unroll") for (int _i = 0; _i < 2; ++_i) \
        __builtin_amdgcn_global_load_lds((const unsigned*)((const char*)(gbase) + (voff)[_i]), (PG8_LAS unsigned*)(lds + (bufoff) + ldsw + _i * 8192), 16, 0, 0); } while (0)
#define PG8_LDA(dst, b, h) do { _Pragma("unroll") for (int m = 0; m < 4; ++m) _Pragma("unroll") for (int k = 0; k < 2; ++k) dst[m][k] = *(const PG8_LAS bf16x8*)(lds + PG8_SA(b, h) + aoff + m * 2048 + k * 1024); } while (0)
#define PG8_LDB(dst, b, h) do { _Pragma("unroll") for (int n = 0; n < 2; ++n) _Pragma("unroll") for (int k = 0; k < 2; ++k) dst[n][k] = *(const PG8_LAS bf16x8*)(lds + PG8_SB(b, h) + boff + n * 2048 + k * 1024); } while (0)
#define PG8_MMA(ai, bj, At, Bt) do { __builtin_amdgcn_s_setprio(1); _Pragma("unroll") for (int m = 0; m < 4; ++m) _Pragma("unroll") for (int n = 0; n < 2; ++n) _Pragma("unroll") for (int k = 0; k < 2; ++k) \
        acc[ai][bj][m][n] = __builtin_amdgcn_mfma_f32_16x16x32_bf16(Bt[n][k], At[m][k], acc[ai][bj][m][n], 0, 0, 0); __builtin_amdgcn_s_setprio(0); } while (0)
#define PG8_WAIT_V(n) asm volatile("s_waitcnt vmcnt(" #n ")" ::: "memory")
#define PG8_WAIT_L(n) asm volatile("s_waitcnt lgkmcnt(" #n ")" ::: "memory")
#define PG8_BAR __builtin_amdgcn_s_barrier()
#define PG8_SCHED __builtin_amdgcn_sched_barrier(0)
    Unit cur, nxt; int ui = 0;
    if (!S.next(0, cur)) return;
    f32x4 acc[2][2][4][2];
#pragma unroll
    for (int a = 0; a < 2; ++a)
#pragma unroll
        for (int b = 0; b < 2; ++b)
#pragma unroll
            for (int m = 0; m < 4; ++m)
#pragma unroll
                for (int n = 0; n < 2; ++n) acc[a][b][m][n] = (f32x4){0.f, 0.f, 0.f, 0.f};
    bf16x8 At[4][2], B0[2][2], B1[2][2];
    const char* cA = (const char*)g.A + (size_t)cur.pm * tstepA + (size_t)cur.kc * K * 2; const char* cB = (const char*)g.Bt + (size_t)cur.pn * tstepB + (size_t)cur.kc * K * 2;
    S.a_ready(cur);
    if constexpr (SP2) {
        PG8_STAGE(PG8_SB(0, 0), cB, voffB); PG8_STAGE(PG8_SB(0, 1), cB + hstepB, voffB); PG8_STAGE(PG8_SA(0, 0), cA, voffA); PG8_STAGE(PG8_SA(0, 1), cA + hstepA, voffA);
        if (wr == 1) PG8_BAR;
        PG8_WAIT_V(2); PG8_BAR;
        PG8_STAGE(PG8_SB(1, 0), cB + kstep, voffB); PG8_STAGE(PG8_SA(1, 0), cA + kstep, voffA); PG8_STAGE(PG8_SB(1, 1), cB + hstepB + kstep, voffB);
        PG8_WAIT_V(6); PG8_BAR;
    } else {
        PG8_STAGE(PG8_SB(0, 0), cB, voffB); PG8_STAGE(PG8_SA(0, 0), cA, voffA); PG8_STAGE(PG8_SB(0, 1), cB + hstepB, voffB); PG8_STAGE(PG8_SA(0, 1), cA + hstepA, voffA);
        if (wr == 1) PG8_BAR;
        PG8_WAIT_V(4); PG8_BAR;
        PG8_STAGE(PG8_SB(1, 0), cB + kstep, voffB); PG8_STAGE(PG8_SA(1, 0), cA + kstep, voffA); PG8_STAGE(PG8_SB(1, 1), cB + hstepB + kstep, voffB);
        PG8_WAIT_V(6); PG8_BAR;
    }
    for (;;) {
        const bool has_next = S.next(ui + 1, nxt);
        const char* nA = has_next ? (const char*)g.A + (size_t)nxt.pm * tstepA + (size_t)nxt.kc * K * 2 : cA; const char* nB = has_next ? (const char*)g.Bt + (size_t)nxt.pn * tstepB + (size_t)nxt.kc * K * 2 : cB;
        for (int t = 0; t < nt; t += 2) {
            const bool last = (t == nt - 2);
            const char* a1 = cA + (size_t)(t + 1) * kstep;
            const char* a2 = last ? nA : cA + (size_t)(t + 2) * kstep; const char* b2 = last ? nB : cB + (size_t)(t + 2) * kstep;
            const char* a3 = a2 + kstep; const char* b3 = b2 + kstep;
            if (last && has_next) S.a_ready(nxt);
            if constexpr (SP2) {
            PG8_LDB(B0, 0, 0); PG8_LDB(B1, 0, 1); PG8_SCHED; PG8_LDA(At, 0, 0); PG8_STAGE(PG8_SA(1, 1), a1 + hstepA, voffA);
            PG8_WAIT_V(8); PG8_WAIT_L(0); PG8_BAR; PG8_MMA(0, 0, At, B0); PG8_MMA(0, 1, At, B1); PG8_BAR; PG8_SCHED;
            PG8_LDA(At, 0, 1); PG8_STAGE(PG8_SB(0, 0), b2, voffB); PG8_STAGE(PG8_SB(0, 1), b2 + hstepB, voffB); PG8_STAGE(PG8_SA(0, 0), a2, voffA);
            PG8_WAIT_V(8); PG8_WAIT_L(0); PG8_BAR; PG8_MMA(1, 0, At, B0); PG8_MMA(1, 1, At, B1); PG8_BAR; PG8_SCHED;
            PG8_LDB(B0, 1, 0); PG8_LDB(B1, 1, 1); PG8_SCHED; PG8_LDA(At, 1, 0); PG8_STAGE(PG8_SA(0, 1), a2 + hstepA, voffA);
            PG8_WAIT_V(8); PG8_WAIT_L(0); PG8_BAR; PG8_MMA(0, 0, At, B0); PG8_MMA(0, 1, At, B1); PG8_BAR; PG8_SCHED;
            PG8_LDA(At, 1, 1); PG8_STAGE(PG8_SB(1, 0), b3, voffB); PG8_STAGE(PG8_SB(1, 1), b3 + hstepB, voffB); PG8_STAGE(PG8_SA(1, 0), a3, voffA);
            PG8_WAIT_V(8); PG8_WAIT_L(0); PG8_BAR; PG8_MMA(1, 0, At, B0); PG8_MMA(1, 1, At, B1); PG8_BAR; PG8_SCHED;
            } else {
            PG8_LDB(B0, 0, 0); PG8_SCHED; PG8_LDA(At, 0, 0); PG8_STAGE(PG8_SA(1, 1), a1 + hstepA, voffA);
            PG8_WAIT_L(8); PG8_BAR; PG8_WAIT_L(0); PG8_MMA(0, 0, At, B0); PG8_BAR; PG8_SCHED;
            PG8_LDB(B1, 0, 1); PG8_STAGE(PG8_SB(0, 0), b2, voffB);
            PG8_BAR; PG8_WAIT_L(0); PG8_MMA(0, 1, At, B1); PG8_BAR;
            PG8_LDA(At, 0, 1); PG8_STAGE(PG8_SA(0, 0), a2, voffA);
            PG8_BAR; PG8_WAIT_L(0); PG8_MMA(1, 0, At, B0); PG8_BAR; PG8_SCHED;
            PG8_STAGE(PG8_SB(0, 1), b2 + hstepB, voffB);
            PG8_WAIT_V(6); PG8_BAR; PG8_MMA(1, 1, At, B1); PG8_BAR;
            PG8_LDB(B0, 1, 0); PG8_SCHED; PG8_LDA(At, 1, 0); PG8_STAGE(PG8_SA(0, 1), a2 + hstepA, voffA);
            PG8_WAIT_L(8); PG8_BAR; PG8_WAIT_L(0); PG8_MMA(0, 0, At, B0); PG8_BAR; PG8_SCHED;
            PG8_LDB(B1, 1, 1); PG8_STAGE(PG8_SB(1, 0), b3, voffB);
            PG8_BAR; PG8_WAIT_L(0); PG8_MMA(0, 1, At, B1); PG8_BAR;
            PG8_LDA(At, 1, 1); PG8_STAGE(PG8_SA(1, 0), a3, voffA);
            PG8_BAR; PG8_WAIT_L(0); PG8_MMA(1, 0, At, B0); PG8_BAR; PG8_SCHED;
            PG8_STAGE(PG8_SB(1, 1), b3 + hstepB, voffB);
            PG8_WAIT_V(6); PG8_BAR; PG8_MMA(1, 1, At, B1); PG8_BAR;
            }
        }
        if constexpr (ALIGN_EPI) { if (wr == 0) PG8_BAR; }
        if constexpr (!Epi::AFTER_DRAIN) { E(acc, cur, wr, wc, fr, fq); S.done(cur); }
        if (!has_next) break;
#pragma unroll
        for (int a = 0; a < 2; ++a)
#pragma unroll
            for (int b = 0; b < 2; ++b)
#pragma unroll
                for (int m = 0; m < 4; ++m)
#pragma unroll
                    for (int n = 0; n < 2; ++n) acc[a][b][m][n] = (f32x4){0.f, 0.f, 0.f, 0.f};
        cur = nxt; cA = nA; cB = nB; ++ui;
        if constexpr (ALIGN_EPI) { if (wr == 1) PG8_BAR; }
    }
    PG8_WAIT_V(0);
    if constexpr (!ALIGN_EPI) { if (wr == 0) PG8_BAR; }
    PG8_BAR;
    if constexpr (Epi::AFTER_DRAIN) { E.fused(acc, cur, wr, wc, fr, fq, lds, wid, lane); S.done(cur); }
#undef PG8_SA
#undef PG8_SB
#undef PG8_STAGE
#undef PG8_LDA
#undef PG8_LDB
#undef PG8_MMA
#undef PG8_WAIT_V
#undef PG8_WAIT_L
#undef PG8_BAR
#undef PG8_SCHED
}
}

namespace att {
typedef unsigned short bf16_t;
using bf16x8 = __attribute__((ext_vector_type(8))) short;
using s16x4  = __attribute__((ext_vector_type(4))) short;
using f32x16 = __attribute__((ext_vector_type(16))) float;
using u32x4  = __attribute__((ext_vector_type(4))) unsigned;
#define KSWZ(row, colB) ((row) * 256 + ((colB) ^ (((row) & 15) << 4)))
#define KSWZ64(row, colB) ((row) * 128 + ((colB) ^ ((((row) >> 1) & 7) << 4)))
#define SBAR() __builtin_amdgcn_sched_barrier(0)
__device__ __forceinline__ int crow(int r, int hi) { return (r & 3) + 8 * (r >> 2) + 4 * hi; }
__device__ __forceinline__ unsigned cvtpk(float lo, float hi) { unsigned r; asm volatile("v_cvt_pk_bf16_f32 %0, %1, %2" : "=v"(r) : "v"(lo), "v"(hi)); return r; }

__device__ __forceinline__ void partialSM(f32x16& p0, f32x16& p1, float& m_reg, float& alpha, const float C, const float THRS) {
  float pmax = p0[0];
#pragma unroll
  for (int r = 1; r < 16; ++r) pmax = fmaxf(pmax, p0[r]);
#pragma unroll
  for (int r = 0; r < 16; ++r) pmax = fmaxf(pmax, p1[r]);
  { auto rr = __builtin_amdgcn_permlane32_swap(__float_as_uint(pmax), __float_as_uint(pmax), false, false);
    pmax = fmaxf(__uint_as_float(rr[0]), __uint_as_float(rr[1])); }
  float mn;
  if (__builtin_expect(__all(pmax - m_reg <= THRS), 1)) { mn = m_reg; alpha = 1.f; }
  else { mn = fmaxf(m_reg, pmax); alpha = __builtin_amdgcn_exp2f((m_reg - mn) * C); m_reg = mn; }
  const float mnC = -mn * C;
#pragma unroll
  for (int r = 0; r < 16; ++r) p0[r] = fmaf(p0[r], C, mnC);
#pragma unroll
  for (int r = 0; r < 16; ++r) p1[r] = fmaf(p1[r], C, mnC);
#pragma unroll
  for (int r = 0; r < 16; ++r) p0[r] = __builtin_amdgcn_exp2f(p0[r]);
}
__device__ __forceinline__ void finishSM(f32x16& p0, f32x16& p1, float alpha, float& l_reg, bf16x8& pa0, bf16x8& pa1, bf16x8& pa2, bf16x8& pa3) {
#pragma unroll
  for (int r = 0; r < 16; ++r) p1[r] = __builtin_amdgcn_exp2f(p1[r]);
  float ps = 0;
#pragma unroll
  for (int r = 0; r < 16; ++r) ps += p0[r];
#pragma unroll
  for (int r = 0; r < 16; ++r) ps += p1[r];
  { auto rr = __builtin_amdgcn_permlane32_swap(__float_as_uint(ps), __float_as_uint(ps), false, false);
    ps = __uint_as_float(rr[0]) + __uint_as_float(rr[1]); }
  l_reg = l_reg * alpha + ps;
#define PK4(P, BASE, OUT) do { unsigned a0 = cvtpk(P[BASE + 0], P[BASE + 1]), a1 = cvtpk(P[BASE + 2], P[BASE + 3]);   \
    unsigned b0 = cvtpk(P[BASE + 4], P[BASE + 5]), b1 = cvtpk(P[BASE + 6], P[BASE + 7]);                              \
    auto r0 = __builtin_amdgcn_permlane32_swap(a0, b0, false, false); auto r1 = __builtin_amdgcn_permlane32_swap(a1, b1, false, false); \
    u32x4 w = {r0[0], r1[0], r0[1], r1[1]}; OUT = *reinterpret_cast<bf16x8*>(&w); } while (0)
  PK4(p0, 0, pa0); PK4(p0, 8, pa1); PK4(p1, 0, pa2); PK4(p1, 8, pa3);
#undef PK4
}
template <int DN>
__device__ __forceinline__ void qkt(f32x16& p0, f32x16& p1, const char* Kn, const char* Kr, const bf16x8* qr, const char* qrl, int r32, int hi) {
  p0 = f32x16{}; p1 = f32x16{};
  if constexpr (DN > 0) {
#pragma unroll
    for (int d0 = 0; d0 < DN / 16; ++d0) { const int cb = (d0 * 16 + hi * 8) * 2;
      bf16x8 b0 = *reinterpret_cast<const bf16x8*>(Kn + KSWZ(r32, cb));
      bf16x8 b1 = *reinterpret_cast<const bf16x8*>(Kn + KSWZ(32 + r32, cb));
      p0 = __builtin_amdgcn_mfma_f32_32x32x16_bf16(b0, qr[d0], p0, 0, 0, 0);
      p1 = __builtin_amdgcn_mfma_f32_32x32x16_bf16(b1, qr[d0], p1, 0, 0, 0); }
  }
#pragma unroll
  for (int d0 = 0; d0 < 4; ++d0) { const int cb = (d0 * 16 + hi * 8) * 2;
    bf16x8 b0 = *reinterpret_cast<const bf16x8*>(Kr + KSWZ64(r32, cb));
    bf16x8 b1 = *reinterpret_cast<const bf16x8*>(Kr + KSWZ64(32 + r32, cb));
    bf16x8 q; if constexpr (DN > 0) q = *reinterpret_cast<const bf16x8*>(qrl + d0 * 1024); else q = qr[d0];
    p0 = __builtin_amdgcn_mfma_f32_32x32x16_bf16(b0, q, p0, 0, 0, 0);
    p1 = __builtin_amdgcn_mfma_f32_32x32x16_bf16(b1, q, p1, 0, 0, 0); }
}
__device__ __forceinline__ void band_mask(f32x16& p0, f32x16& p1, int d) {
#pragma unroll
  for (int r = 0; r < 16; ++r) { const int v = d - ((r & 3) + 8 * (r >> 2));
    if (v > 128 || v < -128) p0[r] = -1e30f;
    if (v - 32 > 128 || v - 32 < -128) p1[r] = -1e30f; }
}
__device__ __forceinline__ int v_rd_base(int lane) { return ((lane & 3) << 3) | (((lane >> 2) & 3) << 6) | (((lane >> 4) & 1) << 5) | (((lane >> 5) & 1) << 8); }
template <int NCB> constexpr int v_rd_off(int d0, int ks, int half) { return d0 * 512 + ks * (2 * NCB * 512) + half * (NCB * 512); }
template <int OFF> __device__ __forceinline__ s16x4 tr_read(int vb) {
  s16x4 r; asm volatile("ds_read_b64_tr_b16 %0, %1 offset:%2" : "=&v"(r) : "v"(vb), "i"(OFF) : "memory"); return r;
}
template <int D0, int NCB> __device__ __forceinline__ void pv_one(f32x16& od, int vb, bf16x8 pa0, bf16x8 pa1, bf16x8 pa2, bf16x8 pa3) {
  const s16x4 l0 = tr_read<v_rd_off<NCB>(D0, 0, 0)>(vb), h0 = tr_read<v_rd_off<NCB>(D0, 0, 1)>(vb), l1 = tr_read<v_rd_off<NCB>(D0, 1, 0)>(vb), h1 = tr_read<v_rd_off<NCB>(D0, 1, 1)>(vb);
  const s16x4 l2 = tr_read<v_rd_off<NCB>(D0, 2, 0)>(vb), h2 = tr_read<v_rd_off<NCB>(D0, 2, 1)>(vb), l3 = tr_read<v_rd_off<NCB>(D0, 3, 0)>(vb), h3 = tr_read<v_rd_off<NCB>(D0, 3, 1)>(vb);
  asm volatile("s_waitcnt lgkmcnt(0)" ::: "memory"); SBAR();
#define PK(L, H) (bf16x8){L[0], L[1], L[2], L[3], H[0], H[1], H[2], H[3]}
  od = __builtin_amdgcn_mfma_f32_32x32x16_bf16(pa0, PK(l0, h0), od, 0, 0, 0);
  od = __builtin_amdgcn_mfma_f32_32x32x16_bf16(pa1, PK(l1, h1), od, 0, 0, 0);
  od = __builtin_amdgcn_mfma_f32_32x32x16_bf16(pa2, PK(l2, h2), od, 0, 0, 0);
  od = __builtin_amdgcn_mfma_f32_32x32x16_bf16(pa3, PK(l3, h3), od, 0, 0, 0);
#undef PK
}
template <int NCB> __device__ __forceinline__ void pv_all(f32x16* o, int vb, bf16x8 pa0, bf16x8 pa1, bf16x8 pa2, bf16x8 pa3) {
  pv_one<0, NCB>(o[0], vb, pa0, pa1, pa2, pa3); pv_one<1, NCB>(o[1], vb, pa0, pa1, pa2, pa3);
  if constexpr (NCB == 4) { pv_one<2, NCB>(o[2], vb, pa0, pa1, pa2, pa3); pv_one<3, NCB>(o[3], vb, pa0, pa1, pa2, pa3); }
}

#define ATT_LAS __attribute__((address_space(3)))
template <int DN, int DV, bool MASK>
__device__ __forceinline__ void attn_unit(const bf16_t* __restrict__ Qb, const int ldq, const bf16_t* __restrict__ Kn, const int ldkn,
    const bf16_t* __restrict__ Kr, const int ldkr, const bf16_t* __restrict__ Vp, const int ldv, bf16_t* __restrict__ Ob, const int ldo,
    const int NT, const int n1, const int r1, const int r2, const int qpos0, const int kt2,
    const float C, const float THRS, const float sinkl2, char* lds, ATT_LAS unsigned char* ldsL, const int wave_) {
  constexpr int NQR = DN > 0 ? DN / 16 : 4, NCB = DV / 32, VB = 64 * DV * 2, KNB = 64 * DN * 2, KRB = 64 * 64 * 2, BUF = VB + KNB + KRB;
  constexpr int NVC = VB / 8192, NKC = KNB / 8192;
  const int wid = wave_, lane = lane_id_v(), r32 = lane & 31, hi = lane >> 5;
  char* Vl = lds; char* Knl = lds + VB; char* Krl = lds + VB + KNB;
  float* wsf = (float*)(lds + 3 * BUF) + wid * 64; float* li_l = wsf; float* al_l = wsf + 32;
  float m_reg = -1e30f, l_reg = 0; f32x16 o[NCB] = {}; bf16x8 qr[NQR];
  const bf16_t* Qw = Qb + (MASK ? (long)r32 * ldq + wid * 64 : (long)(wid * 32 + r32) * ldq) + hi * 8;
#pragma unroll
  for (int d0 = 0; d0 < NQR; ++d0) qr[d0] = *reinterpret_cast<const bf16x8*>(Qw + d0 * 16);
  char* qrl = lds + 3 * BUF + 2048 + wid * 4096 + lane * 16;
  if constexpr (DN > 0) {
#pragma unroll
    for (int d0 = 0; d0 < 4; ++d0) *reinterpret_cast<bf16x8*>(qrl + d0 * 1024) = *reinterpret_cast<const bf16x8*>(Qw + DN + d0 * 16);
  }
  int offV[NVC], offK[NKC > 0 ? NKC : 1], offR;
#pragma unroll
  for (int i = 0; i < NVC; ++i) { const int ch = wid * NVC + i, sub = ch * 2 + (lane >> 5), kk = (sub / NCB) * 8 + ((lane & 31) >> 2), col = (sub % NCB) * 32 + (lane & 3) * 8;
    const int k = (kk & ~0xC) | ((kk & 4) << 1) | ((kk & 8) >> 1); offV[i] = k * ldv + col; }
#pragma unroll
  for (int i = 0; i < NKC; ++i) { const int ch = wid * NKC + i, row = ch * 4 + (lane >> 4), cb = ((lane & 15) * 16) ^ ((row & 15) << 4); offK[i] = row * ldkn + (cb >> 1); }
  { const int row = wid * 8 + (lane >> 3), cb = ((lane & 7) * 16) ^ (((row >> 1) & 7) << 4); offR = row * ldkr + (cb >> 1); }
  const int vb0 = (int)(uintptr_t)Vl + v_rd_base(lane);
  const int qd = qpos0 + (MASK ? 0 : wid * 32) + r32 - 4 * hi;
#define TROW(j) ((j) < n1 ? r1 + 64 * (j) : r2 + 64 * ((j) - n1))
#define DMA(j, b) do { const long row0_ = TROW(j); \
    _Pragma("unroll") for (int i_ = 0; i_ < NVC; ++i_) __builtin_amdgcn_global_load_lds((const unsigned*)(Vp + row0_ * ldv + offV[i_]), (ATT_LAS unsigned*)(ldsL + (b) + (wid * NVC + i_) * 1024), 16, 0, 0); \
    _Pragma("unroll") for (int i_ = 0; i_ < NKC; ++i_) __builtin_amdgcn_global_load_lds((const unsigned*)(Kn + row0_ * ldkn + offK[i_]), (ATT_LAS unsigned*)(ldsL + (b) + VB + (wid * NKC + i_) * 1024), 16, 0, 0); \
    __builtin_amdgcn_global_load_lds((const unsigned*)(Kr + row0_ * ldkr + offR), (ATT_LAS unsigned*)(ldsL + (b) + VB + KNB + wid * 1024), 16, 0, 0); } while (0)
#define WAITV() asm volatile("s_waitcnt vmcnt(0)" ::: "memory")
  const int q0w = qpos0 + (MASK ? 0 : wid * 32);
#define KP(j) (kt2 + 64 * ((j) - n1))
#define NEED(j) (!MASK || (j) < n1 || (KP(j) <= q0w + 159 && KP(j) + 63 >= q0w - 128))
#define SCORE(P0, P1, b, j) do { qkt<DN>(P0, P1, Knl + (b), Krl + (b), qr, qrl, r32, hi); \
    if constexpr (MASK) { if ((j) >= n1 && !(KP(j) >= q0w - 97 && KP(j) <= q0w + 65)) band_mask(P0, P1, qd - KP(j)); } } while (0)
#define RESC(a) do { if (__any((a) < 1.f)) { const int l_ = lane_id_v(); if (l_ < 32) al_l[l_] = (a); asm volatile("s_waitcnt lgkmcnt(0)" ::: "memory"); \
    _Pragma("unroll") for (int d = 0; d < NCB; ++d) _Pragma("unroll") for (int r = 0; r < 16; ++r) o[d][r] *= al_l[crow(r, l_ >> 5)]; } } while (0)
#define ROT() do { const int t_ = bp; bp = bc; bc = bn; bn = t_; } while (0)
  f32x16 pA0, pA1, pB0, pB1; float alA, alB; bf16x8 pa0, pa1, pa2, pa3;
  int bp = 0, bc = BUF, bn = 2 * BUF;
  DMA(0, 0); DMA(1, BUF); WAITV(); __syncthreads();
  SCORE(pA0, pA1, 0, 0); partialSM(pA0, pA1, m_reg, alA, C, THRS);
  bool nA = true, nB = true;
  for (int j = 1; j + 1 < NT; j += 2) {
    DMA(j + 1, bn);
    nB = NEED(j);
    SBAR(); if (nB) SCORE(pB0, pB1, bc, j);
    if (nA) finishSM(pA0, pA1, alA, l_reg, pa0, pa1, pa2, pa3); SBAR();
    if (nA) pv_all<NCB>(o, vb0 + bp, pa0, pa1, pa2, pa3);
    if (nB) { partialSM(pB0, pB1, m_reg, alB, C, THRS); RESC(alB); }
    WAITV(); __syncthreads(); ROT();
    DMA(j + 2, bn);
    nA = NEED(j + 1);
    SBAR(); if (nA) SCORE(pA0, pA1, bc, j + 1);
    if (nB) finishSM(pB0, pB1, alB, l_reg, pa0, pa1, pa2, pa3); SBAR();
    if (nB) pv_all<NCB>(o, vb0 + bp, pa0, pa1, pa2, pa3);
    if (nA) { partialSM(pA0, pA1, m_reg, alA, C, THRS); RESC(alA); }
    WAITV(); __syncthreads(); ROT();
  }
  nB = NEED(NT - 1);
  SBAR(); if (nB) SCORE(pB0, pB1, bc, NT - 1);
  if (nA) finishSM(pA0, pA1, alA, l_reg, pa0, pa1, pa2, pa3); SBAR();
  if (nA) pv_all<NCB>(o, vb0 + bp, pa0, pa1, pa2, pa3);
  if (nB) { partialSM(pB0, pB1, m_reg, alB, C, THRS);
    RESC(alB);
    finishSM(pB0, pB1, alB, l_reg, pa0, pa1, pa2, pa3); SBAR();
    pv_all<NCB>(o, vb0 + bc, pa0, pa1, pa2, pa3); }
  l_reg += __builtin_amdgcn_exp2f(sinkl2 - m_reg * C);
  const int lane2 = lane_id_v(), r32e = lane2 & 31, hie = lane2 >> 5;
  if (hie == 0) li_l[r32e] = l_reg; asm volatile("s_waitcnt lgkmcnt(0)" ::: "memory");
  float rli[16];
#pragma unroll
  for (int r = 0; r < 16; ++r) rli[r] = __builtin_amdgcn_rcpf(li_l[crow(r, hie)]);
  bf16_t* Ow = Ob + (MASK ? (long)(wid * 64) : (long)(wid * 32) * ldo);
#pragma unroll
  for (int r = 0; r < 16; ++r) { const int orow = crow(r, hie);
#pragma unroll
    for (int d0 = 0; d0 < NCB; ++d0) Ow[(long)orow * ldo + d0 * 32 + r32e] = (bf16_t)(cvtpk(o[d0][r] * rli[r], 0.f) & 0xffffu); }
  __syncthreads();
#undef TROW
#undef DMA
#undef WAITV
#undef SCORE
#undef RESC
#undef ROT
#undef KP
#undef NEED
}
}

constexpr size_t MiB = 1u << 20;
constexpr size_t WS_MOD = 0;
constexpr size_t WS_SSQ = 512 * 1024;
constexpr size_t WS_ROPE = 1792 * 1024;
constexpr size_t CTL_ZERO_BYTES = 2 * MiB;
constexpr size_t WS_XC = 2 * MiB;
constexpr size_t WS_WIN = 8 * MiB, WS_WQB = 13 * MiB, WS_WKVB = 16 * MiB, WS_WOM = 20 * MiB, WS_WF1 = 28 * MiB, WS_WF2 = 92 * MiB, WS_WQKV = 156 * MiB, WS_WOS = 166 * MiB;
constexpr size_t WS_S1 = 176 * MiB;
constexpr size_t WS_S2 = 306 * MiB;
constexpr size_t WS_G = 436 * MiB;
constexpr size_t WS_Q = WS_G, WS_KV = WS_G + 196 * MiB, WS_KR = WS_G + 456 * MiB;
constexpr size_t WS_PART = WS_G + 520 * MiB;
constexpr size_t WS_END = WS_PART + 64 * MiB;
static_assert((size_t)NROW * 2048 * 2 == 130 * MiB && WS_SSQ + 8 * (size_t)NROW * 4 <= WS_ROPE && (size_t)NROW * NQ * 2 <= 196 * MiB && (size_t)NROW * NKV * 2 <= 260 * MiB, "ws map");

#define LAS __attribute__((address_space(3)))
typedef unsigned short bf16_t;
typedef float f32x4 __attribute__((ext_vector_type(4)));
typedef unsigned u32x4 __attribute__((ext_vector_type(4)));
typedef unsigned u32x2 __attribute__((ext_vector_type(2)));
constexpr int LDS_BYTES = 3 * 40960 + 2048 + 32768;
constexpr int N_PHASES = 17;
#ifndef PROBE_PH
#define PROBE_PH -1
#endif
#ifndef PROBE_PH2
#define PROBE_PH2 -1
#endif
#if PROBE_PH >= 0
#define rep_PROBE0 (rep_ != 0)
#define REP(k) for (int rep_ = 0; rep_ < ((((PROBE_PH) >> (k)) & 1) ? 2 : 1); ++rep_)
#define SSQP(i) (rep_ ? SSQ + 6 * NROW : SSQ + (i) * NROW)
#else
#define rep_PROBE0 false
#define REP(k)
#define SSQP(i) (SSQ + (i) * NROW)
#endif

struct Args { const float* in[18]; float* out; unsigned char* ws; int ph_lo, ph_hi; };

__device__ __forceinline__ float wave_sum(float v) {
#pragma unroll
  for (int o = 1; o < 64; o <<= 1) v += __shfl_xor(v, o);
  return v;
}
__device__ __forceinline__ unsigned pk2(float lo, float hi) { unsigned r; asm volatile("v_cvt_pk_bf16_f32 %0, %1, %2" : "=v"(r) : "v"(lo), "v"(hi)); return r; }

__device__ __forceinline__ int dest_row(int mode, int n) {
  if (mode == 1) { if (n < 1024) return n; const int j = n - 1024; return 1024 + (((j & 31) << 1) | (j >> 5)); }
  if (mode == 2) { const int h = n / 192, d = n - h * 192; if (d < 128) return n; const int j = d - 128; return h * 192 + 128 + (((j & 31) << 1) | (j >> 5)); }
  if (mode == 3) { if (n >= 2304) return n; const int d = n & 63; return (n & ~63) + (((d & 31) << 1) | (d >> 5)); }
  return n;
}
__device__ __forceinline__ void tr_item(const float* __restrict__ W, int K, int N, bf16_t* __restrict__ WT, const float* __restrict__ ks, int mode, LAS float* scr, int item, int lane) {
  const int nblk = N / 32, kb = item / nblk, nb = item - kb * nblk, k0 = 64 * kb, n0 = 32 * nb;
  float wv[32];
#pragma unroll
  for (int i = 0; i < 32; ++i) wv[i] = W[(size_t)(k0 + 2 * i + (lane >> 5)) * N + n0 + (lane & 31)];
  if (ks) {
#pragma unroll
    for (int i = 0; i < 32; ++i) wv[i] *= ks[k0 + 2 * i + (lane >> 5)];
  }
#pragma unroll
  for (int i = 0; i < 32; ++i) scr[(2 * i + (lane >> 5)) * 33 + (lane & 31)] = wv[i];
  asm volatile("s_waitcnt lgkmcnt(0)" ::: "memory");
  const int c = lane & 7;
#pragma unroll
  for (int j = 0; j < 4; ++j) { const int n = (lane >> 3) + 8 * j; const LAS float* s = scr + (8 * c) * 33 + n;
    u32x4 o; o.x = pk2(s[0 * 33], s[1 * 33]); o.y = pk2(s[2 * 33], s[3 * 33]); o.z = pk2(s[4 * 33], s[5 * 33]); o.w = pk2(s[6 * 33], s[7 * 33]);
    *(u32x4*)(WT + (size_t)dest_row(mode, n0 + n) * K + k0 + 8 * c) = o; }
  asm volatile("s_waitcnt lgkmcnt(0)" ::: "memory");
}

__device__ __forceinline__ float silu_f(float x) { return x / (1.f + __expf(-x)); }

constexpr int TI0 = 32 * 34, TI1 = 8 * 96, TI2 = 8 * 128, TI3 = 32 * 64, TI4 = 32 * 256, TI6 = 128 * 64, TI8 = 32 * 80, TI9 = 32 * 64;
constexpr int N_EARLY = TI0 + TI1 + TI2, N_LATE = TI3 + 2 * TI4 + 2 * TI6 + TI8 + TI9;
__device__ __forceinline__ void tr_dispatch(const Args& a, int it  , LAS float* scr, int lane) {
  unsigned char* ws = a.ws;
  int r = it; const float* W; int K, N, mode = 0; const float* ks = nullptr; bf16_t* dst;
  if (r < TI0) { W = a.in[9]; K = 2048; N = 1088; mode = 1; dst = (bf16_t*)(ws + WS_WIN); }
  else if ((r -= TI0) < TI1) { W = a.in[12]; K = 512; N = 3072; mode = 2; ks = a.in[10]; dst = (bf16_t*)(ws + WS_WQB); }
  else if ((r -= TI1) < TI2) { W = a.in[13]; K = 512; N = 4096; ks = a.in[11]; dst = (bf16_t*)(ws + WS_WKVB); }
  else if ((r -= TI2) < TI3) { W = a.in[14]; K = 2048; N = 2048; dst = (bf16_t*)(ws + WS_WOM); }
  else if ((r -= TI3) < 2 * TI4) { const int l = r / TI4; r -= l * TI4; W = a.in[7] + (size_t)l * 2048 * 8192; K = 2048; N = 8192; dst = (bf16_t*)(ws + WS_WF1) + (size_t)l * 2048 * 8192; }
  else if ((r -= 2 * TI4) < 2 * TI6) { const int l = r / TI6; r -= l * TI6; W = a.in[8] + (size_t)l * 2048 * 8192; K = 8192; N = 2048; dst = (bf16_t*)(ws + WS_WF2) + (size_t)l * 2048 * 8192; }
  else if ((r -= 2 * TI6) < TI8) { W = a.in[15]; K = 2048; N = 2560; mode = 3; dst = (bf16_t*)(ws + WS_WQKV); }
  else { r -= TI8; W = a.in[17]; K = 2048; N = 2048; dst = (bf16_t*)(ws + WS_WOS); }
  tr_item(W, K, N, dst, ks, mode, scr, r, lane);
}

__device__ __forceinline__ void p0_prologue(const Args& a, LAS unsigned char* lds, int gw, int NGW, int wave, int lane, bool only_transposes) {
  unsigned char* ws = a.ws;
  LAS float* scr = (LAS float*)(lds + wave * 16384);
  for (int it = gw; it < N_EARLY + N_LATE; it += NGW) tr_dispatch(a, it, scr, lane);
  if (only_transposes) return;
  float* MOD = (float*)(ws + WS_MOD);
  for (int it = gw; it < 2 * 48 * 64; it += NGW) {
    const int kc = it & 63, cb = (it >> 6) % 48, l = it / (64 * 48);
    const int n0 = cb * 256 + lane * 4, k0 = kc * 32;
    const float* Wm = a.in[4] + (size_t)l * 2048 * 12288 + n0;
    f32x4 a0 = {0.f, 0.f, 0.f, 0.f}, a1 = a0, a2 = a0;
#pragma unroll 16
    for (int k = 0; k < 32; ++k) { const int kk = k0 + k;
      const float s0 = silu_f(a.in[1][kk]), s1 = silu_f(a.in[1][2048 + kk]), s2 = silu_f(a.in[3][kk]);
      const f32x4 w = *(const f32x4*)(Wm + (size_t)kk * 12288);
      a0 += w * s0; a1 += w * s1; a2 += w * s2; }
    if (kc == 0) { const f32x4 b = *(const f32x4*)(a.in[5] + l * 12288 + n0); a0 += b; a1 += b; a2 += b; }
    float* mo = MOD + (size_t)(l * 3) * 12288 + n0;
#pragma unroll
    for (int e = 0; e < 4; ++e) { atomicAdd(mo + e, a0[e]); atomicAdd(mo + 12288 + e, a1[e]); atomicAdd(mo + 2 * 12288 + e, a2[e]); }
  }
  float* tab = (float*)(ws + WS_ROPE);
  for (int e = gw * 64 + lane; e < 320 * 16; e += NGW * 64) {
    const int i = e & 15, pos = e >> 4; const float p = (float)(pos < 256 ? pos : pos - 256);
    const float freq = exp2f(-(float)i * 0.8304820237218406f); const float ang = p * freq;
    tab[e * 2] = cosf(ang); tab[e * 2 + 1] = sinf(ang);
  }
}

__device__ __forceinline__ f32x4 ldf4(const float* base, unsigned boff) { return *(const f32x4*)((const char*)base + boff); }
__device__ __forceinline__ void stf4(float* base, unsigned boff, f32x4 v) { *(f32x4*)((char*)base + boff) = v; }
__device__ __forceinline__ f32x4 ldf4s(const float* base, unsigned boff) { return __builtin_nontemporal_load((const f32x4*)((const char*)base + boff)); }
__device__ __forceinline__ void stf4s(float* base, unsigned boff, f32x4 v) { __builtin_nontemporal_store(v, (f32x4*)((char*)base + boff)); }
template <bool UPD, bool DOH, int NKC>
__device__ __forceinline__ void norm_rows(const int row0, const int nrows, const float* xin_lat, const float* xin_ctx, float* xout_lat, float* xout_ctx, const bf16_t* Y, const float* ssq,
    const float* gA, const float* gateM, const float* gB, const float* scM, const float* shM, bf16_t* H, int lane, const float* part) {
  const int b = row0 / TB, rb = row0 - b * TB; const bool isctx = rb < CTXL;
  const int v = isctx ? 2 : b;
  const size_t xoff = isctx ? (size_t)(b * CTXL + rb) * DM : (size_t)(b * SEQ + rb - CTXL) * DM;
  const float* xin = (isctx ? xin_ctx : xin_lat) + xoff;
  float* xout = UPD ? ((isctx ? xout_ctx : xout_lat) + xoff) : nullptr;
  const int lane_ = lane_id_v();
  const unsigned lo = (unsigned)lane_ * 16u, lo2 = (unsigned)lane_ * 8u;
  f32x4 GA[8], GB[8], SH[8];
#pragma unroll
  for (int j = 0; j < 8; ++j) { const unsigned o = lo + 1024u * j;
    if (UPD) GA[j] = ldf4(gateM + v * 12288, o) * ldf4(gA, o);
    if (DOH) { GB[j] = ldf4(gB, o) * (ldf4(scM + v * 12288, o) + 1.0f); SH[j] = ldf4(shM + v * 12288, o); } }
  f32x4 xn[8]; u32x2 yn[8];
#pragma unroll
  for (int j = 0; j < 8; ++j) { xn[j] = ldf4s(xin, lo + 1024u * j); if (UPD && !(NKC > 0 && isctx)) yn[j] = __builtin_nontemporal_load((const u32x2*)((const char*)(Y + (size_t)row0 * DM) + lo2 + 512u * j)); }
  for (int rr = 0; rr < nrows; ++rr) {
    const int row = row0 + rr;
    f32x4 x[8]; u32x2 yc[8];
#pragma unroll
    for (int j = 0; j < 8; ++j) { x[j] = xn[j]; if (UPD) yc[j] = yn[j]; }
    if (rr + 1 < nrows) { const float* xr = xin + (size_t)(rr + 1) * DM;
#pragma unroll
      for (int j = 0; j < 8; ++j) { xn[j] = ldf4s(xr, lo + 1024u * j); if (UPD && !(NKC > 0 && isctx)) yn[j] = __builtin_nontemporal_load((const u32x2*)((const char*)(Y + (size_t)(row + 1) * DM) + lo2 + 512u * j)); } }
    if (UPD && NKC > 0 && isctx) {
      f32x4 y[8]; float ys = 0.f; const float* pr = part + (size_t)(b * CTXL + rb + rr) * DM;
#pragma unroll
      for (int j = 0; j < 8; ++j) y[j] = ldf4(pr, lo + 1024u * j);
#pragma unroll 1
      for (int k = 1; k < NKC; ++k) { pr += (size_t)512 * DM;
#pragma unroll
        for (int j = 0; j < 8; ++j) y[j] += ldf4(pr, lo + 1024u * j); }
#pragma unroll
      for (int j = 0; j < 8; ++j) ys += (y[j][0] * y[j][0] + y[j][1] * y[j][1]) + (y[j][2] * y[j][2] + y[j][3] * y[j][3]);
      const float rinv = __builtin_amdgcn_rsqf(wave_sum(ys) * (1.0f / 2048.0f) + NORM_EPS);
      float* xo = xout + (size_t)rr * DM;
#pragma unroll
      for (int j = 0; j < 8; ++j) { x[j] += GA[j] * (y[j] * rinv); stf4s(xo, lo + 1024u * j, x[j]); }
    } else if (UPD) {
      const float rinv = __builtin_amdgcn_rsqf(ssq[row] * (1.0f / 2048.0f) + NORM_EPS);
      float* xo = xout + (size_t)rr * DM;
#pragma unroll
      for (int j = 0; j < 8; ++j) { const u32x2 yb = yc[j];
        f32x4 y; y[0] = __uint_as_float(yb.x << 16); y[1] = __uint_as_float(yb.x & 0xffff0000u); y[2] = __uint_as_float(yb.y << 16); y[3] = __uint_as_float(yb.y & 0xffff0000u);
        x[j] += GA[j] * (y * rinv);
        stf4s(xo, lo + 1024u * j, x[j]); }
    }
    if (DOH) {
      float ss = 0.f;
#pragma unroll
      for (int j = 0; j < 8; ++j) ss += (x[j][0] * x[j][0] + x[j][1] * x[j][1]) + (x[j][2] * x[j][2] + x[j][3] * x[j][3]);
      const float r = __builtin_amdgcn_rsqf(wave_sum(ss) * (1.0f / 2048.0f) + NORM_EPS);
      bf16_t* hr = H + (size_t)row * DM;
#pragma unroll
      for (int j = 0; j < 8; ++j) { const f32x4 h = x[j] * r * GB[j] + SH[j]; u32x2 w; w.x = pk2(h[0], h[1]); w.y = pk2(h[2], h[3]);
        *(u32x2*)((char*)hr + lo2 + 512u * j) = w; }
    }
  }
}
template <bool UPD, bool DOH, int NKC = 0>
__device__ __forceinline__ void norm_phase(const float* xin_lat, const float* xin_ctx, float* xout_lat, float* xout_ctx, const bf16_t* Y, const float* ssq,
    const float* gA, const float* gateM, const float* gB, const float* scM, const float* shM, bf16_t* H, bool skipctx, int gw, int NGW, int lane, const float* part = nullptr) {
  for (int ch = gw; ch < 2 * SEQ / 16; ch += NGW) { const int b = ch / (SEQ / 16), row0 = b * TB + CTXL + (ch - b * (SEQ / 16)) * 16;
    norm_rows<UPD, DOH, 0>(row0, 16, xin_lat, xin_ctx, xout_lat, xout_ctx, Y, ssq, gA, gateM, gB, scM, shM, H, lane, part); }
  if (!skipctx)
    for (int r = gw; r < 2 * CTXL; r += NGW) { const int b = r / CTXL, row0 = b * TB + (r - b * CTXL);
      norm_rows<UPD, DOH, NKC>(row0, 1, xin_lat, xin_ctx, xout_lat, xout_ctx, Y, ssq, gA, gateM, gB, scM, shM, H, lane, part); }
}

__global__ void __launch_bounds__(512, 2) mk_fwd(Args a) {
  extern __shared__ __attribute__((aligned(16))) unsigned char lds[];
  cg::grid_group grid = cg::this_grid();
  const int wave = __builtin_amdgcn_readfirstlane(threadIdx.x >> 6);
  const int G = gridDim.x, c = blockIdx.x, gw = c * 8 + wave, NGW = G * 8;
  LAS unsigned char* ldsL = (LAS unsigned char*)lds;
  unsigned char* ws = a.ws;
  const int lo = a.ph_lo, hi = a.ph_hi;
#define IN(k) (lo <= (k) && (k) < hi)
  unsigned* barw = (unsigned*)(ws + CTL_ZERO_BYTES - 256); unsigned bar_epoch = 0;
#define OWN_BAR() do { __builtin_amdgcn_fence(__ATOMIC_RELEASE, "workgroup"); __builtin_amdgcn_s_barrier(); bar_epoch += (unsigned)G; \
    if (wave == 0) { if (lane_id_v() == 0) { __builtin_amdgcn_fence(__ATOMIC_ACQUIRE, "workgroup"); __builtin_amdgcn_fence(__ATOMIC_RELEASE, "agent"); \
      __hip_atomic_fetch_add(barw, 1u, __ATOMIC_RELAXED, __HIP_MEMORY_SCOPE_AGENT); \
      while (__hip_atomic_load(barw, __ATOMIC_RELAXED, __HIP_MEMORY_SCOPE_AGENT) < bar_epoch) __builtin_amdgcn_s_sleep(1); \
      __builtin_amdgcn_fence(__ATOMIC_ACQUIRE, "agent"); __builtin_amdgcn_fence(__ATOMIC_RELEASE, "workgroup"); } } \
    __builtin_amdgcn_s_barrier(); __builtin_amdgcn_fence(__ATOMIC_ACQUIRE, "workgroup"); } while (0)
#define SEAM(k) do { if (IN(k) && IN((k) + 1)) { if ((k) == 0) grid.sync(); else { OWN_BAR(); if ((PROBE_PH >> 20) & 1) OWN_BAR(); } } } while (0)
  float* MOD = (float*)(ws + WS_MOD); float* SSQ = (float*)(ws + WS_SSQ);
  const float* RT = (const float*)(ws + WS_ROPE); const float* CT = RT + 256 * 16 * 2;
  float* XC = (float*)(ws + WS_XC); float* PART = (float*)(ws + WS_PART);
  bf16_t* S1 = (bf16_t*)(ws + WS_S1); bf16_t* S2 = (bf16_t*)(ws + WS_S2);
  bf16_t* Qb = (bf16_t*)(ws + WS_Q); bf16_t* KVb = (bf16_t*)(ws + WS_KV); bf16_t* KRb = (bf16_t*)(ws + WS_KR); bf16_t* Gb = (bf16_t*)(ws + WS_G);
  const float* gn = a.in[6];
#define MODP(l, chunk) (MOD + (size_t)(l) * 3 * 12288 + (chunk) * 2048)
#define RUN_GEMM(MODE, Ap, lda_, Bp, N_, K_, skip, ...) do { pg8::Gemm g{Ap, Bp, NROW, N_, K_, lda_, K_}; pg8::RowSched S; S.init((skip) ? 128 : 130, (N_) / 256, G, c, (skip) ? 1 : 0, (K_) == DFF ? 1 : 0); \
    pg8::Epi<MODE> E{__VA_ARGS__}; pg8::gemm_phase<pg8::Epi<MODE>, pg8::RowSched, true, true>(ldsL, g, S, E, wave); } while (0)
#define RUN_CTX_SPLIT(Ap, Bp, K_, NKC_) do { pg8::Gemm g{Ap, Bp, NROW, 2048, (K_) / (NKC_), K_, K_}; pg8::CtxSplitSched S; S.init(8, NKC_, G, c); \
    pg8::Epi<6> E{nullptr, 2048, nullptr, nullptr, nullptr, RT, CT, PART}; pg8::gemm_phase<pg8::Epi<6>, pg8::CtxSplitSched, true, true>(ldsL, g, S, E, wave); } while (0)

  if (IN(0)) { REP(0) p0_prologue(a, ldsL, gw, NGW, wave, lane_id_v(), rep_PROBE0); __syncthreads(); } SEAM(0);
  if (IN(1)) REP(1) norm_phase<false, true>(a.in[0], a.in[2], nullptr, nullptr, nullptr, nullptr, nullptr, nullptr, gn + 0 * 2048, MODP(0, 1), MODP(0, 0), S1, false, gw, NGW, lane_id_v());
  SEAM(1);
  if (IN(2)) REP(2) RUN_GEMM(1, S1, 2048, (const bf16_t*)(ws + WS_WIN), NP1, 2048, false, S2, NP1, SSQP(0), nullptr, KRb, RT, CT);
  SEAM(2);
  if (IN(3)) REP(3) {
    RUN_GEMM(2, S2, NP1, (const bf16_t*)(ws + WS_WQB), NQ, 512, false, Qb, NQ, nullptr, SSQ, nullptr, RT, CT);
    RUN_GEMM(3, S2 + 512, NP1, (const bf16_t*)(ws + WS_WKVB), NKV, 512, false, KVb, NKV, nullptr, SSQ + NROW, nullptr, RT, CT);
  }
  SEAM(3);
  if (IN(4)) REP(4) {
    const float SC = 0.07216878364870322f, Cc = SC * 1.4426950408889634f, THRS = 8.f / SC;
    for (int r = 0;; ++r) {
      const int u = c + r * G; if (u >= 2080) break;
      int b, h, rowq, NT;
      if (u < 2048) { int pair, qb; if (G == 256) { pair = (c & 7) * 4 + (r >> 1); qb = (c >> 3) + 32 * (r & 1); } else { pair = u >> 6; qb = u & 63; }
        b = pair >> 4; h = pair & 15; rowq = b * TB + CTXL + qb * 256; NT = TB / 64; }
      else { const int p = u - 2048; b = p >> 4; h = p & 15; rowq = b * TB; NT = CTXL / 64; }
      att::attn_unit<128, 128, false>(Qb + (size_t)rowq * NQ + h * 192, NQ, KVb + h * 256, NKV, KRb, 64, KVb + h * 256 + 128, NKV, S1 + (size_t)rowq * DM + h * 128, DM,
                                      NT, NT, b * TB, 0, 0, 0, Cc, THRS, -INFINITY, (char*)lds, ldsL, wave);
    }
  }
  SEAM(4);
  if (IN(5)) REP(5) { RUN_GEMM(0, S1, 2048, (const bf16_t*)(ws + WS_WOM), 2048, 2048, true, S2, 2048, SSQP(2), nullptr, nullptr, RT, CT);
    RUN_CTX_SPLIT(S1, (const bf16_t*)(ws + WS_WOM), 2048, 8); }
  SEAM(5);
  if (IN(6)) norm_phase<true, true, 8>(a.in[0], a.in[2], a.out, XC, S2, SSQ + 2 * NROW, gn + 1 * 2048, MODP(0, 2), gn + 2 * 2048, MODP(0, 4), MODP(0, 3), S1, false, gw, NGW, lane_id_v(), PART);
  SEAM(6);
  if (IN(7)) REP(7) RUN_GEMM(4, S1, 2048, (const bf16_t*)(ws + WS_WF1), DFF, 2048, false, Gb, DFF, nullptr, nullptr, nullptr, RT, CT);
  SEAM(7);
  if (IN(8)) REP(8) { RUN_GEMM(0, Gb, DFF, (const bf16_t*)(ws + WS_WF2), 2048, DFF, true, S2, 2048, SSQP(3), nullptr, nullptr, RT, CT);
    RUN_CTX_SPLIT(Gb, (const bf16_t*)(ws + WS_WF2), DFF, 16); }
  SEAM(8);
  if (IN(9)) norm_phase<true, true, 16>(a.out, XC, a.out, XC, S2, SSQ + 3 * NROW, gn + 3 * 2048, MODP(0, 5), gn + 4 * 2048, MODP(1, 1), MODP(1, 0), S1, false, gw, NGW, lane_id_v(), PART);
  SEAM(9);
  if (IN(10)) REP(10) RUN_GEMM(5, S1, 2048, (const bf16_t*)(ws + WS_WQKV), NQKV, 2048, false, Gb, NQKV, nullptr, nullptr, nullptr, RT, CT);
  SEAM(10);
  if (IN(11)) REP(11) {
    const float SC = 0.125f, Cc = SC * 1.4426950408889634f, THRS = 8.f / SC;
    const int cx = (G == 256) ? (c & 7) * 32 + (c >> 3) : c;
    for (int u = cx; u < 4096; u += G) {
      const int pairkv = u >> 9, qb32 = u & 511, b = pairkv >> 2, kvh = pairkv & 3, t0 = qb32 * 32;
      int f = (t0 - 128) < 0 ? 0 : (t0 - 128) >> 6, l = (t0 + 159) >> 6; if (l > SEQ / 64 - 1) l = SEQ / 64 - 1;
      if ((l - f + 1) & 1) { if (l < SEQ / 64 - 1) ++l; else --f; }
      const int nwin = l - f + 1, tstart = 64 * f;
      const int rowq = b * TB + CTXL + t0;
      att::attn_unit<0, 64, true>(Gb + (size_t)rowq * NQKV + kvh * 512, NQKV, nullptr, 0, Gb + 2048 + kvh * 64, NQKV, Gb + 2304 + kvh * 64, NQKV, S1 + (size_t)rowq * DM + kvh * 512, DM,
                                  4 + nwin, 4, b * TB, b * TB + CTXL + tstart, t0, tstart, Cc, THRS, a.in[16][kvh * 8 + wave] * 1.4426950408889634f, (char*)lds, ldsL, wave);
    }
  }
  SEAM(11);
  if (IN(12)) REP(12) RUN_GEMM(0, S1, 2048, (const bf16_t*)(ws + WS_WOS), 2048, 2048, true, S2, 2048, SSQP(4), nullptr, nullptr, RT, CT);
  SEAM(12);
  if (IN(13)) norm_phase<true, true>(a.out, XC, a.out, XC, S2, SSQ + 4 * NROW, gn + 5 * 2048, MODP(1, 2), gn + 6 * 2048, MODP(1, 4), MODP(1, 3), S1, true, gw, NGW, lane_id_v());
  SEAM(13);
  if (IN(14)) REP(14) RUN_GEMM(4, S1, 2048, (const bf16_t*)(ws + WS_WF1) + (size_t)2048 * 8192, DFF, 2048, true, Gb, DFF, nullptr, nullptr, nullptr, RT, CT);
  SEAM(14);
  if (IN(15)) REP(15) RUN_GEMM(0, Gb, DFF, (const bf16_t*)(ws + WS_WF2) + (size_t)2048 * 8192, 2048, DFF, true, S2, 2048, SSQP(5), nullptr, nullptr, RT, CT);
  SEAM(15);
  if (IN(16)) norm_phase<true, false>(a.out, XC, a.out, XC, S2, SSQ + 5 * NROW, gn + 7 * 2048, MODP(1, 5), nullptr, nullptr, nullptr, nullptr, true, gw, NGW, lane_id_v());
#undef IN
#undef SEAM
}

extern "C" void kernel_launch(void* const* d_in, const int* in_sizes, int n_in, void* d_out, int out_size, void* d_ws, size_t ws_size, hipStream_t stream) {
  static int grid = 0;
  if (grid == 0) {
    if (n_in != 18 || out_size != 2 * SEQ * DM || ws_size < WS_END) { fprintf(stderr, "kernel_launch: unexpected shapes: n_in %d out %d ws %zu (need %zu)\n", n_in, out_size, ws_size, (size_t)WS_END); grid = -1; return; }
    int dev = 0, cus = 0, per_cu = 0;
    hipGetDevice(&dev); hipDeviceGetAttribute(&cus, hipDeviceAttributeMultiprocessorCount, dev);
    if (hipFuncSetAttribute((const void*)mk_fwd, hipFuncAttributeMaxDynamicSharedMemorySize, LDS_BYTES) != hipSuccess) { fprintf(stderr, "kernel_launch: hipFuncSetAttribute failed\n"); grid = -1; return; }
    if (hipOccupancyMaxActiveBlocksPerMultiprocessor(&per_cu, (const void*)mk_fwd, 512, LDS_BYTES) != hipSuccess || per_cu < 1) { fprintf(stderr, "kernel_launch: occupancy query gave %d\n", per_cu); per_cu = 1; }
    (void)hipGetLastError();
    grid = cus * per_cu;
    fprintf(stderr, "kernel_launch: grid %d (cus %d x %d)\n", grid, cus, per_cu);
  }
  if (grid < 0) return;
  hipMemsetAsync((char*)d_ws, 0, CTL_ZERO_BYTES, stream);
  Args a{};
  for (int i = 0; i < 18; ++i) a.in[i] = (const float*)d_in[i];
  a.out = (float*)d_out; a.ws = (unsigned char*)d_ws; a.ph_lo = 0; a.ph_hi = N_PHASES;
  void* args[] = {&a};
  hipError_t e = hipLaunchCooperativeKernel((const void*)mk_fwd, dim3(grid), dim3(512), args, LDS_BYTES, stream);
  if (e != hipSuccess) fprintf(stderr, "kernel_launch: cooperative launch failed: %s (grid %d)\n", hipGetErrorString(e), grid);
}
```

```cpp
#include <hip/hip_runtime.h>
#include <hip/hip_cooperative_groups.h>
#include <cstdio>
#include <cstdint>
namespace cg = cooperative_groups;

constexpr int DM = 2048, SEQ = 16384, CTXL = 256, TB = SEQ + CTXL  , NROW = 2 * TB  , DFF = 8192;
constexpr int NP1 = 1280  , NQ = 3072, NKV = 4096, NQKV = 2560;
constexpr float NORM_EPS = 1e-6f;
__device__ __forceinline__ int lane_id_v() { int l; asm volatile("v_mbcnt_lo_u32_b32 %0, -1, 0\n\tv_mbcnt_hi_u32_b32 %0, -1, %0" : "=v"(l)); return l; }
namespace pg8 {
#define PG8_LAS __attribute__((address_space(3)))
typedef unsigned short bf16_t;
typedef short bf16x8 __attribute__((ext_vector_type(8)));
typedef float f32x4 __attribute__((ext_vector_type(4)));
typedef unsigned u32x4 __attribute__((ext_vector_type(4)));
constexpr int BM = 256, BK = 64, HALF = 128, HTB = HALF * BK * 2  , STAGE_BYTES = 8 * HTB, NXCD = 8, WGM = 4;

__host__ __device__ __forceinline__ int lds_byte(int r, int c) { const int st = (r >> 4) * 2 + (c >> 5), rr = r & 15, cc = c & 31, ob = rr * 64 + cc * 2; return st * 1024 + (ob ^ (((ob >> 9) & 1) << 5)); }
__host__ __device__ __forceinline__ void stage_rc(int b, int& R, int& C) { const int st = b / 1024, sb = b % 1024, swz = sb ^ (((sb >> 9) & 1) << 5); R = (st >> 1) * 16 + swz / 64; C = (st & 1) * 32 + (swz % 64) / 2; }
__host__ __device__ __forceinline__ int perm32(int rho) { const int n = rho >> 4, i = rho & 15; return 8 * (i >> 2) + 4 * n + (i & 3); }

struct Unit { int pm, pn, kc; };
struct Gemm { const bf16_t* A; const bf16_t* Bt; int M, N, K, lda, ldb; };

struct StaticOrder {
    int nM, nN, nwg, G, c;
    __host__ __device__ void init(int M, int N, int G_, int c_) { nM = M / BM; nN = N / BM; nwg = nM * nN; G = G_; c = c_; }
    __host__ __device__ bool next(int i, Unit& u) const {
        const long L = (long)i * G + c; if (L >= nwg) return false;
        int wgid = (int)L; { const int q = nwg / NXCD, r = nwg % NXCD, xcd = wgid % NXCD, off = wgid / NXCD; wgid = (xcd < r ? xcd * (q + 1) : r * (q + 1) + (xcd - r) * q) + off; }
        const int nig = WGM * nN, gid = wgid / nig, fm = gid * WGM, gsz = (nM - fm) < WGM ? (nM - fm) : WGM;
        u.pm = fm + ((wgid % nig) % gsz); u.pn = (wgid % nig) / gsz; return true;
    }
    __device__ __forceinline__ void a_ready(const Unit&) const {}
    __device__ __forceinline__ void done(const Unit&) const {}
};


__device__ __forceinline__ unsigned cvt_pk_bf16(float lo, float hi) { unsigned r; asm volatile("v_cvt_pk_bf16_f32 %0, %1, %2" : "=v"(r) : "v"(lo), "v"(hi)); return r; }

struct RowSched {
    int nM, nN, nwg, G, c, skipctx, rev;
    __device__ void init(int nM_, int nN_, int G_, int c_, int skipctx_, int rev_ = 0) { nM = nM_; nN = nN_; nwg = nM * nN; G = G_; c = c_; skipctx = skipctx_; rev = rev_; }
    __device__ bool next(int i, Unit& u) const {
        const long L = (long)i * G + c; if (L >= nwg) return false;
        int wgid = (int)L; { const int q = nwg / NXCD, r = nwg % NXCD, xcd = wgid % NXCD, off = wgid / NXCD; wgid = (xcd < r ? xcd * (q + 1) : r * (q + 1) + (xcd - r) * q) + off; }
        const int nig = WGM * nN, gid = wgid / nig, fm = gid * WGM, gsz = (nM - fm) < WGM ? (nM - fm) : WGM;
        int pm = fm + ((wgid % nig) % gsz); u.pn = (wgid % nig) / gsz;
        if (rev) pm = nM - 1 - pm;
        if (skipctx) pm += 1 + (pm >= 64 ? 1 : 0);
        u.pm = pm; u.kc = 0; return true;
    }
    __device__ __forceinline__ void a_ready(const Unit&) const {}
    __device__ __forceinline__ void done(const Unit&) const {}
};

struct CtxSplitSched {
    int nN, NKC, nwg, G, c;
    __device__ void init(int nN_, int NKC_, int G_, int c_) { nN = nN_; NKC = NKC_; nwg = 2 * nN * NKC; G = G_; c = c_; }
    __device__ bool next(int i, Unit& u) const {
        const long L = (long)i * G + c; if (L >= nwg) return false;
        const int l = (int)L, t = l / NKC; u.kc = l - t * NKC; u.pn = t % nN; u.pm = (t / nN) ? 65 : 0; return true;
    }
    __device__ __forceinline__ void a_ready(const Unit&) const {}
    __device__ __forceinline__ void done(const Unit&) const {}
};

template <int MODE> struct Epi {
    static constexpr bool PERM = true, AFTER_DRAIN = false;
    bf16_t* O; int ldc;
    float* ssq;
    const float* rssq;
    bf16_t* KR;
    const float* rtab; const float* ctab;
    float* part;
    __device__ __forceinline__ void operator()(const f32x4 (&acc)[2][2][4][2], const Unit& u, int wr, int wc, int fr, int fq) const {
        const int pm = u.pm, pn = u.pn;
        const bool isctx = (pm == 0) || (pm == 65);
        const int tbase = (pm > 65 ? pm - 66 : pm - 1) * 256;
#pragma unroll
        for (int ai = 0; ai < 2; ++ai)
#pragma unroll
            for (int m = 0; m < 4; ++m) {
                const int rt = ai * HALF + wr * 64 + m * 16 + fr;
                const int row = pm * BM + rt;
                const int t = tbase + rt;
                float rs = 1.f;
                if (MODE == 2 || MODE == 3) rs = __builtin_amdgcn_rsqf(rssq[row] * (1.0f / 512.0f) + 1e-6f);
                float sq = 0.f;
#pragma unroll
                for (int bj = 0; bj < 2; ++bj) {
                    const int col = pn * BM + bj * HALF + wc * 32 + 8 * fq;
                    f32x4 v0 = acc[ai][bj][m][0], v1 = acc[ai][bj][m][1];
                    if (MODE == 6) { float* pp = part + ((size_t)u.kc * 512 + (pm == 65 ? 256 : 0) + rt) * ldc + col; *(f32x4*)pp = v0; *(f32x4*)(pp + 4) = v1; continue; }
                    if (MODE == 2 || MODE == 3) { v0 = v0 * rs; v1 = v1 * rs; }
                    if (MODE == 0 || MODE == 1) sq += (v0[0] * v0[0] + v0[1] * v0[1]) + (v0[2] * v0[2] + v0[3] * v0[3]) + (v1[0] * v1[0] + v1[1] * v1[1]) + (v1[2] * v1[2] + v1[3] * v1[3]);
                    bool dorope = false; int i0 = 0;
                    if (MODE == 2) { const int hc = col % 192; dorope = (!isctx) && (hc >= 128); i0 = (hc - 128) >> 1; }
                    if (MODE == 5) { dorope = (!isctx) && (col < 2304); i0 = (col & 63) >> 1; }
                    if (MODE == 1) { dorope = (!isctx) && (pn == 4) && (col < 1088); i0 = (col - 1024) >> 1; }
                    if (MODE == 1 || MODE == 2 || MODE == 5) {
                        if (dorope) {
                            const float* tb = (i0 < 16) ? (rtab + ((t >> 6) * 16 + i0) * 2) : (ctab + ((t & 63) * 16 + (i0 - 16)) * 2);
                            const f32x4 c0 = *(const f32x4*)tb, c1 = *(const f32x4*)(tb + 4);
                            f32x4 w0, w1;
                            w0[0] = v0[0] * c0[0] - v0[1] * c0[1]; w0[1] = v0[0] * c0[1] + v0[1] * c0[0];
                            w0[2] = v0[2] * c0[2] - v0[3] * c0[3]; w0[3] = v0[2] * c0[3] + v0[3] * c0[2];
                            w1[0] = v1[0] * c1[0] - v1[1] * c1[1]; w1[1] = v1[0] * c1[1] + v1[1] * c1[0];
                            w1[2] = v1[2] * c1[2] - v1[3] * c1[3]; w1[3] = v1[2] * c1[3] + v1[3] * c1[2];
                            v0 = w0; v1 = w1;
                        }
                    }
                    if (MODE == 4) {
#pragma unroll
                        for (int e = 0; e < 4; ++e) { const float a = fmaxf(v0[e], 0.f), b = fmaxf(v1[e], 0.f); v0[e] = a * a; v1[e] = b * b; }
                    }
                    u32x4 w; w.x = cvt_pk_bf16(v0[0], v0[1]); w.y = cvt_pk_bf16(v0[2], v0[3]); w.z = cvt_pk_bf16(v1[0], v1[1]); w.w = cvt_pk_bf16(v1[2], v1[3]);
                    if (MODE == 1 && pn == 4) { if (col < 1088) *(u32x4*)(KR + (size_t)row * 64 + (col - 1024)) = w; }
                    else if (MODE == 3) { const int b_ = pm >= 65 ? 1 : 0;
                        *(u32x4*)(O + ((size_t)(b_ * 16 + pn) * TB + (row - b_ * TB)) * 256 + (col - pn * BM)) = w; }
                    else *(u32x4*)(O + (size_t)row * ldc + col) = w;
                }
                if (MODE == 0 || MODE == 1) {
                    if (MODE == 0 || pn < 4) {
                        sq += __shfl_xor(sq, 16); sq += __shfl_xor(sq, 32);
                        if (fq == 0) atomicAdd(ssq + (MODE == 1 ? (size_t)(pn >> 1) * NROW : (size_t)0) + row, sq);
                    }
                }
            }
    }
};

template <class Epi, class Sched, bool ALIGN_EPI = false, bool SP2 = false>
__device__ __forceinline__ void gemm_phase(PG8_LAS unsigned char* lds, const Gemm g, const Sched& S, const Epi& E, const int wave_) {
    const int wid = wave_, lane = lane_id_v(), tid = wid * 64 + lane, wr = wid >> 2, wc = wid & 3, fr = lane & 15, fq = lane >> 4;
    const int K = g.K, nt = K / BK, lda = g.lda, ldb = g.ldb;
    unsigned voffA[2], voffB[2];
#pragma unroll
    for (int i = 0; i < 2; ++i) { int R, C; stage_rc(tid * 16 + i * 8192, R, C); const int Rb = Epi::PERM ? ((R & ~31) + perm32(R & 31)) : R;
        voffA[i] = (unsigned)(R * lda + C) * 2u; voffB[i] = (unsigned)(Rb * ldb + C) * 2u; }
    const size_t kstep = (size_t)(BK * 2);
    const size_t hstepA = (size_t)HALF * lda * 2, hstepB = (size_t)HALF * ldb * 2;
    const size_t tstepA = 2 * hstepA, tstepB = 2 * hstepB;
    const unsigned ldsw = (unsigned)wid * 1024u;
    const int aoff = lds_byte(wr * 64 + fr, fq * 8), boff = lds_byte(wc * 32 + fr, fq * 8);
#define PG8_SA(b, h) (((b) * 2 + (h)) * HTB)
#define PG8_SB(b, h) ((4 + (b) * 2 + (h)) * HTB)
#define PG8_STAGE(bufoff, gbase, voff) do { _Pragma("unroll") for (int _i = 0; _i < 2; ++_i) \
        __builtin_amdgcn_global_load_lds((const unsigned*)((const char*)(gbase) + (voff)[_i]), (PG8_LAS unsigned*)(lds + (bufoff) + ldsw + _i * 8192), 16, 0, 0); } while (0)
#define PG8_LDA(dst, b, h) do { _Pragma("unroll") for (int m = 0; m < 4; ++m) _Pragma("unroll") for (int k = 0; k < 2; ++k) dst[m][k] = *(const PG8_LAS bf16x8*)(lds + PG8_SA(b, h) + aoff + m * 2048 + k * 1024); } while (0)
#define PG8_LDB(dst, b, h) do { _Pragma("unroll") for (int n = 0; n < 2; ++n) _Pragma("unroll") for (int k = 0; k < 2; ++k) dst[n][k] = *(const PG8_LAS bf16x8*)(lds + PG8_SB(b, h) + boff + n * 2048 + k * 1024); } while (0)
#define PG8_MMA(ai, bj, At, Bt) do { __builtin_amdgcn_s_setprio(1); _Pragma("unroll") for (int m = 0; m < 4; ++m) _Pragma("unroll") for (int n = 0; n < 2; ++n) _Pragma("unroll") for (int k = 0; k < 2; ++k) \
        acc[ai][bj][m][n] = __builtin_amdgcn_mfma_f32_16x16x32_bf16(Bt[n][k], At[m][k], acc[ai][bj][m][n], 0, 0, 0); __builtin_amdgcn_s_setprio(0); } while (0)
#define PG8_WAIT_V(n) asm volatile("s_waitcnt vmcnt(" #n ")" ::: "memory")
#define PG8_WAIT_L(n) asm volatile("s_waitcnt lgkmcnt(" #n ")" ::: "memory")
#define PG8_BAR __builtin_amdgcn_s_barrier()
#define PG8_SCHED __builtin_amdgcn_sched_barrier(0)
    Unit cur, nxt; int ui = 0;
    if (!S.next(0, cur)) return;
    f32x4 acc[2][2][4][2];
#pragma unroll
    for (int a = 0; a < 2; ++a)
#pragma unroll
        for (int b = 0; b < 2; ++b)
#pragma unroll
            for (int m = 0; m < 4; ++m)
#pragma unroll
                for (int n = 0; n < 2; ++n) acc[a][b][m][n] = (f32x4){0.f, 0.f, 0.f, 0.f};
    bf16x8 At[4][2], B0[2][2], B1[2][2];
    const char* cA = (const char*)g.A + (size_t)cur.pm * tstepA + (size_t)cur.kc * K * 2; const char* cB = (const char*)g.Bt + (size_t)cur.pn * tstepB + (size_t)cur.kc * K * 2;
    S.a_ready(cur);
    if constexpr (SP2) {
        PG8_STAGE(PG8_SB(0, 0), cB, voffB); PG8_STAGE(PG8_SB(0, 1), cB + hstepB, voffB); PG8_STAGE(PG8_SA(0, 0), cA, voffA); PG8_STAGE(PG8_SA(0, 1), cA + hstepA, voffA);
        if (wr == 1) PG8_BAR;
        PG8_WAIT_V(2); PG8_BAR;
        PG8_STAGE(PG8_SB(1, 0), cB + kstep, voffB); PG8_STAGE(PG8_SA(1, 0), cA + kstep, voffA); PG8_STAGE(PG8_SB(1, 1), cB + hstepB + kstep, voffB);
        PG8_WAIT_V(6); PG8_BAR;
    } else {
        PG8_STAGE(PG8_SB(0, 0), cB, voffB); PG8_STAGE(PG8_SA(0, 0), cA, voffA); PG8_STAGE(PG8_SB(0, 1), cB + hstepB, voffB); PG8_STAGE(PG8_SA(0, 1), cA + hstepA, voffA);
        if (wr == 1) PG8_BAR;
        PG8_WAIT_V(4); PG8_BAR;
        PG8_STAGE(PG8_SB(1, 0), cB + kstep, voffB); PG8_STAGE(PG8_SA(1, 0), cA + kstep, voffA); PG8_STAGE(PG8_SB(1, 1), cB + hstepB + kstep, voffB);
        PG8_WAIT_V(6); PG8_BAR;
    }
    for (;;) {
        const bool has_next = S.next(ui + 1, nxt);
        const char* nA = has_next ? (const char*)g.A + (size_t)nxt.pm * tstepA + (size_t)nxt.kc * K * 2 : cA; const char* nB = has_next ? (const char*)g.Bt + (size_t)nxt.pn * tstepB + (size_t)nxt.kc * K * 2 : cB;
        for (int t = 0; t < nt; t += 2) {
            const bool last = (t == nt - 2);
            const char* a1 = cA + (size_t)(t + 1) * kstep;
            const char* a2 = last ? nA : cA + (size_t)(t + 2) * kstep; const char* b2 = last ? nB : cB + (size_t)(t + 2) * kstep;
            const char* a3 = a2 + kstep; const char* b3 = b2 + kstep;
            if (last && has_next) S.a_ready(nxt);
            if constexpr (SP2) {
            PG8_LDB(B0, 0, 0); PG8_LDB(B1, 0, 1); PG8_SCHED; PG8_LDA(At, 0, 0); PG8_STAGE(PG8_SA(1, 1), a1 + hstepA, voffA);
            PG8_WAIT_V(8); PG8_WAIT_L(0); PG8_BAR; PG8_MMA(0, 0, At, B0); PG8_MMA(0, 1, At, B1); PG8_BAR; PG8_SCHED;
            PG8_LDA(At, 0, 1); PG8_STAGE(PG8_SB(0, 0), b2, voffB); PG8_STAGE(PG8_SB(0, 1), b2 + hstepB, voffB); PG8_STAGE(PG8_SA(0, 0), a2, voffA);
            PG8_WAIT_V(8); PG8_WAIT_L(0); PG8_BAR; PG8_MMA(1, 0, At, B0); PG8_MMA(1, 1, At, B1); PG8_BAR; PG8_SCHED;
            PG8_LDB(B0, 1, 0); PG8_LDB(B1, 1, 1); PG8_SCHED; PG8_LDA(At, 1, 0); PG8_STAGE(PG8_SA(0, 1), a2 + hstepA, voffA);
            PG8_WAIT_V(8); PG8_WAIT_L(0); PG8_BAR; PG8_MMA(0, 0, At, B0); PG8_MMA(0, 1, At, B1); PG8_BAR; PG8_SCHED;
            PG8_LDA(At, 1, 1); PG8_STAGE(PG8_SB(1, 0), b3, voffB); PG8_STAGE(PG8_SB(1, 1), b3 + hstepB, voffB); PG8_STAGE(PG8_SA(1, 0), a3, voffA);
            PG8_WAIT_V(8); PG8_WAIT_L(0); PG8_BAR; PG8_MMA(1, 0, At, B0); PG8_MMA(1, 1, At, B1); PG8_BAR; PG8_SCHED;
            } else {
            PG8_LDB(B0, 0, 0); PG8_SCHED; PG8_LDA(At, 0, 0); PG8_STAGE(PG8_SA(1, 1), a1 + hstepA, voffA);
            PG8_WAIT_L(8); PG8_BAR; PG8_WAIT_L(0); PG8_MMA(0, 0, At, B0); PG8_BAR; PG8_SCHED;
            PG8_LDB(B1, 0, 1); PG8_STAGE(PG8_SB(0, 0), b2, voffB);
            PG8_BAR; PG8_WAIT_L(0); PG8_MMA(0, 1, At, B1); PG8_BAR;
            PG8_LDA(At, 0, 1); PG8_STAGE(PG8_SA(0, 0), a2, voffA);
            PG8_BAR; PG8_WAIT_L(0); PG8_MMA(1, 0, At, B0); PG8_BAR; PG8_SCHED;
            PG8_STAGE(PG8_SB(0, 1), b2 + hstepB, voffB);
            PG8_WAIT_V(6); PG8_BAR; PG8_MMA(1, 1, At, B1); PG8_BAR;
            PG8_LDB(B0, 1, 0); PG8_SCHED; PG8_LDA(At, 1, 0); PG8_STAGE(PG8_SA(0, 1), a2 + hstepA, voffA);
            PG8_WAIT_L(8); PG8_BAR; PG8_WAIT_L(0); PG8_MMA(0, 0, At, B0); PG8_BAR; PG8_SCHED;
            PG8_LDB(B1, 1, 1); PG8_STAGE(PG8_SB(1, 0), b3, voffB);
            PG8_BAR; PG8_WAIT_L(0); PG8_MMA(0, 1, At, B1); PG8_BAR;
            PG8_LDA(At, 1, 1); PG8_STAGE(PG8_SA(1, 0), a3, voffA);
            PG8_BAR; PG8_WAIT_L(0); PG8_MMA(1, 0, At, B0); PG8_BAR; PG8_SCHED;
            PG8_STAGE(PG8_SB(1, 1), b3 + hstepB, voffB);
            PG8_WAIT_V(6); PG8_BAR; PG8_MMA(1, 1, At, B1); PG8_BAR;
            }
        }
        if constexpr (ALIGN_EPI) { if (wr == 0) PG8_BAR; }
        if constexpr (!Epi::AFTER_DRAIN) { E(acc, cur, wr, wc, fr, fq); S.done(cur); }
        if (!has_next) break;
#pragma unroll
        for (int a = 0; a < 2; ++a)
#pragma unroll
            for (int b = 0; b < 2; ++b)
#pragma unroll
                for (int m = 0; m < 4; ++m)
#pragma unroll
                    for (int n = 0; n < 2; ++n) acc[a][b][m][n] = (f32x4){0.f, 0.f, 0.f, 0.f};
        cur = nxt; cA = nA; cB = nB; ++ui;
        if constexpr (ALIGN_EPI) { if (wr == 1) PG8_BAR; }
    }
    PG8_WAIT_V(0);
    if constexpr (!ALIGN_EPI) { if (wr == 0) PG8_BAR; }
    PG8_BAR;
    if constexpr (Epi::AFTER_DRAIN) { E.fused(acc, cur, wr, wc, fr, fq, lds, wid, lane); S.done(cur); }
#undef PG8_SA
#undef PG8_SB
#undef PG8_STAGE
#undef PG8_LDA
#undef PG8_LDB
#undef PG8_MMA
#undef PG8_WAIT_V
#undef PG8_WAIT_L
#undef PG8_BAR
#undef PG8_SCHED
}
}

namespace att {
typedef unsigned short bf16_t;
using bf16x8 = __attribute__((ext_vector_type(8))) short;
using s16x4  = __attribute__((ext_vector_type(4))) short;
using f32x16 = __attribute__((ext_vector_type(16))) float;
using u32x4  = __attribute__((ext_vector_type(4))) unsigned;
#define KSWZ(row, colB) ((row) * 256 + ((colB) ^ (((row) & 15) << 4)))
#define KSWZ64(row, colB) ((row) * 128 + ((colB) ^ ((((row) >> 1) & 7) << 4)))
#define SBAR() __builtin_amdgcn_sched_barrier(0)
__device__ __forceinline__ int crow(int r, int hi) { return (r & 3) + 8 * (r >> 2) + 4 * hi; }
__device__ __forceinline__ unsigned cvtpk(float lo, float hi) { unsigned r; asm volatile("v_cvt_pk_bf16_f32 %0, %1, %2" : "=v"(r) : "v"(lo), "v"(hi)); return r; }

__device__ __forceinline__ void partialSM(f32x16& p0, f32x16& p1, float& m_reg, float& alpha, const float C, const float THRS) {
  float pmax = p0[0];
#pragma unroll
  for (int r = 1; r < 16; ++r) pmax = fmaxf(pmax, p0[r]);
#pragma unroll
  for (int r = 0; r < 16; ++r) pmax = fmaxf(pmax, p1[r]);
  { auto rr = __builtin_amdgcn_permlane32_swap(__float_as_uint(pmax), __float_as_uint(pmax), false, false);
    pmax = fmaxf(__uint_as_float(rr[0]), __uint_as_float(rr[1])); }
  float mn;
  if (__builtin_expect(__all(pmax - m_reg <= THRS), 1)) { mn = m_reg; alpha = 1.f; }
  else { mn = fmaxf(m_reg, pmax); alpha = __builtin_amdgcn_exp2f((m_reg - mn) * C); m_reg = mn; }
  const float mnC = -mn * C;
#pragma unroll
  for (int r = 0; r < 16; ++r) p0[r] = fmaf(p0[r], C, mnC);
#pragma unroll
  for (int r = 0; r < 16; ++r) p1[r] = fmaf(p1[r], C, mnC);
#pragma unroll
  for (int r = 0; r < 16; ++r) p0[r] = __builtin_amdgcn_exp2f(p0[r]);
}
__device__ __forceinline__ void finishSM(f32x16& p0, f32x16& p1, float alpha, float& l_reg, bf16x8& pa0, bf16x8& pa1, bf16x8& pa2, bf16x8& pa3) {
#pragma unroll
  for (int r = 0; r < 16; ++r) p1[r] = __builtin_amdgcn_exp2f(p1[r]);
  float ps = 0;
#pragma unroll
  for (int r = 0; r < 16; ++r) ps += p0[r];
#pragma unroll
  for (int r = 0; r < 16; ++r) ps += p1[r];
  { auto rr = __builtin_amdgcn_permlane32_swap(__float_as_uint(ps), __float_as_uint(ps), false, false);
    ps = __uint_as_float(rr[0]) + __uint_as_float(rr[1]); }
  l_reg = l_reg * alpha + ps;
#define PK4(P, BASE, OUT) do { unsigned a0 = cvtpk(P[BASE + 0], P[BASE + 1]), a1 = cvtpk(P[BASE + 2], P[BASE + 3]);   \
    unsigned b0 = cvtpk(P[BASE + 4], P[BASE + 5]), b1 = cvtpk(P[BASE + 6], P[BASE + 7]);                              \
    auto r0 = __builtin_amdgcn_permlane32_swap(a0, b0, false, false); auto r1 = __builtin_amdgcn_permlane32_swap(a1, b1, false, false); \
    u32x4 w = {r0[0], r1[0], r0[1], r1[1]}; OUT = *reinterpret_cast<bf16x8*>(&w); } while (0)
  PK4(p0, 0, pa0); PK4(p0, 8, pa1); PK4(p1, 0, pa2); PK4(p1, 8, pa3);
#undef PK4
}
template <int DN>
__device__ __forceinline__ void qkt(f32x16& p0, f32x16& p1, const char* Kn, const char* Kr, const bf16x8* qr, const char* qrl, int r32, int hi) {
  p0 = f32x16{}; p1 = f32x16{};
  if constexpr (DN > 0) {
#pragma unroll
    for (int d0 = 0; d0 < DN / 16; ++d0) { const int cb = (d0 * 16 + hi * 8) * 2;
      bf16x8 b0 = *reinterpret_cast<const bf16x8*>(Kn + KSWZ(r32, cb));
      bf16x8 b1 = *reinterpret_cast<const bf16x8*>(Kn + KSWZ(32 + r32, cb));
      p0 = __builtin_amdgcn_mfma_f32_32x32x16_bf16(b0, qr[d0], p0, 0, 0, 0);
      p1 = __builtin_amdgcn_mfma_f32_32x32x16_bf16(b1, qr[d0], p1, 0, 0, 0); }
  }
#pragma unroll
  for (int d0 = 0; d0 < 4; ++d0) { const int cb = (d0 * 16 + hi * 8) * 2;
    bf16x8 b0 = *reinterpret_cast<const bf16x8*>(Kr + KSWZ64(r32, cb));
    bf16x8 b1 = *reinterpret_cast<const bf16x8*>(Kr + KSWZ64(32 + r32, cb));
    bf16x8 q; if constexpr (DN > 0) q = *reinterpret_cast<const bf16x8*>(qrl + d0 * 1024); else q = qr[d0];
    p0 = __builtin_amdgcn_mfma_f32_32x32x16_bf16(b0, q, p0, 0, 0, 0);
    p1 = __builtin_amdgcn_mfma_f32_32x32x16_bf16(b1, q, p1, 0, 0, 0); }
}
__device__ __forceinline__ void band_mask(f32x16& p0, f32x16& p1, int d) {
#pragma unroll
  for (int r = 0; r < 16; ++r) { const int v = d - ((r & 3) + 8 * (r >> 2));
    if (v > 128 || v < -128) p0[r] = -1e30f;
    if (v - 32 > 128 || v - 32 < -128) p1[r] = -1e30f; }
}
__device__ __forceinline__ int v_rd_base(int lane) { return ((lane & 3) << 3) | (((lane >> 2) & 3) << 6) | (((lane >> 4) & 1) << 5) | (((lane >> 5) & 1) << 8); }
template <int NCB> constexpr int v_rd_off(int d0, int ks, int half) { return d0 * 512 + ks * (2 * NCB * 512) + half * (NCB * 512); }
template <int OFF> __device__ __forceinline__ s16x4 tr_read(int vb) {
  s16x4 r; asm volatile("ds_read_b64_tr_b16 %0, %1 offset:%2" : "=&v"(r) : "v"(vb), "i"(OFF) : "memory"); return r;
}
template <int D0, int NCB> __device__ __forceinline__ void pv_one(f32x16& od, int vb, bf16x8 pa0, bf16x8 pa1, bf16x8 pa2, bf16x8 pa3) {
  const s16x4 l0 = tr_read<v_rd_off<NCB>(D0, 0, 0)>(vb), h0 = tr_read<v_rd_off<NCB>(D0, 0, 1)>(vb), l1 = tr_read<v_rd_off<NCB>(D0, 1, 0)>(vb), h1 = tr_read<v_rd_off<NCB>(D0, 1, 1)>(vb);
  const s16x4 l2 = tr_read<v_rd_off<NCB>(D0, 2, 0)>(vb), h2 = tr_read<v_rd_off<NCB>(D0, 2, 1)>(vb), l3 = tr_read<v_rd_off<NCB>(D0, 3, 0)>(vb), h3 = tr_read<v_rd_off<NCB>(D0, 3, 1)>(vb);
  asm volatile("s_waitcnt lgkmcnt(0)" ::: "memory"); SBAR();
#define PK(L, H) (bf16x8){L[0], L[1], L[2], L[3], H[0], H[1], H[2], H[3]}
  od = __builtin_amdgcn_mfma_f32_32x32x16_bf16(pa0, PK(l0, h0), od, 0, 0, 0);
  od = __builtin_amdgcn_mfma_f32_32x32x16_bf16(pa1, PK(l1, h1), od, 0, 0, 0);
  od = __builtin_amdgcn_mfma_f32_32x32x16_bf16(pa2, PK(l2, h2), od, 0, 0, 0);
  od = __builtin_amdgcn_mfma_f32_32x32x16_bf16(pa3, PK(l3, h3), od, 0, 0, 0);
#undef PK
}
template <int NCB> __device__ __forceinline__ void pv_all(f32x16* o, int vb, bf16x8 pa0, bf16x8 pa1, bf16x8 pa2, bf16x8 pa3) {
  pv_one<0, NCB>(o[0], vb, pa0, pa1, pa2, pa3); pv_one<1, NCB>(o[1], vb, pa0, pa1, pa2, pa3);
  if constexpr (NCB == 4) { pv_one<2, NCB>(o[2], vb, pa0, pa1, pa2, pa3); pv_one<3, NCB>(o[3], vb, pa0, pa1, pa2, pa3); }
}

#define ATT_LAS __attribute__((address_space(3)))
template <int DN, int DV, bool MASK>
__device__ __forceinline__ void attn_unit(const bf16_t* __restrict__ Qb, const int ldq, const bf16_t* __restrict__ Kn, const int ldkn,
    const bf16_t* __restrict__ Kr, const int ldkr, const bf16_t* __restrict__ Vp, const int ldv, bf16_t* __restrict__ Ob, const int ldo,
    const int NT, const int n1, const int r1, const int r2, const int qpos0, const int kt2,
    const float C, const float THRS, const float sinkl2, char* lds, ATT_LAS unsigned char* ldsL, const int wave_) {
  constexpr int NQR = DN > 0 ? DN / 16 : 4, NCB = DV / 32, VB = 64 * DV * 2, KNB = 64 * DN * 2, KRB = 64 * 64 * 2, BUF = VB + KNB + KRB;
  constexpr int NVC = VB / 8192, NKC = KNB / 8192;
  const int wid = wave_, lane = lane_id_v(), r32 = lane & 31, hi = lane >> 5;
  char* Vl = lds; char* Knl = lds + VB; char* Krl = lds + VB + KNB;
  float* wsf = (float*)(lds + 3 * BUF) + wid * 64; float* li_l = wsf; float* al_l = wsf + 32;
  float m_reg = -1e30f, l_reg = 0; f32x16 o[NCB] = {}; bf16x8 qr[NQR];
  const bf16_t* Qw = Qb + (MASK ? (long)r32 * ldq + wid * 64 : (long)(wid * 32 + r32) * ldq) + hi * 8;
#pragma unroll
  for (int d0 = 0; d0 < NQR; ++d0) qr[d0] = *reinterpret_cast<const bf16x8*>(Qw + d0 * 16);
  char* qrl = lds + 3 * BUF + 2048 + wid * 4096 + lane * 16;
  if constexpr (DN > 0) {
#pragma unroll
    for (int d0 = 0; d0 < 4; ++d0) *reinterpret_cast<bf16x8*>(qrl + d0 * 1024) = *reinterpret_cast<const bf16x8*>(Qw + DN + d0 * 16);
  }
  int offV[NVC], offK[NKC > 0 ? NKC : 1], offR;
#pragma unroll
  for (int i = 0; i < NVC; ++i) { const int ch = wid * NVC + i, sub = ch * 2 + (lane >> 5), kk = (sub / NCB) * 8 + ((lane & 31) >> 2), col = (sub % NCB) * 32 + (lane & 3) * 8;
    const int k = (kk & ~0xC) | ((kk & 4) << 1) | ((kk & 8) >> 1); offV[i] = k * ldv + col; }
#pragma unroll
  for (int i = 0; i < NKC; ++i) { const int ch = wid * NKC + i, row = ch * 4 + (lane >> 4), cb = ((lane & 15) * 16) ^ ((row & 15) << 4); offK[i] = row * ldkn + (cb >> 1); }
  { const int row = wid * 8 + (lane >> 3), cb = ((lane & 7) * 16) ^ (((row >> 1) & 7) << 4); offR = row * ldkr + (cb >> 1); }
  const int vb0 = (int)(uintptr_t)Vl + v_rd_base(lane);
  const int qd = qpos0 + (MASK ? 0 : wid * 32) + r32 - 4 * hi;
#define TROW(j) ((j) < n1 ? r1 + 64 * (j) : r2 + 64 * ((j) - n1))
#define DMA(j, b) do { const long row0_ = TROW(j); \
    _Pragma("unroll") for (int i_ = 0; i_ < NVC; ++i_) __builtin_amdgcn_global_load_lds((const unsigned*)(Vp + row0_ * ldv + offV[i_]), (ATT_LAS unsigned*)(ldsL + (b) + (wid * NVC + i_) * 1024), 16, 0, 0); \
    _Pragma("unroll") for (int i_ = 0; i_ < NKC; ++i_) __builtin_amdgcn_global_load_lds((const unsigned*)(Kn + row0_ * ldkn + offK[i_]), (ATT_LAS unsigned*)(ldsL + (b) + VB + (wid * NKC + i_) * 1024), 16, 0, 0); \
    __builtin_amdgcn_global_load_lds((const unsigned*)(Kr + row0_ * ldkr + offR), (ATT_LAS unsigned*)(ldsL + (b) + VB + KNB + wid * 1024), 16, 0, 0); } while (0)
#define WAITV() asm volatile("s_waitcnt vmcnt(0)" ::: "memory")
  const int q0w = qpos0 + (MASK ? 0 : wid * 32);
#define KP(j) (kt2 + 64 * ((j) - n1))
#define NEED(j) (!MASK || (j) < n1 || (KP(j) <= q0w + 159 && KP(j) + 63 >= q0w - 128))
#define SCORE(P0, P1, b, j) do { qkt<DN>(P0, P1, Knl + (b), Krl + (b), qr, qrl, r32, hi); \
    if constexpr (MASK) { if ((j) >= n1 && !(KP(j) >= q0w - 97 && KP(j) <= q0w + 65)) band_mask(P0, P1, qd - KP(j)); } } while (0)
#define RESC(a) do { if (__any((a) < 1.f)) { const int l_ = lane_id_v(); if (l_ < 32) al_l[l_] = (a); asm volatile("s_waitcnt lgkmcnt(0)" ::: "memory"); \
    _Pragma("unroll") for (int d = 0; d < NCB; ++d) _Pragma("unroll") for (int r = 0; r < 16; ++r) o[d][r] *= al_l[crow(r, l_ >> 5)]; } } while (0)
#define ROT() do { const int t_ = bp; bp = bc; bc = bn; bn = t_; } while (0)
  f32x16 pA0, pA1, pB0, pB1; float alA, alB; bf16x8 pa0, pa1, pa2, pa3;
  int bp = 0, bc = BUF, bn = 2 * BUF;
  DMA(0, 0); DMA(1, BUF); WAITV(); __syncthreads();
  SCORE(pA0, pA1, 0, 0); partialSM(pA0, pA1, m_reg, alA, C, THRS);
  bool nA = true, nB = true;
  for (int j = 1; j + 1 < NT; j += 2) {
    DMA(j + 1, bn);
    nB = NEED(j);
    SBAR(); if (nB) SCORE(pB0, pB1, bc, j);
    if (nA) finishSM(pA0, pA1, alA, l_reg, pa0, pa1, pa2, pa3); SBAR();
    if (nA) pv_all<NCB>(o, vb0 + bp, pa0, pa1, pa2, pa3);
    if (nB) { partialSM(pB0, pB1, m_reg, alB, C, THRS); RESC(alB); }
    WAITV(); __syncthreads(); ROT();
    DMA(j + 2, bn);
    nA = NEED(j + 1);
    SBAR(); if (nA) SCORE(pA0, pA1, bc, j + 1);
    if (nB) finishSM(pB0, pB1, alB, l_reg, pa0, pa1, pa2, pa3); SBAR();
    if (nB) pv_all<NCB>(o, vb0 + bp, pa0, pa1, pa2, pa3);
    if (nA) { partialSM(pA0, pA1, m_reg, alA, C, THRS); RESC(alA); }
    WAITV(); __syncthreads(); ROT();
  }
  nB = NEED(NT - 1);
  SBAR(); if (nB) SCORE(pB0, pB1, bc, NT - 1);
  if (nA) finishSM(pA0, pA1, alA, l_reg, pa0, pa1, pa2, pa3); SBAR();
  if (nA) pv_all<NCB>(o, vb0 + bp, pa0, pa1, pa2, pa3);
  if (nB) { partialSM(pB0, pB1, m_reg, alB, C, THRS);
    RESC(alB);
    finishSM(pB0, pB1, alB, l_reg, pa0, pa1, pa2, pa3); SBAR();
    pv_all<NCB>(o, vb0 + bc, pa0, pa1, pa2, pa3); }
  l_reg += __builtin_amdgcn_exp2f(sinkl2 - m_reg * C);
  const int lane2 = lane_id_v(), r32e = lane2 & 31, hie = lane2 >> 5;
  if (hie == 0) li_l[r32e] = l_reg; asm volatile("s_waitcnt lgkmcnt(0)" ::: "memory");
  float rli[16];
#pragma unroll
  for (int r = 0; r < 16; ++r) rli[r] = __builtin_amdgcn_rcpf(li_l[crow(r, hie)]);
  bf16_t* Ow = Ob + (MASK ? (long)(wid * 64) : (long)(wid * 32) * ldo);
#pragma unroll
  for (int r = 0; r < 16; ++r) { const int orow = crow(r, hie);
#pragma unroll
    for (int d0 = 0; d0 < NCB; ++d0) Ow[(long)orow * ldo + d0 * 32 + r32e] = (bf16_t)(cvtpk(o[d0][r] * rli[r], 0.f) & 0xffffu); }
  __syncthreads();
#undef TROW
#undef DMA
#undef WAITV
#undef SCORE
#undef RESC
#undef ROT
#undef KP
#undef NEED
}
}

constexpr size_t MiB = 1u << 20;
constexpr size_t WS_MOD = 0;
constexpr size_t WS_SSQ = 512 * 1024;
constexpr size_t WS_ROPE = 1792 * 1024;
constexpr size_t CTL_ZERO_BYTES = 2 * MiB;
constexpr size_t WS_XC = 2 * MiB;
constexpr size_t WS_WIN = 8 * MiB, WS_WQB = 13 * MiB, WS_WKVB = 16 * MiB, WS_WOM = 20 * MiB, WS_WF1 = 28 * MiB, WS_WF2 = 92 * MiB, WS_WQKV = 156 * MiB, WS_WOS = 166 * MiB;
constexpr size_t WS_S1 = 176 * MiB;
constexpr size_t WS_S2 = 306 * MiB;
constexpr size_t WS_G = 436 * MiB;
constexpr size_t WS_Q = WS_G, WS_KV = WS_G + 196 * MiB, WS_KR = WS_G + 456 * MiB;
constexpr size_t WS_PART = WS_G + 520 * MiB;
constexpr size_t WS_END = WS_PART + 64 * MiB;
static_assert((size_t)NROW * 2048 * 2 == 130 * MiB && WS_SSQ + 8 * (size_t)NROW * 4 <= WS_ROPE && (size_t)NROW * NQ * 2 <= 196 * MiB && (size_t)NROW * NKV * 2 <= 260 * MiB, "ws map");

#define LAS __attribute__((address_space(3)))
typedef unsigned short bf16_t;
typedef float f32x4 __attribute__((ext_vector_type(4)));
typedef unsigned u32x4 __attribute__((ext_vector_type(4)));
typedef unsigned u32x2 __attribute__((ext_vector_type(2)));
constexpr int LDS_BYTES = 3 * 40960 + 2048 + 32768;
constexpr int N_PHASES = 17;
#ifndef PROBE_PH
#define PROBE_PH -1
#endif
#ifndef PROBE_PH2
#define PROBE_PH2 -1
#endif
#if PROBE_PH >= 0
#define rep_PROBE0 (rep_ != 0)
#define REP(k) for (int rep_ = 0; rep_ < ((((PROBE_PH) >> (k)) & 1) ? 2 : 1); ++rep_)
#define SSQP(i) (rep_ ? SSQ + 6 * NROW : SSQ + (i) * NROW)
#else
#define rep_PROBE0 false
#define REP(k)
#define SSQP(i) (SSQ + (i) * NROW)
#endif

struct Args { const float* in[18]; float* out; unsigned char* ws; int ph_lo, ph_hi; };

__device__ __forceinline__ float wave_sum(float v) {
#pragma unroll
  for (int o = 1; o < 64; o <<= 1) v += __shfl_xor(v, o);
  return v;
}
__device__ __forceinline__ unsigned pk2(float lo, float hi) { unsigned r; asm volatile("v_cvt_pk_bf16_f32 %0, %1, %2" : "=v"(r) : "v"(lo), "v"(hi)); return r; }

__device__ __forceinline__ int dest_row(int mode, int n) {
  if (mode == 1) { if (n < 1024) return n; const int j = n - 1024; return 1024 + (((j & 31) << 1) | (j >> 5)); }
  if (mode == 2) { const int h = n / 192, d = n - h * 192; if (d < 128) return n; const int j = d - 128; return h * 192 + 128 + (((j & 31) << 1) | (j >> 5)); }
  if (mode == 3) { if (n >= 2304) return n; const int d = n & 63; return (n & ~63) + (((d & 31) << 1) | (d >> 5)); }
  return n;
}
__device__ __forceinline__ void tr_item(const float* __restrict__ W, int K, int N, bf16_t* __restrict__ WT, const float* __restrict__ ks, int mode, LAS float* scr, int item, int lane) {
  const int nblk = N / 32, kb = item / nblk, nb = item - kb * nblk, k0 = 64 * kb, n0 = 32 * nb;
  float wv[32];
#pragma unroll
  for (int i = 0; i < 32; ++i) wv[i] = W[(size_t)(k0 + 2 * i + (lane >> 5)) * N + n0 + (lane & 31)];
  if (ks) {
#pragma unroll
    for (int i = 0; i < 32; ++i) wv[i] *= ks[k0 + 2 * i + (lane >> 5)];
  }
#pragma unroll
  for (int i = 0; i < 32; ++i) scr[(2 * i + (lane >> 5)) * 33 + (lane & 31)] = wv[i];
  asm volatile("s_waitcnt lgkmcnt(0)" ::: "memory");
  const int c = lane & 7;
#pragma unroll
  for (int j = 0; j < 4; ++j) { const int n = (lane >> 3) + 8 * j; const LAS float* s = scr + (8 * c) * 33 + n;
    u32x4 o; o.x = pk2(s[0 * 33], s[1 * 33]); o.y = pk2(s[2 * 33], s[3 * 33]); o.z = pk2(s[4 * 33], s[5 * 33]); o.w = pk2(s[6 * 33], s[7 * 33]);
    *(u32x4*)(WT + (size_t)dest_row(mode, n0 + n) * K + k0 + 8 * c) = o; }
  asm volatile("s_waitcnt lgkmcnt(0)" ::: "memory");
}

__device__ __forceinline__ float silu_f(float x) { return x / (1.f + __expf(-x)); }

constexpr int TI0 = 32 * 34, TI1 = 8 * 96, TI2 = 8 * 128, TI3 = 32 * 64, TI4 = 32 * 256, TI6 = 128 * 64, TI8 = 32 * 80, TI9 = 32 * 64;
constexpr int N_EARLY = TI0 + TI1 + TI2, N_LATE = TI3 + 2 * TI4 + 2 * TI6 + TI8 + TI9;
__device__ __forceinline__ void tr_dispatch(const Args& a, int it  , LAS float* scr, int lane) {
  unsigned char* ws = a.ws;
  int r = it; const float* W; int K, N, mode = 0; const float* ks = nullptr; bf16_t* dst;
  if (r < TI0) { W = a.in[9]; K = 2048; N = 1088; mode = 1; dst = (bf16_t*)(ws + WS_WIN); }
  else if ((r -= TI0) < TI1) { W = a.in[12]; K = 512; N = 3072; mode = 2; ks = a.in[10]; dst = (bf16_t*)(ws + WS_WQB); }
  else if ((r -= TI1) < TI2) { W = a.in[13]; K = 512; N = 4096; ks = a.in[11]; dst = (bf16_t*)(ws + WS_WKVB); }
  else if ((r -= TI2) < TI3) { W = a.in[14]; K = 2048; N = 2048; dst = (bf16_t*)(ws + WS_WOM); }
  else if ((r -= TI3) < 2 * TI4) { const int l = r / TI4; r -= l * TI4; W = a.in[7] + (size_t)l * 2048 * 8192; K = 2048; N = 8192; dst = (bf16_t*)(ws + WS_WF1) + (size_t)l * 2048 * 8192; }
  else if ((r -= 2 * TI4) < 2 * TI6) { const int l = r / TI6; r -= l * TI6; W = a.in[8] + (size_t)l * 2048 * 8192; K = 8192; N = 2048; dst = (bf16_t*)(ws + WS_WF2) + (size_t)l * 2048 * 8192; }
  else if ((r -= 2 * TI6) < TI8) { W = a.in[15]; K = 2048; N = 2560; mode = 3; dst = (bf16_t*)(ws + WS_WQKV); }
  else { r -= TI8; W = a.in[17]; K = 2048; N = 2048; dst = (bf16_t*)(ws + WS_WOS); }
  tr_item(W, K, N, dst, ks, mode, scr, r, lane);
}

__device__ __forceinline__ void p0_prologue(const Args& a, LAS unsigned char* lds, int gw, int NGW, int wave, int lane, bool only_transposes) {
  unsigned char* ws = a.ws;
  LAS float* scr = (LAS float*)(lds + wave * 16384);
  for (int it = gw; it < N_EARLY + N_LATE; it += NGW) tr_dispatch(a, it, scr, lane);
  if (only_transposes) return;
  float* MOD = (float*)(ws + WS_MOD);
  for (int it = gw; it < 2 * 48 * 64; it += NGW) {
    const int kc = it & 63, cb = (it >> 6) % 48, l = it / (64 * 48);
    const int n0 = cb * 256 + lane * 4, k0 = kc * 32;
    const float* Wm = a.in[4] + (size_t)l * 2048 * 12288 + n0;
    f32x4 a0 = {0.f, 0.f, 0.f, 0.f}, a1 = a0, a2 = a0;
#pragma unroll 16
    for (int k = 0; k < 32; ++k) { const int kk = k0 + k;
      const float s0 = silu_f(a.in[1][kk]), s1 = silu_f(a.in[1][2048 + kk]), s2 = silu_f(a.in[3][kk]);
      const f32x4 w = *(const f32x4*)(Wm + (size_t)kk * 12288);
      a0 += w * s0; a1 += w * s1; a2 += w * s2; }
    if (kc == 0) { const f32x4 b = *(const f32x4*)(a.in[5] + l * 12288 + n0); a0 += b; a1 += b; a2 += b; }
    float* mo = MOD + (size_t)(l * 3) * 12288 + n0;
#pragma unroll
    for (int e = 0; e < 4; ++e) { atomicAdd(mo + e, a0[e]); atomicAdd(mo + 12288 + e, a1[e]); atomicAdd(mo + 2 * 12288 + e, a2[e]); }
  }
  float* tab = (float*)(ws + WS_ROPE);
  for (int e = gw * 64 + lane; e < 320 * 16; e += NGW * 64) {
    const int i = e & 15, pos = e >> 4; const float p = (float)(pos < 256 ? pos : pos - 256);
    const float freq = exp2f(-(float)i * 0.8304820237218406f); const float ang = p * freq;
    tab[e * 2] = cosf(ang); tab[e * 2 + 1] = sinf(ang);
  }
}

__device__ __forceinline__ f32x4 ldf4(const float* base, unsigned boff) { return *(const f32x4*)((const char*)base + boff); }
__device__ __forceinline__ void stf4(float* base, unsigned boff, f32x4 v) { *(f32x4*)((char*)base + boff) = v; }
__device__ __forceinline__ f32x4 ldf4s(const float* base, unsigned boff) { return __builtin_nontemporal_load((const f32x4*)((const char*)base + boff)); }
__device__ __forceinline__ void stf4s(float* base, unsigned boff, f32x4 v) { __builtin_nontemporal_store(v, (f32x4*)((char*)base + boff)); }
template <bool UPD, bool DOH, int NKC>
__device__ __forceinline__ void norm_rows(const int row0, const int nrows, const float* xin_lat, const float* xin_ctx, float* xout_lat, float* xout_ctx, const bf16_t* Y, const float* ssq,
    const float* gA, const float* gateM, const float* gB, const float* scM, const float* shM, bf16_t* H, int lane, const float* part) {
  const int b = row0 / TB, rb = row0 - b * TB; const bool isctx = rb < CTXL;
  const int v = isctx ? 2 : b;
  const size_t xoff = isctx ? (size_t)(b * CTXL + rb) * DM : (size_t)(b * SEQ + rb - CTXL) * DM;
  const float* xin = (isctx ? xin_ctx : xin_lat) + xoff;
  float* xout = UPD ? ((isctx ? xout_ctx : xout_lat) + xoff) : nullptr;
  const int lane_ = lane_id_v();
  const unsigned lo = (unsigned)lane_ * 16u, lo2 = (unsigned)lane_ * 8u;
  f32x4 GA[8], GB[8], SH[8];
#pragma unroll
  for (int j = 0; j < 8; ++j) { const unsigned o = lo + 1024u * j;
    if (UPD) GA[j] = ldf4(gateM + v * 12288, o) * ldf4(gA, o);
    if (DOH) { GB[j] = ldf4(gB, o) * (ldf4(scM + v * 12288, o) + 1.0f); SH[j] = ldf4(shM + v * 12288, o); } }
  f32x4 xn[8]; u32x2 yn[8];
#pragma unroll
  for (int j = 0; j < 8; ++j) { xn[j] = ldf4s(xin, lo + 1024u * j); if (UPD && !(NKC > 0 && isctx)) yn[j] = __builtin_nontemporal_load((const u32x2*)((const char*)(Y + (size_t)row0 * DM) + lo2 + 512u * j)); }
  for (int rr = 0; rr < nrows; ++rr) {
    const int row = row0 + rr;
    f32x4 x[8]; u32x2 yc[8];
#pragma unroll
    for (int j = 0; j < 8; ++j) { x[j] = xn[j]; if (UPD) yc[j] = yn[j]; }
    if (rr + 1 < nrows) { const float* xr = xin + (size_t)(rr + 1) * DM;
#pragma unroll
      for (int j = 0; j < 8; ++j) { xn[j] = ldf4s(xr, lo + 1024u * j); if (UPD && !(NKC > 0 && isctx)) yn[j] = __builtin_nontemporal_load((const u32x2*)((const char*)(Y + (size_t)(row + 1) * DM) + lo2 + 512u * j)); } }
    if (UPD && NKC > 0 && isctx) {
      f32x4 y[8]; float ys = 0.f; const float* pr = part + (size_t)(b * CTXL + rb + rr) * DM;
#pragma unroll
      for (int j = 0; j < 8; ++j) y[j] = ldf4(pr, lo + 1024u * j);
#pragma unroll 1
      for (int k = 1; k < NKC; ++k) { pr += (size_t)512 * DM;
#pragma unroll
        for (int j = 0; j < 8; ++j) y[j] += ldf4(pr, lo + 1024u * j); }
#pragma unroll
      for (int j = 0; j < 8; ++j) ys += (y[j][0] * y[j][0] + y[j][1] * y[j][1]) + (y[j][2] * y[j][2] + y[j][3] * y[j][3]);
      const float rinv = __builtin_amdgcn_rsqf(wave_sum(ys) * (1.0f / 2048.0f) + NORM_EPS);
      float* xo = xout + (size_t)rr * DM;
#pragma unroll
      for (int j = 0; j < 8; ++j) { x[j] += GA[j] * (y[j] * rinv); stf4s(xo, lo + 1024u * j, x[j]); }
    } else if (UPD) {
      const float rinv = __builtin_amdgcn_rsqf(ssq[row] * (1.0f / 2048.0f) + NORM_EPS);
      float* xo = xout + (size_t)rr * DM;
#pragma unroll
      for (int j = 0; j < 8; ++j) { const u32x2 yb = yc[j];
        f32x4 y; y[0] = __uint_as_float(yb.x << 16); y[1] = __uint_as_float(yb.x & 0xffff0000u); y[2] = __uint_as_float(yb.y << 16); y[3] = __uint_as_float(yb.y & 0xffff0000u);
        x[j] += GA[j] * (y * rinv);
        stf4s(xo, lo + 1024u * j, x[j]); }
    }
    if (DOH) {
      float ss = 0.f;
#pragma unroll
      for (int j = 0; j < 8; ++j) ss += (x[j][0] * x[j][0] + x[j][1] * x[j][1]) + (x[j][2] * x[j][2] + x[j][3] * x[j][3]);
      const float r = __builtin_amdgcn_rsqf(wave_sum(ss) * (1.0f / 2048.0f) + NORM_EPS);
      bf16_t* hr = H + (size_t)row * DM;
#pragma unroll
      for (int j = 0; j < 8; ++j) { const f32x4 h = x[j] * r * GB[j] + SH[j]; u32x2 w; w.x = pk2(h[0], h[1]); w.y = pk2(h[2], h[3]);
        *(u32x2*)((char*)hr + lo2 + 512u * j) = w; }
    }
  }
}
template <bool UPD, bool DOH, int NKC = 0>
__device__ __forceinline__ void norm_phase(const float* xin_lat, const float* xin_ctx, float* xout_lat, float* xout_ctx, const bf16_t* Y, const float* ssq,
    const float* gA, const float* gateM, const float* gB, const float* scM, const float* shM, bf16_t* H, bool skipctx, int gw, int NGW, int lane, const float* part = nullptr) {
  for (int ch = gw; ch < 2 * SEQ / 16; ch += NGW) { const int b = ch / (SEQ / 16), row0 = b * TB + CTXL + (ch - b * (SEQ / 16)) * 16;
    norm_rows<UPD, DOH, 0>(row0, 16, xin_lat, xin_ctx, xout_lat, xout_ctx, Y, ssq, gA, gateM, gB, scM, shM, H, lane, part); }
  if (!skipctx)
    for (int r = gw; r < 2 * CTXL; r += NGW) { const int b = r / CTXL, row0 = b * TB + (r - b * CTXL);
      norm_rows<UPD, DOH, NKC>(row0, 1, xin_lat, xin_ctx, xout_lat, xout_ctx, Y, ssq, gA, gateM, gB, scM, shM, H, lane, part); }
}

__global__ void __launch_bounds__(512, 2) mk_fwd(Args a) {
  extern __shared__ __attribute__((aligned(16))) unsigned char lds[];
  cg::grid_group grid = cg::this_grid();
  const int wave = __builtin_amdgcn_readfirstlane(threadIdx.x >> 6);
  const int G = gridDim.x, c = blockIdx.x, gw = c * 8 + wave, NGW = G * 8;
  LAS unsigned char* ldsL = (LAS unsigned char*)lds;
  unsigned char* ws = a.ws;
  const int lo = a.ph_lo, hi = a.ph_hi;
#define IN(k) (lo <= (k) && (k) < hi)
  unsigned* barw = (unsigned*)(ws + CTL_ZERO_BYTES - 256); unsigned bar_epoch = 0;
#define OWN_BAR() do { __builtin_amdgcn_fence(__ATOMIC_RELEASE, "workgroup"); __builtin_amdgcn_s_barrier(); bar_epoch += (unsigned)G; \
    if (wave == 0) { if (lane_id_v() == 0) { __builtin_amdgcn_fence(__ATOMIC_ACQUIRE, "workgroup"); __builtin_amdgcn_fence(__ATOMIC_RELEASE, "agent"); \
      __hip_atomic_fetch_add(barw, 1u, __ATOMIC_RELAXED, __HIP_MEMORY_SCOPE_AGENT); \
      while (__hip_atomic_load(barw, __ATOMIC_RELAXED, __HIP_MEMORY_SCOPE_AGENT) < bar_epoch) __builtin_amdgcn_s_sleep(1); \
      __builtin_amdgcn_fence(__ATOMIC_ACQUIRE, "agent"); __builtin_amdgcn_fence(__ATOMIC_RELEASE, "workgroup"); } } \
    __builtin_amdgcn_s_barrier(); __builtin_amdgcn_fence(__ATOMIC_ACQUIRE, "workgroup"); } while (0)
#define SEAM(k) do { if (IN(k) && IN((k) + 1)) { if ((k) == 0) grid.sync(); else { OWN_BAR(); if ((PROBE_PH >> 20) & 1) OWN_BAR(); } } } while (0)
  float* MOD = (float*)(ws + WS_MOD); float* SSQ = (float*)(ws + WS_SSQ);
  const float* RT = (const float*)(ws + WS_ROPE); const float* CT = RT + 256 * 16 * 2;
  float* XC = (float*)(ws + WS_XC); float* PART = (float*)(ws + WS_PART);
  bf16_t* S1 = (bf16_t*)(ws + WS_S1); bf16_t* S2 = (bf16_t*)(ws + WS_S2);
  bf16_t* Qb = (bf16_t*)(ws + WS_Q); bf16_t* KVb = (bf16_t*)(ws + WS_KV); bf16_t* KRb = (bf16_t*)(ws + WS_KR); bf16_t* Gb = (bf16_t*)(ws + WS_G);
  const float* gn = a.in[6];
#define MODP(l, chunk) (MOD + (size_t)(l) * 3 * 12288 + (chunk) * 2048)
#define RUN_GEMM(MODE, Ap, lda_, Bp, N_, K_, skip, ...) do { pg8::Gemm g{Ap, Bp, NROW, N_, K_, lda_, K_}; pg8::RowSched S; S.init((skip) ? 128 : 130, (N_) / 256, G, c, (skip) ? 1 : 0, (K_) == DFF ? 1 : 0); \
    pg8::Epi<MODE> E{__VA_ARGS__}; pg8::gemm_phase<pg8::Epi<MODE>, pg8::RowSched, true, true>(ldsL, g, S, E, wave); } while (0)
#define RUN_CTX_SPLIT(Ap, Bp, K_, NKC_) do { pg8::Gemm g{Ap, Bp, NROW, 2048, (K_) / (NKC_), K_, K_}; pg8::CtxSplitSched S; S.init(8, NKC_, G, c); \
    pg8::Epi<6> E{nullptr, 2048, nullptr, nullptr, nullptr, RT, CT, PART}; pg8::gemm_phase<pg8::Epi<6>, pg8::CtxSplitSched, true, true>(ldsL, g, S, E, wave); } while (0)

  if (IN(0)) { REP(0) p0_prologue(a, ldsL, gw, NGW, wave, lane_id_v(), rep_PROBE0); __syncthreads(); } SEAM(0);
  if (IN(1)) REP(1) norm_phase<false, true>(a.in[0], a.in[2], nullptr, nullptr, nullptr, nullptr, nullptr, nullptr, gn + 0 * 2048, MODP(0, 1), MODP(0, 0), S1, false, gw, NGW, lane_id_v());
  SEAM(1);
  if (IN(2)) REP(2) RUN_GEMM(1, S1, 2048, (const bf16_t*)(ws + WS_WIN), NP1, 2048, false, S2, NP1, SSQP(0), nullptr, KRb, RT, CT);
  SEAM(2);
  if (IN(3)) REP(3) {
    RUN_GEMM(2, S2, NP1, (const bf16_t*)(ws + WS_WQB), NQ, 512, false, Qb, NQ, nullptr, SSQ, nullptr, RT, CT);
    RUN_GEMM(3, S2 + 512, NP1, (const bf16_t*)(ws + WS_WKVB), NKV, 512, false, KVb, NKV, nullptr, SSQ + NROW, nullptr, RT, CT);
  }
  SEAM(3);
  if (IN(4)) REP(4) {
    const float SC = 0.07216878364870322f, Cc = SC * 1.4426950408889634f, THRS = 8.f / SC;
    for (int r = 0;; ++r) {
      const int u = c + r * G; if (u >= 2080) break;
      int b, h, rowq, NT;
      if (u < 2048) { int pair, qb; if (G == 256) { pair = (c & 7) * 4 + (r >> 1); qb = (c >> 3) + 32 * (r & 1); } else { pair = u >> 6; qb = u & 63; }
        b = pair >> 4; h = pair & 15; rowq = b * TB + CTXL + qb * 256; NT = TB / 64; }
      else { const int p = u - 2048; b = p >> 4; h = p & 15; rowq = b * TB; NT = CTXL / 64; }
      const bf16_t* kvh_ = KVb + ((size_t)(b * 15 + h) * TB) * 256;
      att::attn_unit<128, 128, false>(Qb + (size_t)rowq * NQ + h * 192, NQ, kvh_, 256, KRb, 64, kvh_ + 128, 256, S1 + (size_t)rowq * DM + h * 128, DM,
                                      NT, NT, b * TB, 0, 0, 0, Cc, THRS, -INFINITY, (char*)lds, ldsL, wave);
    }
  }
  SEAM(4);
  if (IN(5)) REP(5) { RUN_GEMM(0, S1, 2048, (const bf16_t*)(ws + WS_WOM), 2048, 2048, true, S2, 2048, SSQP(2), nullptr, nullptr, RT, CT);
    RUN_CTX_SPLIT(S1, (const bf16_t*)(ws + WS_WOM), 2048, 8); }
  SEAM(5);
  if (IN(6)) norm_phase<true, true, 8>(a.in[0], a.in[2], a.out, XC, S2, SSQ + 2 * NROW, gn + 1 * 2048, MODP(0, 2), gn + 2 * 2048, MODP(0, 4), MODP(0, 3), S1, false, gw, NGW, lane_id_v(), PART);
  SEAM(6);
  if (IN(7)) REP(7) RUN_GEMM(4, S1, 2048, (const bf16_t*)(ws + WS_WF1), DFF, 2048, false, Gb, DFF, nullptr, nullptr, nullptr, RT, CT);
  SEAM(7);
  if (IN(8)) REP(8) { RUN_GEMM(0, Gb, DFF, (const bf16_t*)(ws + WS_WF2), 2048, DFF, true, S2, 2048, SSQP(3), nullptr, nullptr, RT, CT);
    RUN_CTX_SPLIT(Gb, (const bf16_t*)(ws + WS_WF2), DFF, 16); }
  SEAM(8);
  if (IN(9)) norm_phase<true, true, 16>(a.out, XC, a.out, XC, S2, SSQ + 3 * NROW, gn + 3 * 2048, MODP(0, 5), gn + 4 * 2048, MODP(1, 1), MODP(1, 0), S1, false, gw, NGW, lane_id_v(), PART);
  SEAM(9);
  if (IN(10)) REP(10) RUN_GEMM(5, S1, 2048, (const bf16_t*)(ws + WS_WQKV), NQKV, 2048, false, Gb, NQKV, nullptr, nullptr, nullptr, RT, CT);
  SEAM(10);
  if (IN(11)) REP(11) {
    const float SC = 0.125f, Cc = SC * 1.4426950408889634f, THRS = 8.f / SC;
    const int cx = (G == 256) ? (c & 7) * 32 + (c >> 3) : c;
    for (int u = cx; u < 4096; u += G) {
      const int pairkv = u >> 9, qb32 = u & 511, b = pairkv >> 2, kvh = pairkv & 3, t0 = qb32 * 32;
      int f = (t0 - 128) < 0 ? 0 : (t0 - 128) >> 6, l = (t0 + 159) >> 6; if (l > SEQ / 64 - 1) l = SEQ / 64 - 1;
      if ((l - f + 1) & 1) { if (l < SEQ / 64 - 1) ++l; else --f; }
      const int nwin = l - f + 1, tstart = 64 * f;
      const int rowq = b * TB + CTXL + t0;
      att::attn_unit<0, 64, true>(Gb + (size_t)rowq * NQKV + kvh * 512, NQKV, nullptr, 0, Gb + 2048 + kvh * 64, NQKV, Gb + 2304 + kvh * 64, NQKV, S1 + (size_t)rowq * DM + kvh * 512, DM,
                                  4 + nwin, 4, b * TB, b * TB + CTXL + tstart, t0, tstart, Cc, THRS, a.in[16][kvh * 8 + wave] * 1.4426950408889634f, (char*)lds, ldsL, wave);
    }
  }
  SEAM(11);
  if (IN(12)) REP(12) RUN_GEMM(0, S1, 2048, (const bf16_t*)(ws + WS_WOS), 2048, 2048, true, S2, 2048, SSQP(4), nullptr, nullptr, RT, CT);
  SEAM(12);
  if (IN(13)) norm_phase<true, true>(a.out, XC, a.out, XC, S2, SSQ + 4 * NROW, gn + 5 * 2048, MODP(1, 2), gn + 6 * 2048, MODP(1, 4), MODP(1, 3), S1, true, gw, NGW, lane_id_v());
  SEAM(13);
  if (IN(14)) REP(14) RUN_GEMM(4, S1, 2048, (const bf16_t*)(ws + WS_WF1) + (size_t)2048 * 8192, DFF, 2048, true, Gb, DFF, nullptr, nullptr, nullptr, RT, CT);
  SEAM(14);
  if (IN(15)) REP(15) RUN_GEMM(0, Gb, DFF, (const bf16_t*)(ws + WS_WF2) + (size_t)2048 * 8192, 2048, DFF, true, S2, 2048, SSQP(5), nullptr, nullptr, RT, CT);
  SEAM(15);
  if (IN(16)) norm_phase<true, false>(a.out, XC, a.out, XC, S2, SSQ + 5 * NROW, gn + 7 * 2048, MODP(1, 5), nullptr, nullptr, nullptr, nullptr, true, gw, NGW, lane_id_v());
#undef IN
#undef SEAM
}

extern "C" void kernel_launch(void* const* d_in, const int* in_sizes, int n_in, void* d_out, int out_size, void* d_ws, size_t ws_size, hipStream_t stream) {
  static int grid = 0;
  if (grid == 0) {
    if (n_in != 18 || out_size != 2 * SEQ * DM || ws_size < WS_END) { fprintf(stderr, "kernel_launch: unexpected shapes: n_in %d out %d ws %zu (need %zu)\n", n_in, out_size, ws_size, (size_t)WS_END); grid = -1; return; }
    int dev = 0, cus = 0, per_cu = 0;
    hipGetDevice(&dev); hipDeviceGetAttribute(&cus, hipDeviceAttributeMultiprocessorCount, dev);
    if (hipFuncSetAttribute((const void*)mk_fwd, hipFuncAttributeMaxDynamicSharedMemorySize, LDS_BYTES) != hipSuccess) { fprintf(stderr, "kernel_launch: hipFuncSetAttribute failed\n"); grid = -1; return; }
    if (hipOccupancyMaxActiveBlocksPerMultiprocessor(&per_cu, (const void*)mk_fwd, 512, LDS_BYTES) != hipSuccess || per_cu < 1) { fprintf(stderr, "kernel_launch: occupancy query gave %d\n", per_cu); per_cu = 1; }
    (void)hipGetLastError();
    grid = cus * per_cu;
    fprintf(stderr, "kernel_launch: grid %d (cus %d x %d)\n", grid, cus, per_cu);
  }
  if (grid < 0) return;
  hipMemsetAsync((char*)d_ws, 0, CTL_ZERO_BYTES, stream);
  Args a{};
  for (int i = 0; i < 18; ++i) a.in[i] = (const float*)d_in[i];
  a.out = (float*)d_out; a.ws = (unsigned char*)d_ws; a.ph_lo = 0; a.ph_hi = N_PHASES;
  void* args[] = {&a};
  hipError_t e = hipLaunchCooperativeKernel((const void*)mk_fwd, dim3(grid), dim3(512), args, LDS_BYTES, stream);
  if (e != hipSuccess) fprintf(stderr, "kernel_launch: cooperative launch failed: %s (grid %d)\n", hipGetErrorString(e), grid);
}
```
